# Optimizing an MI355X kernel written in HIP

```python
import jax, jax.numpy as jnp
from jax import lax
import numpy as np

D_MODEL = 2048
BATCH = 4
SEQ = 8192
DEPTH = 2
DEC_BATCH = 8
DEC_SEQ = 32
PAST_LEN = 1024

CHUNK = 64
HEAD_DIM = 128
N_HEADS = D_MODEL // HEAD_DIM
H_A = N_HEADS // 4
H_B = (N_HEADS - H_A) // 2
H_C = N_HEADS - H_A - H_B
A_LEFT_CHUNKS = 8
A_WIN = A_LEFT_CHUNKS * CHUNK
A_BAND = (A_LEFT_CHUNKS + 1) * CHUNK
REL_CLIP = 128
N_REL = 2 * REL_CLIP + 1
D_FF = -(-8 * D_MODEL // (3 * 256)) * 256
N_IN = 3 * D_MODEL + H_B
Q_BLOCK = 128
EPS = 1e-6
ATTN_SCALE = HEAD_DIM ** -0.5
FORGET_BIAS = 4.0

kernel_name = 'hybrid_streaming_encoder_step'

F32 = jnp.float32


def rmsnorm(x, g):
    xf = x.astype(F32)
    y = xf * lax.rsqrt(jnp.mean(xf * xf, axis=-1, keepdims=True) + EPS)
    return (y * g.astype(F32)).astype(x.dtype)


def split_heads(t):
    return t[:, :, :H_A], t[:, :, H_A:H_A + H_B], t[:, :, H_A + H_B:]


def rel_bias_scores(rel_table, rel):
    idx = jnp.clip(rel, -REL_CLIP, REL_CLIP) + REL_CLIP
    return jnp.transpose(rel_table[idx], (2, 0, 1)).astype(F32)


def to_blocks(t):
    b, t_len = t.shape[:2]
    return jnp.swapaxes(t.reshape((b, t_len // Q_BLOCK, Q_BLOCK) + t.shape[2:]), 0, 1)


def from_blocks(o):
    o = jnp.swapaxes(o, 0, 1)
    return o.reshape((o.shape[0], o.shape[1] * o.shape[2]) + o.shape[3:])


def band_attn_prompt(q, k, v, rel_table):
    b, t_len, h, dh = q.shape
    nc = t_len // CHUNK
    left = A_LEFT_CHUNKS * CHUNK

    def band(t):
        tp = jnp.pad(t, ((0, 0), (left, 0), (0, 0), (0, 0))).reshape(b, nc + A_LEFT_CHUNKS, CHUNK, h, dh)
        return jnp.concatenate([tp[:, j:j + nc] for j in range(A_LEFT_CHUNKS + 1)], axis=2)

    kb, vb = band(k), band(v)
    qc = q.reshape(b, nc, CHUNK, h, dh)
    s = jnp.einsum('bnqhd,bnkhd->bnhqk', qc, kb).astype(F32) * ATTN_SCALE
    slot = jnp.arange(A_BAND)
    rel = jnp.arange(CHUNK)[:, None] + left - slot[None, :]
    s = s + rel_bias_scores(rel_table, rel)
    kpos = (jnp.arange(nc)[:, None] - A_LEFT_CHUNKS) * CHUNK + slot[None, :]
    s = jnp.where((kpos >= 0)[None, :, None, None, :], s, -jnp.inf)
    p = jax.nn.softmax(s, axis=-1).astype(v.dtype)
    return jnp.einsum('bnhqk,bnkhd->bnqhd', p, vb).reshape(b, t_len, h, dh)


def band_attn_sample(q, k, v, ck, cv, rel_table):
    w = ck.shape[1]
    tn = q.shape[1]
    kk = jnp.concatenate([ck.astype(k.dtype), k], axis=1)
    vv = jnp.concatenate([cv.astype(v.dtype), v], axis=1)
    s = jnp.einsum('bqhd,bkhd->bhqk', q, kk).astype(F32) * ATTN_SCALE
    rel = jnp.arange(tn)[:, None] - (jnp.arange(w + tn) - w)[None, :]
    s = s + rel_bias_scores(rel_table, rel)
    p = jax.nn.softmax(s, axis=-1).astype(v.dtype)
    return jnp.einsum('bhqk,bkhd->bqhd', p, vv)


def fox_core(q, k, v, fq, fk, qpos, kpos):
    s = jnp.einsum('bqhd,bkhd->bhqk', q, k).astype(F32) * ATTN_SCALE
    s = s + jnp.transpose(fq, (0, 2, 1))[..., :, None] - jnp.transpose(fk, (0, 2, 1))[..., None, :]
    s = jnp.where(kpos[None, :] <= qpos[:, None], s, -jnp.inf)
    p = jax.nn.softmax(s, axis=-1).astype(v.dtype)
    return jnp.einsum('bhqk,bkhd->bqhd', p, v)


def fox_prompt(q, k, v, logf):
    t_len = q.shape[1]
    f_cum = jnp.cumsum(logf, axis=1)
    kpos = jnp.arange(t_len)

    def block(args):
        qi, fi, q0 = args
        return fox_core(qi, k, v, fi, f_cum, q0 + jnp.arange(Q_BLOCK), kpos)

    o = lax.map(block, (to_blocks(q), to_blocks(f_cum), jnp.arange(0, t_len, Q_BLOCK)))
    return from_blocks(o)


def fox_sample(q, k, v, logf, ck, cv, clogf):
    p_len = ck.shape[1]
    tn = q.shape[1]
    kk = jnp.concatenate([ck.astype(k.dtype), k], axis=1)
    vv = jnp.concatenate([cv.astype(v.dtype), v], axis=1)
    f_cum = jnp.cumsum(jnp.concatenate([clogf.astype(F32), logf], axis=1), axis=1)
    return fox_core(q, kk, vv, f_cum[:, p_len:], f_cum, p_len + jnp.arange(tn), jnp.arange(p_len + tn))


def stick_core(q, k, v, qpos, kpos):
    z = jnp.einsum('bqhd,bkhd->bhqk', q, k).astype(F32) * ATTN_SCALE
    mask = kpos[None, :] < qpos[:, None]
    log_stay = jnp.where(mask, jax.nn.log_sigmoid(-z), 0.0)
    after = lax.cumsum(log_stay, axis=3, reverse=True) - log_stay
    weight = jnp.where(mask, jnp.exp(jax.nn.log_sigmoid(z) + after), 0.0)
    return jnp.einsum('bhqk,bkhd->bqhd', weight.astype(v.dtype), v)


def stick_prompt(q, k, v):
    t_len = q.shape[1]
    kpos = jnp.arange(t_len)

    def block(args):
        qi, q0 = args
        return stick_core(qi, k, v, q0 + jnp.arange(Q_BLOCK), kpos)

    o = lax.map(block, (to_blocks(q), jnp.arange(0, t_len, Q_BLOCK)))
    return from_blocks(o)


def stick_sample(q, k, v, ck, cv):
    p_len = ck.shape[1]
    tn = q.shape[1]
    kk = jnp.concatenate([ck.astype(k.dtype), k], axis=1)
    vv = jnp.concatenate([cv.astype(v.dtype), v], axis=1)
    return stick_core(q, kk, vv, p_len + jnp.arange(tn), jnp.arange(p_len + tn))


def mix_prompt(q, k, v, logf, rel_table):
    t_len = q.shape[1]
    qa, qb, qc = split_heads(q)
    ka, kb, kc = split_heads(k)
    va, vb, vc = split_heads(v)
    o = jnp.concatenate([band_attn_prompt(qa, ka, va, rel_table),
                         fox_prompt(qb, kb, vb, logf),
                         stick_prompt(qc, kc, vc)], axis=2)
    keep = min(A_WIN, t_len)
    return o, (ka[:, t_len - keep:], va[:, t_len - keep:], kb, vb, logf, kc, vc)


def mix_sample(q, k, v, logf, cak, cav, cbk, cbv, cblogf, cck, ccv, rel_table):
    qa, qb, qc = split_heads(q)
    ka, kb, kc = split_heads(k)
    va, vb, vc = split_heads(v)
    o = jnp.concatenate([band_attn_sample(qa, ka, va, cak, cav, rel_table),
                         fox_sample(qb, kb, vb, logf, cbk, cbv, cblogf),
                         stick_sample(qc, kc, vc, cck, ccv)], axis=2)
    return o, (ka, va, kb, vb, logf, kc, vc)


def layer_forward(x, c, mixer, mixer_args, w_ada, b_ada, g_attn, g_ffn, w_in, b_f, w_o, w_gate, w_up, w_down):
    b, t_len, _ = x.shape
    mod = jax.nn.silu(c) @ w_ada + b_ada
    sh1, sc1, gt1, sh2, sc2, gt2 = [m[:, None, :] for m in jnp.split(mod, 6, axis=-1)]
    h = rmsnorm(x, g_attn) * (1 + sc1) + sh1
    proj = h @ w_in
    q = proj[..., :D_MODEL].reshape(b, t_len, N_HEADS, HEAD_DIM)
    k = proj[..., D_MODEL:2 * D_MODEL].reshape(b, t_len, N_HEADS, HEAD_DIM)
    v = proj[..., 2 * D_MODEL:3 * D_MODEL].reshape(b, t_len, N_HEADS, HEAD_DIM)
    logf = jax.nn.log_sigmoid((proj[..., 3 * D_MODEL:] + b_f).astype(F32))
    o, state = mixer(q, k, v, logf, *mixer_args)
    x = x + gt1 * (o.reshape(b, t_len, D_MODEL) @ w_o)
    h = rmsnorm(x, g_ffn) * (1 + sc2) + sh2
    x = x + gt2 * ((jax.nn.silu(h @ w_gate) * (h @ w_up)) @ w_down)
    return x, state


def setup_inputs(seed: int = 0) -> dict:
    key = jax.random.key(seed)
    ks = jax.random.split(key, 26)

    def nrm(k, shape, scale):
        return jax.random.normal(k, shape, F32) * scale

    a_cache = min(A_WIN, PAST_LEN)
    return {
        'x_prompt': nrm(ks[0], (BATCH, SEQ, D_MODEL), 1.0),
        'x_sample': nrm(ks[1], (DEC_BATCH, DEC_SEQ, D_MODEL), 1.0),
        'cache_a_k': nrm(ks[2], (DEPTH, DEC_BATCH, a_cache, H_A, HEAD_DIM), 1.0),
        'cache_a_v': nrm(ks[3], (DEPTH, DEC_BATCH, a_cache, H_A, HEAD_DIM), 1.0),
        'cache_b_k': nrm(ks[4], (DEPTH, DEC_BATCH, PAST_LEN, H_B, HEAD_DIM), 1.0),
        'cache_b_v': nrm(ks[5], (DEPTH, DEC_BATCH, PAST_LEN, H_B, HEAD_DIM), 1.0),
        'cache_b_logf': jax.nn.log_sigmoid(FORGET_BIAS + nrm(ks[6], (DEPTH, DEC_BATCH, PAST_LEN, H_B), 1.0)),
        'cache_c_k': nrm(ks[7], (DEPTH, DEC_BATCH, PAST_LEN, H_C, HEAD_DIM), 1.0),
        'cache_c_v': nrm(ks[8], (DEPTH, DEC_BATCH, PAST_LEN, H_C, HEAD_DIM), 1.0),
        'c_prompt': nrm(ks[9], (BATCH, D_MODEL), 1.0),
        'c_sample': nrm(ks[10], (DEC_BATCH, D_MODEL), 1.0),
        'w_ada': nrm(ks[11], (DEPTH, D_MODEL, 6 * D_MODEL), 0.5 * D_MODEL ** -0.5),
        'b_ada': nrm(ks[12], (DEPTH, 6 * D_MODEL), 0.01),
        'g_attn': 1.0 + nrm(ks[13], (DEPTH, D_MODEL), 0.1),
        'g_ffn': 1.0 + nrm(ks[14], (DEPTH, D_MODEL), 0.1),
        'w_in': nrm(ks[15], (DEPTH, D_MODEL, N_IN), D_MODEL ** -0.5),
        'b_f': FORGET_BIAS + nrm(ks[16], (DEPTH, H_B), 0.1),
        'rel_bias': nrm(ks[17], (DEPTH, N_REL, H_A), 0.5),
        'w_o': nrm(ks[18], (DEPTH, D_MODEL, D_MODEL), D_MODEL ** -0.5),
        'w_gate': nrm(ks[19], (DEPTH, D_MODEL, D_FF), D_MODEL ** -0.5),
        'w_up': nrm(ks[20], (DEPTH, D_MODEL, D_FF), D_MODEL ** -0.5),
        'w_down': nrm(ks[21], (DEPTH, D_FF, D_MODEL), D_FF ** -0.5),
        'g_final': 1.0 + nrm(ks[22], (D_MODEL,), 0.1),
    }


def reference(x_prompt, x_sample, cache_a_k, cache_a_v, cache_b_k, cache_b_v, cache_b_logf, cache_c_k, cache_c_v,
              c_prompt, c_sample, w_ada, b_ada, g_attn, g_ffn, w_in, b_f, rel_bias, w_o, w_gate, w_up, w_down, g_final):
    xp, xs = x_prompt, x_sample
    states_p, states_s = [], []
    for l in range(DEPTH):
        params = (w_ada[l], b_ada[l], g_attn[l], g_ffn[l], w_in[l], b_f[l], w_o[l], w_gate[l], w_up[l], w_down[l])
        xp, st_p = layer_forward(xp, c_prompt, mix_prompt, (rel_bias[l],), *params)
        xs, st_s = layer_forward(xs, c_sample, mix_sample,
                                 (cache_a_k[l], cache_a_v[l], cache_b_k[l], cache_b_v[l], cache_b_logf[l],
                                  cache_c_k[l], cache_c_v[l], rel_bias[l]), *params)
        states_p.append(st_p)
        states_s.append(st_s)
    a_k_p, a_v_p, b_k_p, b_v_p, b_logf_p, c_k_p, c_v_p = [jnp.stack(t) for t in zip(*states_p)]
    a_k_s, a_v_s, b_k_s, b_v_s, b_logf_s, c_k_s, c_v_s = [jnp.stack(t) for t in zip(*states_s)]
    y_prompt = rmsnorm(xp, g_final)
    y_sample = rmsnorm(xs, g_final)
    return (y_prompt, y_sample, a_k_p, a_v_p, b_k_p, b_v_p, b_logf_p, c_k_p, c_v_p,
            a_k_s, a_v_s, b_k_s, b_v_s, b_logf_s, c_k_s, c_v_s)
```

```cpp
#include <hip/hip_runtime.h>
#include <cstdio>
#include <cstdint>

#define LAS __attribute__((address_space(3)))
#define GAS __attribute__((address_space(1)))
typedef unsigned short bf16;
typedef short bf16x8 __attribute__((ext_vector_type(8)));
typedef float f32x4 __attribute__((ext_vector_type(4)));
typedef float f32x2 __attribute__((ext_vector_type(2)));
typedef float f32x16 __attribute__((ext_vector_type(16)));
typedef unsigned u32x4 __attribute__((ext_vector_type(4)));
typedef unsigned u32x2 __attribute__((ext_vector_type(2)));

constexpr int D = 2048, NH = 16, HD = 128, DFF = 5632, NQKV = 6144, NIN = 6150, NMOD = 6 * D;
constexpr int PB = 4, PT = 8192, SB = 8, ST = 32, PAST = 1024, AWIN = 512;
constexpr int HA = 4, HB = 6, HC = 6;
constexpr int MP = PB * PT, MS = SB * ST, MT = MP + MS;
constexpr int LDQ = NQKV;
constexpr float EPS = 1e-6f;
constexpr float ATT_SCALE = 0.08838834764831845f, INV_SCALE = 11.313708498984761f, LOG2E = 1.4426950408889634f, LN2 = 0.6931471805599453f;
constexpr int NMIDX = PB + SB;

constexpr size_t O_Y_P = 0;
constexpr size_t O_Y_S = O_Y_P + (size_t)MP * D;
constexpr size_t O_AK_P = O_Y_S + (size_t)MS * D;
constexpr size_t SZ_A_P = (size_t)2 * PB * AWIN * HA * HD, SZ_B_P = (size_t)2 * PB * PT * HB * HD, SZ_LF_P = (size_t)2 * PB * PT * HB;
constexpr size_t SZ_A_S = (size_t)2 * SB * ST * HA * HD, SZ_B_S = (size_t)2 * SB * ST * HB * HD, SZ_LF_S = (size_t)2 * SB * ST * HB;
constexpr size_t O_AV_P = O_AK_P + SZ_A_P, O_BK_P = O_AV_P + SZ_A_P, O_BV_P = O_BK_P + SZ_B_P, O_BLF_P = O_BV_P + SZ_B_P, O_CK_P = O_BLF_P + SZ_LF_P, O_CV_P = O_CK_P + SZ_B_P;
constexpr size_t O_AK_S = O_CV_P + SZ_B_P, O_AV_S = O_AK_S + SZ_A_S, O_BK_S = O_AV_S + SZ_A_S, O_BV_S = O_BK_S + SZ_B_S, O_BLF_S = O_BV_S + SZ_B_S, O_CK_S = O_BLF_S + SZ_LF_S, O_CV_S = O_CK_S + SZ_B_S;
constexpr size_t O_END = O_CV_S + SZ_B_S;

constexpr size_t MiB = 1u << 20;
constexpr size_t WS_CTL = 0, CTL_ZERO_BYTES = 4 * MiB;
constexpr size_t WS_MOD = 2 * MiB;
constexpr size_t SZ_WIN = (size_t)NQKV * D * 2, SZ_WO = (size_t)D * D * 2, SZ_WGU = (size_t)2 * DFF * D * 2, SZ_WDN = (size_t)D * DFF * 2;
constexpr size_t WS_WIN = 4 * MiB, WS_WO = WS_WIN + 2 * SZ_WIN, WS_WGU = WS_WO + 2 * SZ_WO, WS_WDN = WS_WGU + 2 * SZ_WGU;
constexpr size_t WS_H = WS_WDN + 2 * SZ_WDN;
constexpr size_t WS_QKV = WS_H + (size_t)MT * D * 2;
constexpr size_t WS_CACHE = WS_QKV + (size_t)MT * NQKV * 2;
constexpr size_t SZ_CA = (size_t)2 * SB * AWIN * HA * HD * 2, SZ_CB = (size_t)2 * SB * PAST * HB * HD * 2;
constexpr size_t WS_CAK = WS_CACHE, WS_CAV = WS_CAK + SZ_CA, WS_CBK = WS_CAV + SZ_CA, WS_CBV = WS_CBK + SZ_CB, WS_CCK = WS_CBV + SZ_CB, WS_CCV = WS_CCK + SZ_CB;
constexpr size_t WS_FP = WS_CCV + SZ_CB;
constexpr size_t WS_FS = WS_FP + (size_t)PB * PT * HB * 4;
constexpr size_t WS_END = WS_FS + (size_t)SB * (PAST + ST) * HB * 4 + 4096;
static_assert((size_t)MT * DFF * 2 <= (size_t)MT * NQKV * 2, "ACT overlays QKV");
constexpr int CW_TMO = 0, CW_BAR = 4096, CW_QUEUE = 16384;

constexpr int RING_OFF = 0, RING_BYTES = 131072;
constexpr int MISC_OFF = RING_BYTES;
constexpr int LDS_BYTES = 147456;

#define LDS_WAIT() asm volatile("s_waitcnt lgkmcnt(0)" ::: "memory")
#define VM_WAIT() asm volatile("s_waitcnt vmcnt(0)" ::: "memory")
__device__ __forceinline__ unsigned cvt_pk_bf16(float lo, float hi) { unsigned r; asm volatile("v_cvt_pk_bf16_f32 %0, %1, %2" : "=v"(r) : "v"(lo), "v"(hi)); return r; }
__device__ __forceinline__ float fast_exp2(float x) { return __builtin_amdgcn_exp2f(x); }
__device__ __forceinline__ float fast_log2(float x) { return __builtin_amdgcn_logf(x); }
__device__ __forceinline__ float fast_rcp(float x) { return __builtin_amdgcn_rcpf(x); }
__device__ __forceinline__ float wave_sum(float v) {
#pragma unroll
    for (int o = 1; o < 64; o <<= 1) v += __shfl_xor(v, o);
    return v;
}
namespace pg8 {
#define PG8_LAS __attribute__((address_space(3)))
typedef unsigned short bf16_t;
typedef short bf16x8 __attribute__((ext_vector_type(8)));
typedef float f32x4 __attribute__((ext_vector_type(4)));
typedef unsigned u32x4 __attribute__((ext_vector_type(4)));
constexpr int BM = 256, BK = 64, HALF = 128, HTB = HALF * BK * 2  , STAGE_BYTES = 8 * HTB, NXCD = 8, WGM = 8;

__host__ __device__ __forceinline__ int lds_byte(int r, int c) { const int st = (r >> 4) * 2 + (c >> 5), rr = r & 15, cc = c & 31, ob = rr * 64 + cc * 2; return st * 1024 + (ob ^ (((ob >> 9) & 1) << 5)); }
__host__ __device__ __forceinline__ void stage_rc(int b, int& R, int& C) { const int st = b / 1024, sb = b % 1024, swz = sb ^ (((sb >> 9) & 1) << 5); R = (st >> 1) * 16 + swz / 64; C = (st & 1) * 32 + (swz % 64) / 2; }
__host__ __device__ __forceinline__ int perm32(int rho) { const int n = rho >> 4, i = rho & 15; return 8 * (i >> 2) + 4 * n + (i & 3); }

struct Unit { int pm, pn; };
struct Gemm { const bf16_t* A; const bf16_t* Bt; };

template <int NM, int NN> struct StaticOrder {
    int G, c;
    __host__ __device__ void init(int G_, int c_) { G = G_; c = c_; }
    __host__ __device__ bool next(int i, Unit& u) const {
        constexpr int nM = NM, nN = NN, nwg = NM * NN;
        const int L = i * G + c; if (L >= nwg) return false;
        int wgid = L; { constexpr int q = nwg / NXCD, r = nwg % NXCD; const int xcd = wgid % NXCD, off = wgid / NXCD; wgid = (xcd < r ? xcd * (q + 1) : r * (q + 1) + (xcd - r) * q) + off; }
        constexpr int nig = WGM * nN; const int gid = wgid / nig, fm = gid * WGM, gsz = (nM - fm) < WGM ? (nM - fm) : WGM;
        u.pm = fm + ((wgid % nig) % gsz); u.pn = (wgid % nig) / gsz; return true;
    }
    __device__ __forceinline__ void a_ready(const Unit&) const {}
    __device__ __forceinline__ void done(const Unit&) const {}
};

__device__ __forceinline__ unsigned cvt_pk_bf16(float lo, float hi) { unsigned r; asm volatile("v_cvt_pk_bf16_f32 %0, %1, %2" : "=v"(r) : "v"(lo), "v"(hi)); return r; }

struct EpiQKV {
    static constexpr bool PERM = true, AFTER_DRAIN = false;
    bf16_t* QKV; float* out; int layer;
    __device__ __forceinline__ void operator()(const f32x4 (&acc)[2][2][4][2], const Unit& u, int wr, int wc, int fr, int fq) const {
        const int which = u.pn >> 3;
        const int rl0 = wr * 64 + fr;
        const int d0 = wc * 32 + 8 * fq;
        bf16_t* qbase = QKV + (size_t)(u.pm * BM + rl0) * ::LDQ + u.pn * BM + d0;
        float* fb[2]; int rstride[2]; bool en[2];
#pragma unroll
        for (int bj = 0; bj < 2; ++bj) {
            const int hh = (u.pn & 7) * 2 + bj;
            en[bj] = which != 0; fb[bj] = out; rstride[bj] = 0;
            if (which != 0) {
                const bool isv = which == 2;
                if (u.pm < 128) {
                    const int b = u.pm >> 5, t0 = (u.pm & 31) * 256;
                    if (hh < ::HA) { en[bj] = t0 >= ::PT - ::AWIN; rstride[bj] = ::HA * ::HD;
                        fb[bj] = out + (isv ? ::O_AV_P : ::O_AK_P) + ((size_t)((layer * ::PB + b) * ::AWIN + (t0 - (::PT - ::AWIN))) * ::HA + hh) * ::HD; }
                    else { const int hg = hh < ::HA + ::HB ? hh - ::HA : hh - ::HA - ::HB; rstride[bj] = ::HB * ::HD;
                        const size_t ob = hh < ::HA + ::HB ? (isv ? ::O_BV_P : ::O_BK_P) : (isv ? ::O_CV_P : ::O_CK_P);
                        fb[bj] = out + ob + ((size_t)((layer * ::PB + b) * ::PT + t0) * ::HB + hg) * ::HD; }
                } else {
                    if (hh < ::HA) { rstride[bj] = ::HA * ::HD; fb[bj] = out + (isv ? ::O_AV_S : ::O_AK_S) + ((size_t)(layer * ::MS) * ::HA + hh) * ::HD; }
                    else { const int hg = hh < ::HA + ::HB ? hh - ::HA : hh - ::HA - ::HB; rstride[bj] = ::HB * ::HD;
                        const size_t ob = hh < ::HA + ::HB ? (isv ? ::O_BV_S : ::O_BK_S) : (isv ? ::O_CV_S : ::O_CK_S);
                        fb[bj] = out + ob + ((size_t)(layer * ::MS) * ::HB + hg) * ::HD; }
                }
            }
        }
#pragma unroll
        for (int ai = 0; ai < 2; ++ai)
#pragma unroll
            for (int m = 0; m < 4; ++m) { const int rl = rl0 + ai * HALF + m * 16; bf16_t* rowp = qbase + (size_t)(ai * HALF + m * 16) * ::LDQ;
#pragma unroll
                for (int bj = 0; bj < 2; ++bj) { const f32x4 v0 = acc[ai][bj][m][0], v1 = acc[ai][bj][m][1];
                    u32x4 w; w.x = cvt_pk_bf16(v0[0], v0[1]); w.y = cvt_pk_bf16(v0[2], v0[3]); w.z = cvt_pk_bf16(v1[0], v1[1]); w.w = cvt_pk_bf16(v1[2], v1[3]);
                    *(u32x4*)(rowp + bj * HALF) = w;
                    if (en[bj]) { float* fp = fb[bj] + (size_t)rl * rstride[bj] + d0; *(f32x4*)fp = v0; *(f32x4*)(fp + 4) = v1; } } }
    }
};
struct EpiResid {
    static constexpr bool PERM = false, AFTER_DRAIN = false;
    const float* xin_p; const float* xin_s; float* xout_p; float* xout_s; const float* gate;
    __device__ __forceinline__ void operator()(const f32x4 (&acc)[2][2][4][2], const Unit& u, int wr, int wc, int fr, int fq) const {
        const bool smp = u.pm >= 128;
        const float* xi = smp ? xin_s : xin_p + (size_t)u.pm * BM * ::D; float* xo = smp ? xout_s : xout_p + (size_t)u.pm * BM * ::D;
        const int col0 = u.pn * BM + wc * 32 + 4 * fq;
#pragma unroll
        for (int ai = 0; ai < 2; ++ai)
#pragma unroll
            for (int m = 0; m < 4; ++m) { const int rl = ai * HALF + wr * 64 + m * 16 + fr; const size_t off = (size_t)rl * ::D + col0;
                const int midx = smp ? ::PB + (rl >> 5) : (u.pm >> 5); const float* gp = gate + (size_t)midx * ::NMOD + col0;
#pragma unroll
                for (int bj = 0; bj < 2; ++bj) {
#pragma unroll
                    for (int n = 0; n < 2; ++n) { const f32x4 gv = *(const f32x4*)(gp + bj * HALF + n * 16); const f32x4 xv = *(const f32x4*)(xi + off + bj * HALF + n * 16);
                        *(f32x4*)(xo + off + bj * HALF + n * 16) = xv + gv * acc[ai][bj][m][n]; }
                    asm volatile("" ::: "memory"); } }
    }
};
struct EpiSwiGLU {
    static constexpr bool PERM = true, AFTER_DRAIN = false;
    bf16_t* ACT;
    __device__ __forceinline__ void operator()(const f32x4 (&acc)[2][2][4][2], const Unit& u, int wr, int wc, int fr, int fq) const {
        bf16_t* base = ACT + (size_t)(u.pm * BM + wr * 64 + fr) * ::DFF + u.pn * HALF + wc * 32 + 8 * fq;
#pragma unroll
        for (int ai = 0; ai < 2; ++ai)
#pragma unroll
            for (int m = 0; m < 4; ++m) { float r[8];
#pragma unroll
                for (int n = 0; n < 2; ++n)
#pragma unroll
                    for (int j = 0; j < 4; ++j) { const float g = acc[ai][0][m][n][j], up = acc[ai][1][m][n][j];
                        r[4 * n + j] = g * __builtin_amdgcn_rcpf(1.0f + __builtin_amdgcn_exp2f(-g * ::LOG2E)) * up; }
                u32x4 w; w.x = cvt_pk_bf16(r[0], r[1]); w.y = cvt_pk_bf16(r[2], r[3]); w.z = cvt_pk_bf16(r[4], r[5]); w.w = cvt_pk_bf16(r[6], r[7]);
                *(u32x4*)(base + (size_t)(ai * HALF + m * 16) * ::DFF) = w; }
    }
};

template <class Epi, class Sched, bool ALIGN_EPI, bool SP2, int KK, int LDA>
__device__ __forceinline__ void gemm_phase(PG8_LAS unsigned char* lds, const Gemm g, const Sched& S, const Epi& E) {
    int tid = threadIdx.x; asm volatile("" : "+v"(tid));
    const int wid = __builtin_amdgcn_readfirstlane(tid >> 6), lane = tid & 63, wr = wid >> 2, wc = wid & 3, fr = lane & 15, fq = lane >> 4;
    constexpr int K = KK, nt = K / BK, lda = LDA;
    unsigned voffA[2], voffB[2];
#pragma unroll
    for (int i = 0; i < 2; ++i) { int R, C; stage_rc(tid * 16 + i * 8192, R, C); const int Rb = Epi::PERM ? ((R & ~31) + perm32(R & 31)) : R;
        voffA[i] = (unsigned)(R * lda + C) * 2u; voffB[i] = (unsigned)(Rb * K + C) * 2u; }
    constexpr size_t kstep = (size_t)(BK * 2);
    constexpr size_t hstepA = (size_t)HALF * lda * 2, hstepB = (size_t)HALF * K * 2;
    constexpr size_t tstepA = 2 * hstepA, tstepB = 2 * hstepB;
    const unsigned ldsw = (unsigned)wid * 1024u;
    const int aoff = lds_byte(wr * 64 + fr, fq * 8), boff = lds_byte(wc * 32 + fr, fq * 8);
#define PG8_SA(b, h) (((b) * 2 + (h)) * HTB)
#define PG8_SB(b, h) ((4 + (b) * 2 + (h)) * HTB)
#define PG8_STAGE(bufoff, gbase, voff) do { _Pragma("unroll") for (int _i = 0; _i < 2; ++_i) \
        __builtin_amdgcn_global_load_lds((const unsigned*)((const char*)(gbase) + (voff)[_i]), (PG8_LAS unsigned*)(lds + (bufoff) + ldsw + _i * 8192), 16, 0, 0); } while (0)
#define PG8_LDA(dst, b, h) do { _Pragma("unroll") for (int m = 0; m < 4; ++m) _Pragma("unroll") for (int k = 0; k < 2; ++k) dst[m][k] = *(const PG8_LAS bf16x8*)(lds + PG8_SA(b, h) + aoff + m * 2048 + k * 1024); } while (0)
#define PG8_LDB(dst, b, h) do { _Pragma("unroll") for (int n = 0; n < 2; ++n) _Pragma("unroll") for (int k = 0; k < 2; ++k) dst[n][k] = *(const PG8_LAS bf16x8*)(lds + PG8_SB(b, h) + boff + n * 2048 + k * 1024); } while (0)
#define PG8_MMA(ai, bj, At, Bt) do { __builtin_amdgcn_s_setprio(1); _Pragma("unroll") for (int m = 0; m < 4; ++m) _Pragma("unroll") for (int n = 0; n < 2; ++n) _Pragma("unroll") for (int k = 0; k < 2; ++k) \
        acc[ai][bj][m][n] = __builtin_amdgcn_mfma_f32_16x16x32_bf16(Bt[n][k], At[m][k], acc[ai][bj][m][n], 0, 0, 0); __builtin_amdgcn_s_setprio(0); } while (0)
#define PG8_WAIT_V(n) asm volatile("s_waitcnt vmcnt(" #n ")" ::: "memory")
#define PG8_WAIT_L(n) asm volatile("s_waitcnt lgkmcnt(" #n ")" ::: "memory")
#define PG8_BAR __builtin_amdgcn_s_barrier()
#define PG8_SCHED __builtin_amdgcn_sched_barrier(0)
    Unit cur, nxt; int ui = 0;
    if (!S.next(0, cur)) return;
    f32x4 acc[2][2][4][2];
#pragma unroll
    for (int a = 0; a < 2; ++a)
#pragma unroll
        for (int b = 0; b < 2; ++b)
#pragma unroll
            for (int m = 0; m < 4; ++m)
#pragma unroll
                for (int n = 0; n < 2; ++n) acc[a][b][m][n] = (f32x4){0.f, 0.f, 0.f, 0.f};
    bf16x8 At[4][2], B0[2][2], B1[2][2];
    const char* cA = (const char*)g.A + (size_t)cur.pm * tstepA; const char* cB = (const char*)g.Bt + (size_t)cur.pn * tstepB;
    S.a_ready(cur);
    if constexpr (SP2) {
        PG8_STAGE(PG8_SB(0, 0), cB, voffB); PG8_STAGE(PG8_SB(0, 1), cB + hstepB, voffB); PG8_STAGE(PG8_SA(0, 0), cA, voffA); PG8_STAGE(PG8_SA(0, 1), cA + hstepA, voffA);
        if (wr == 1) PG8_BAR;
        PG8_WAIT_V(2); PG8_BAR;
        PG8_STAGE(PG8_SB(1, 0), cB + kstep, voffB); PG8_STAGE(PG8_SA(1, 0), cA + kstep, voffA); PG8_STAGE(PG8_SB(1, 1), cB + hstepB + kstep, voffB);
        PG8_WAIT_V(6); PG8_BAR;
    } else {
        PG8_STAGE(PG8_SB(0, 0), cB, voffB); PG8_STAGE(PG8_SA(0, 0), cA, voffA); PG8_STAGE(PG8_SB(0, 1), cB + hstepB, voffB); PG8_STAGE(PG8_SA(0, 1), cA + hstepA, voffA);
        if (wr == 1) PG8_BAR;
        PG8_WAIT_V(4); PG8_BAR;
        PG8_STAGE(PG8_SB(1, 0), cB + kstep, voffB); PG8_STAGE(PG8_SA(1, 0), cA + kstep, voffA); PG8_STAGE(PG8_SB(1, 1), cB + hstepB + kstep, voffB);
        PG8_WAIT_V(6); PG8_BAR;
    }
    for (;;) {
        const bool has_next = S.next(ui + 1, nxt);
        const char* nA = has_next ? (const char*)g.A + (size_t)nxt.pm * tstepA : cA; const char* nB = has_next ? (const char*)g.Bt + (size_t)nxt.pn * tstepB : cB;
        for (int t = 0; t < nt; t += 2) {
            const bool last = (t == nt - 2);
            const char* a1 = cA + (size_t)(t + 1) * kstep;
            const char* a2 = last ? nA : cA + (size_t)(t + 2) * kstep; const char* b2 = last ? nB : cB + (size_t)(t + 2) * kstep;
            const char* a3 = a2 + kstep; const char* b3 = b2 + kstep;
            if (last && has_next) S.a_ready(nxt);
            if constexpr (SP2) {
            PG8_LDB(B0, 0, 0); PG8_LDB(B1, 0, 1); PG8_SCHED; PG8_LDA(At, 0, 0); PG8_STAGE(PG8_SA(1, 1), a1 + hstepA, voffA);
            PG8_WAIT_V(8); PG8_WAIT_L(0); PG8_BAR; PG8_MMA(0, 0, At, B0); PG8_MMA(0, 1, At, B1); PG8_BAR; PG8_SCHED;
            PG8_LDA(At, 0, 1); PG8_STAGE(PG8_SB(0, 0), b2, voffB); PG8_STAGE(PG8_SB(0, 1), b2 + hstepB, voffB); PG8_STAGE(PG8_SA(0, 0), a2, voffA);
            PG8_WAIT_V(8); PG8_WAIT_L(0); PG8_BAR; PG8_MMA(1, 0, At, B0); PG8_MMA(1, 1, At, B1); PG8_BAR; PG8_SCHED;
            PG8_LDB(B0, 1, 0); PG8_LDB(B1, 1, 1); PG8_SCHED; PG8_LDA(At, 1, 0); PG8_STAGE(PG8_SA(0, 1), a2 + hstepA, voffA);
            PG8_WAIT_V(8); PG8_WAIT_L(0); PG8_BAR; PG8_MMA(0, 0, At, B0); PG8_MMA(0, 1, At, B1); PG8_BAR; PG8_SCHED;
            PG8_LDA(At, 1, 1); PG8_STAGE(PG8_SB(1, 0), b3, voffB); PG8_STAGE(PG8_SB(1, 1), b3 + hstepB, voffB); PG8_STAGE(PG8_SA(1, 0), a3, voffA);
            PG8_WAIT_V(8); PG8_WAIT_L(0); PG8_BAR; PG8_MMA(1, 0, At, B0); PG8_MMA(1, 1, At, B1); PG8_BAR; PG8_SCHED;
            } else {
            PG8_LDB(B0, 0, 0); PG8_SCHED; PG8_LDA(At, 0, 0); PG8_STAGE(PG8_SA(1, 1), a1 + hstepA, voffA);
            PG8_WAIT_L(8); PG8_BAR; PG8_WAIT_L(0); PG8_MMA(0, 0, At, B0); PG8_BAR; PG8_SCHED;
            PG8_LDB(B1, 0, 1); PG8_STAGE(PG8_SB(0, 0), b2, voffB);
            PG8_BAR; PG8_WAIT_L(0); PG8_MMA(0, 1, At, B1); PG8_BAR;
            PG8_LDA(At, 0, 1); PG8_STAGE(PG8_SA(0, 0), a2, voffA);
            PG8_BAR; PG8_WAIT_L(0); PG8_MMA(1, 0, At, B0); PG8_BAR; PG8_SCHED;
            PG8_STAGE(PG8_SB(0, 1), b2 + hstepB, voffB);
            PG8_WAIT_V(6); PG8_BAR; PG8_MMA(1, 1, At, B1); PG8_BAR;
            PG8_LDB(B0, 1, 0); PG8_SCHED; PG8_LDA(At, 1, 0); PG8_STAGE(PG8_SA(0, 1), a2 + hstepA, voffA);
            PG8_WAIT_L(8); PG8_BAR; PG8_WAIT_L(0); PG8_MMA(0, 0, At, B0); PG8_BAR; PG8_SCHED;
            PG8_LDB(B1, 1, 1); PG8_STAGE(PG8_SB(1, 0), b3, voffB);
            PG8_BAR; PG8_WAIT_L(0); PG8_MMA(0, 1, At, B1); PG8_BAR;
            PG8_LDA(At, 1, 1); PG8_STAGE(PG8_SA(1, 0), a3, voffA);
            PG8_BAR; PG8_WAIT_L(0); PG8_MMA(1, 0, At, B0); PG8_BAR; PG8_SCHED;
            PG8_STAGE(PG8_SB(1, 1), b3 + hstepB, voffB);
            PG8_WAIT_V(6); PG8_BAR; PG8_MMA(1, 1, At, B1); PG8_BAR;
            }
        }
        if constexpr (ALIGN_EPI) { if (wr == 0) PG8_BAR; }
        if constexpr (!Epi::AFTER_DRAIN) { E(acc, cur, wr, wc, fr, fq); S.done(cur); }
        if (!has_next) break;
#pragma unroll
        for (int a = 0; a < 2; ++a)
#pragma unroll
            for (int b = 0; b < 2; ++b)
#pragma unroll
                for (int m = 0; m < 4; ++m)
#pragma unroll
                    for (int n = 0; n < 2; ++n) acc[a][b][m][n] = (f32x4){0.f, 0.f, 0.f, 0.f};
        cur = nxt; cA = nA; cB = nB; ++ui;
        if constexpr (ALIGN_EPI) { if (wr == 1) PG8_BAR; }
    }
    PG8_WAIT_V(0);
    if constexpr (!ALIGN_EPI) { if (wr == 0) PG8_BAR; }
    PG8_BAR;
    if constexpr (Epi::AFTER_DRAIN) { E.fused(acc, cur, wr, wc, fr, fq, lds, wid, lane); S.done(cur); }
#undef PG8_SA
#undef PG8_SB
#undef PG8_STAGE
#undef PG8_LDA
#undef PG8_LDB
#undef PG8_MMA
#undef PG8_WAIT_V
#undef PG8_WAIT_L
#undef PG8_BAR
#undef PG8_SCHED
}
}

#define XB_TMO      128
#define XB_XCNT(j)  (256  + 64 * (j))
#define XB_XSUB(j)  (1280 + 64 * (j))
#define XB_XGEN(j)  (2304 + 64 * (j))
#define XB_TOP      3328
#define XB_TOPGEN   3392
#define XCD_BAR_WORDS 3456
#define XB_SPIN_CAP (1u << 18)

__device__ __forceinline__ unsigned xb_ld(unsigned* p)              { return __hip_atomic_load(p, __ATOMIC_RELAXED, __HIP_MEMORY_SCOPE_AGENT); }
__device__ __forceinline__ unsigned xb_add(unsigned* p, unsigned v) { return __hip_atomic_fetch_add(p, v, __ATOMIC_RELAXED, __HIP_MEMORY_SCOPE_AGENT); }
__device__ __forceinline__ unsigned xb_xcc_id() { return (unsigned)__builtin_amdgcn_s_getreg((3 << 11) | 20) & 0xFu; }
#define XB_SPIN(cond, bar) do { unsigned _sp = 0; while (cond) { __builtin_amdgcn_s_sleep(1); \
    if ((++_sp & 255u) == 0u) { if (xb_ld(&(bar)[XB_TMO])) break; if (_sp > XB_SPIN_CAP) { atomicAdd(&(bar)[XB_TMO], 1u); break; } } } } while (0)

struct XcdBarrier {
    unsigned* bar; unsigned x;
    volatile LAS unsigned* st;
};

__device__ __forceinline__ XcdBarrier xcd_barrier_post(unsigned* bar, volatile LAS unsigned* st) {
    XcdBarrier b; b.bar = bar; b.x = xb_xcc_id(); b.st = st;
    if (threadIdx.x == 0) (void)xb_add(&bar[XB_XCNT(b.x)], 1u);
    return b;
}
__device__ __forceinline__ void xcd_barrier_complete(unsigned* bar, unsigned x, unsigned& nloc, unsigned& nx) {
    const unsigned G = gridDim.x * gridDim.y * gridDim.z;
    unsigned sum, cnt, mine, sp = 0u;
    for (;;) {
        sum = 0u; cnt = 0u; mine = 0u;
#pragma unroll
        for (unsigned j = 0; j < 16; ++j) { const unsigned c = xb_ld(&bar[XB_XCNT(j)]); sum += c; cnt += (c > 0u) ? 1u : 0u; mine = (j == x) ? c : mine; }
        if (sum == G) break;
        __builtin_amdgcn_s_sleep(1);
        if ((++sp & 255u) == 0u) { if (xb_ld(&bar[XB_TMO])) break; if (sp > XB_SPIN_CAP) { atomicAdd(&bar[XB_TMO], 1u); break; } }
    }
    nloc = mine > 0u ? mine : 1u; nx = cnt > 0u ? cnt : 1u;
}

__device__ __forceinline__ void xcd_barrier(const XcdBarrier& b) {
    asm volatile("s_waitcnt vmcnt(0)" ::: "memory");
    __syncthreads();
    if (threadIdx.x == 0) {
        unsigned* bar = b.bar;
        __builtin_amdgcn_s_waitcnt(0);
        unsigned nloc = b.st[0], nx = b.st[1];
        unsigned bx = b.x; asm volatile("" : "+s"(bx));
        if (nloc == 0u) { xcd_barrier_complete(bar, bx, nloc, nx); b.st[0] = nloc; b.st[1] = nx; }
        const unsigned old = xb_add(&bar[XB_XSUB(bx)], 1u);
        const unsigned gen = old / nloc;
        if (old + 1u == (gen + 1u) * nloc) {
            __builtin_amdgcn_fence(__ATOMIC_RELEASE, "agent");
            asm volatile("s_waitcnt vmcnt(0)" ::: "memory");
            const unsigned og = xb_add(&bar[XB_TOP], 1u);
            const unsigned tg = og / nx;
            if (og + 1u == (tg + 1u) * nx) xb_add(&bar[XB_TOPGEN], 1u);
            else XB_SPIN(xb_ld(&bar[XB_TOPGEN]) == tg, bar);
            __builtin_amdgcn_fence(__ATOMIC_ACQUIRE, "agent");
            xb_add(&bar[XB_XGEN(bx)], 1u);
            asm volatile("s_waitcnt vmcnt(0)" ::: "memory");
        } else {
            XB_SPIN(xb_ld(&bar[XB_XGEN(bx)]) == gen, bar);
            __builtin_amdgcn_fence(__ATOMIC_ACQUIRE, "agent");
            asm volatile("s_waitcnt vmcnt(0)" ::: "memory");
        }
    }
    __syncthreads();
}
struct Params {
    const float* in[23];
    float* out;
    unsigned char* ws;
};

struct Ctx {
    LAS unsigned char* lds;
    int tid, lane, wave, G, blk;
};

__device__ __forceinline__ void transpose_item(const float* W, int ld, bf16* WT, int Kd, int k0, int n0, int drow0, LAS float* scr, int lane) {
#pragma unroll 8
    for (int i = 0; i < 32; ++i) { const int kk = 2 * i + (lane >> 5); scr[kk * 33 + (lane & 31)] = W[(size_t)(k0 + kk) * ld + n0 + (lane & 31)]; }
    LDS_WAIT(); asm volatile("" ::: "memory");
    const int c = lane & 7;
#pragma unroll
    for (int j = 0; j < 4; ++j) { const int n = (lane >> 3) + 8 * j; const LAS float* s = scr + (8 * c) * 33 + n;
        u32x4 o; o.x = cvt_pk_bf16(s[0 * 33], s[1 * 33]); o.y = cvt_pk_bf16(s[2 * 33], s[3 * 33]); o.z = cvt_pk_bf16(s[4 * 33], s[5 * 33]); o.w = cvt_pk_bf16(s[6 * 33], s[7 * 33]);
        *(u32x4*)(WT + (size_t)(drow0 + n) * Kd + k0 + 8 * c) = o; }
    LDS_WAIT(); asm volatile("" ::: "memory");
}

__device__ __forceinline__ void cvt_copy(const float* src, bf16* dst, size_t n8, size_t i0, size_t stride) {
    for (size_t i = i0; i < n8; i += stride) { const f32x4 a = *(const f32x4*)(src + i * 8), b = *(const f32x4*)(src + i * 8 + 4);
        u32x4 o; o.x = cvt_pk_bf16(a[0], a[1]); o.y = cvt_pk_bf16(a[2], a[3]); o.z = cvt_pk_bf16(b[0], b[1]); o.w = cvt_pk_bf16(b[2], b[3]);
        *(u32x4*)(dst + i * 8) = o; }
}

__device__ __forceinline__ void p0_prologue(const Params& P, const Ctx& C) {
    unsigned char* ws = P.ws;
    {
        LAS float* scr = (LAS float*)(C.lds + RING_OFF + C.wave * 16384);
        const int gw = C.blk * 8 + C.wave, NGW = C.G * 8;
        constexpr int I_IN = (D / 64) * (NQKV / 32), I_O = (D / 64) * (D / 32), I_G = (D / 64) * (DFF / 32), I_D = (DFF / 64) * (D / 32);
        constexpr int I_L = I_IN + I_O + 2 * I_G + I_D;
        for (int it = gw; it < 2 * I_L; it += NGW) {
            const int l = it / I_L; int r = it % I_L;
            if (r < I_IN) { const int nb = NQKV / 32, kb = r / nb, n0 = (r % nb) * 32;
                transpose_item(P.in[15] + (size_t)l * D * NIN, NIN, (bf16*)(ws + WS_WIN + l * SZ_WIN), D, kb * 64, n0, n0, scr, C.lane); continue; }
            r -= I_IN;
            if (r < I_O) { const int nb = D / 32, kb = r / nb, n0 = (r % nb) * 32;
                transpose_item(P.in[18] + (size_t)l * D * D, D, (bf16*)(ws + WS_WO + l * SZ_WO), D, kb * 64, n0, n0, scr, C.lane); continue; }
            r -= I_O;
            if (r < 2 * I_G) { const int up = r >= I_G; if (up) r -= I_G; const int nb = DFF / 32, kb = r / nb, n0 = (r % nb) * 32;
                const int drow0 = (n0 >> 7) * 256 + (n0 & 127) + (up ? 128 : 0);
                transpose_item(P.in[up ? 20 : 19] + (size_t)l * D * DFF, DFF, (bf16*)(ws + WS_WGU + l * SZ_WGU), D, kb * 64, n0, drow0, scr, C.lane); continue; }
            r -= 2 * I_G;
            { const int nb = D / 32, kb = r / nb, n0 = (r % nb) * 32;
                transpose_item(P.in[21] + (size_t)l * DFF * D, D, (bf16*)(ws + WS_WDN + l * SZ_WDN), DFF, kb * 64, n0, n0, scr, C.lane); }
        }
    }
    {
        const size_t i0 = (size_t)C.blk * 512 + C.tid, stride = (size_t)C.G * 512;
        cvt_copy(P.in[2], (bf16*)(ws + WS_CAK), SZ_CA / 16, i0, stride); cvt_copy(P.in[3], (bf16*)(ws + WS_CAV), SZ_CA / 16, i0, stride);
        cvt_copy(P.in[4], (bf16*)(ws + WS_CBK), SZ_CB / 16, i0, stride); cvt_copy(P.in[5], (bf16*)(ws + WS_CBV), SZ_CB / 16, i0, stride);
        cvt_copy(P.in[7], (bf16*)(ws + WS_CCK), SZ_CB / 16, i0, stride); cvt_copy(P.in[8], (bf16*)(ws + WS_CCV), SZ_CB / 16, i0, stride);
    }
    {
        __syncthreads();
        LAS float* st = (LAS float*)(C.lds + RING_OFF);
        for (int idx = C.tid; idx < NMIDX * D; idx += 512) { const int m = idx / D, k = idx % D;
            const float c = m < PB ? P.in[9][m * D + k] : P.in[10][(m - PB) * D + k];
            st[k * NMIDX + m] = c * fast_rcp(1.0f + fast_exp2(-c * LOG2E)); }
        __syncthreads();
        float* mod = (float*)(ws + WS_MOD);
        constexpr int KC = 256, NKC = D / KC, NNC = NMOD / 256;
        for (int it = C.wave * C.G + C.blk; it < 2 * NKC * NNC; it += 8 * C.G) {
            const int l = it / (NKC * NNC), r = it % (NKC * NNC), kc = r / NNC, nc = r % NNC, k0 = kc * KC, n0 = nc * 256 + C.lane * 4;
            const float* wp = P.in[11] + ((size_t)l * D + k0) * NMOD + n0;
            f32x4 acc[NMIDX];
#pragma unroll
            for (int m = 0; m < NMIDX; ++m) acc[m] = (f32x4){0.f, 0.f, 0.f, 0.f};
#pragma unroll 4
            for (int k = 0; k < KC; ++k) { const f32x4 w = *(const f32x4*)(wp + (size_t)k * NMOD);
                const LAS f32x4* sp = (const LAS f32x4*)(st + (k0 + k) * NMIDX); const f32x4 s0 = sp[0], s1 = sp[1], s2 = sp[2];
                acc[0] += w * s0[0]; acc[1] += w * s0[1]; acc[2] += w * s0[2]; acc[3] += w * s0[3];
                acc[4] += w * s1[0]; acc[5] += w * s1[1]; acc[6] += w * s1[2]; acc[7] += w * s1[3];
                acc[8] += w * s2[0]; acc[9] += w * s2[1]; acc[10] += w * s2[2]; acc[11] += w * s2[3]; }
            f32x4 bias = (f32x4){0.f, 0.f, 0.f, 0.f};
            if (kc == 0) bias = *(const f32x4*)(P.in[12] + (size_t)l * NMOD + n0);
#pragma unroll
            for (int m = 0; m < NMIDX; ++m) { float* mp = mod + ((size_t)l * NMIDX + m) * NMOD + n0;
#pragma unroll
                for (int j = 0; j < 4; ++j) __hip_atomic_fetch_add(mp + j, acc[m][j] + bias[j], __ATOMIC_RELAXED, __HIP_MEMORY_SCOPE_AGENT); }
        }
    }
}

template <bool WITH_LOGF>
__device__ __forceinline__ void norm_rows(const Ctx& C, const float* xrows, bf16* hrows, int nrows, const float* gvec, const float* shift, const float* scale,
                                          const LAS float* wf, const float* bf, float* lf_out) {
    f32x4 gm[8], sh[8];
#pragma unroll
    for (int j = 0; j < 8; ++j) { const int e = 4 * C.lane + 256 * j; const f32x4 g = *(const f32x4*)(gvec + e), sc = *(const f32x4*)(scale + e); sh[j] = *(const f32x4*)(shift + e); gm[j] = g * (sc + 1.0f); }
    for (int r = 0; r < nrows; ++r) {
        const float* xr = xrows + (size_t)r * D; f32x4 v[8]; float ss = 0.f;
#pragma unroll
        for (int j = 0; j < 8; ++j) { v[j] = *(const f32x4*)(xr + 4 * C.lane + 256 * j); ss += (v[j][0] * v[j][0] + v[j][1] * v[j][1]) + (v[j][2] * v[j][2] + v[j][3] * v[j][3]); }
        const float rstd = 1.0f / sqrtf(wave_sum(ss) * (1.0f / D) + EPS);
#pragma unroll
        for (int j = 0; j < 8; ++j) v[j] = v[j] * rstd * gm[j] + sh[j];
        bf16* hr = hrows + (size_t)r * D;
#pragma unroll
        for (int j = 0; j < 8; ++j) { u32x2 w; w.x = cvt_pk_bf16(v[j][0], v[j][1]); w.y = cvt_pk_bf16(v[j][2], v[j][3]); *(u32x2*)(hr + 4 * C.lane + 256 * j) = w; }
        if constexpr (WITH_LOGF) {
            float dots[6];
#pragma unroll
            for (int f = 0; f < 6; ++f) { float a = 0.f;
#pragma unroll
                for (int j = 0; j < 8; ++j) { const f32x4 w = *(const LAS f32x4*)(wf + f * D + 4 * C.lane + 256 * j); a += (v[j][0] * w[0] + v[j][1] * w[1]) + (v[j][2] * w[2] + v[j][3] * w[3]); }
                dots[f] = wave_sum(a); }
            if (C.lane < 6) { float z = C.lane == 0 ? dots[0] : C.lane == 1 ? dots[1] : C.lane == 2 ? dots[2] : C.lane == 3 ? dots[3] : C.lane == 4 ? dots[4] : dots[5];
                z += bf[C.lane];
                const float ls = fminf(z, 0.f) - LN2 * fast_log2(1.0f + fast_exp2(-fabsf(z) * LOG2E));
                lf_out[(size_t)r * HB + C.lane] = ls; }
        }
    }
}

template <bool WITH_LOGF>
__device__ __forceinline__ void norm_phase(const Params& P, const Ctx& C, int layer, const float* xp, const float* xs, const float* gvec, int off_shift, int off_scale) {
    bf16* H = (bf16*)(P.ws + WS_H); const float* mod = (const float*)(P.ws + WS_MOD) + (size_t)layer * NMIDX * NMOD;
    LAS float* wf = (LAS float*)(C.lds + RING_OFF);
    if constexpr (WITH_LOGF) {
        const float* win = P.in[15] + (size_t)layer * D * NIN + NQKV;
        for (int idx = C.tid; idx < 6 * D; idx += 512) { const int k = idx / 6, f = idx % 6; wf[f * D + k] = win[(size_t)k * NIN + f]; }
        __syncthreads();
    }
    const float* bf = P.in[16] + layer * HB;
    float* lfp = P.out + O_BLF_P + (size_t)layer * PB * PT * HB; float* lfs = P.out + O_BLF_S + (size_t)layer * MS * HB;
    const int gw = C.blk * 8 + C.wave, NGW = C.G * 8;
    for (int it = gw; it < MP / 16; it += NGW) { const int r0 = it * 16, b = r0 >> 13; const float* mv = mod + (size_t)b * NMOD;
        norm_rows<WITH_LOGF>(C, xp + (size_t)r0 * D, H + (size_t)r0 * D, 16, gvec, mv + off_shift, mv + off_scale, wf, bf, lfp + (size_t)r0 * HB); }
    if (C.wave == 0) for (int r = C.blk; r < MS; r += C.G) { const float* mv = mod + (size_t)(PB + (r >> 5)) * NMOD;
        norm_rows<WITH_LOGF>(C, xs + (size_t)r * D, H + (size_t)(MP + r) * D, 1, gvec, mv + off_shift, mv + off_scale, wf, bf, lfs + (size_t)r * HB); }
    __syncthreads();
}

__device__ __forceinline__ void final_norm(const Params& P, const Ctx& C) {
    const float* g = P.in[22]; f32x4 gm[8];
#pragma unroll
    for (int j = 0; j < 8; ++j) gm[j] = *(const f32x4*)(g + 4 * C.lane + 256 * j);
    const int gw = C.blk * 8 + C.wave, NGW = C.G * 8;
    for (int r = gw; r < MT; r += NGW) {
        float* xr = P.out + (size_t)r * D; f32x4 v[8]; float ss = 0.f;
#pragma unroll
        for (int j = 0; j < 8; ++j) { v[j] = *(const f32x4*)(xr + 4 * C.lane + 256 * j); ss += (v[j][0] * v[j][0] + v[j][1] * v[j][1]) + (v[j][2] * v[j][2] + v[j][3] * v[j][3]); }
        const float rstd = 1.0f / sqrtf(wave_sum(ss) * (1.0f / D) + EPS);
#pragma unroll
        for (int j = 0; j < 8; ++j) *(f32x4*)(xr + 4 * C.lane + 256 * j) = v[j] * rstd * gm[j];
    }
}


__device__ __forceinline__ float block_excl_scan(const Ctx& C, LAS float* red, float s) {
    float incl = s;
#pragma unroll
    for (int o = 1; o < 64; o <<= 1) { const float t = __shfl_up(incl, o); if (C.lane >= o) incl += t; }
    if (C.lane == 63) red[C.wave] = incl;
    __syncthreads();
    float base = 0.f;
    for (int w = 0; w < C.wave; ++w) base += red[w];
    return base + incl - s;
}

__device__ __forceinline__ void fcum_phase(const Params& P, const Ctx& C, int layer) {
    LAS float* red = (LAS float*)(C.lds + RING_OFF);
    if (C.blk < PB * HB) {
        const int b = C.blk / HB, h = C.blk % HB; const float* lf = P.out + O_BLF_P + ((size_t)(layer * PB + b) * PT) * HB + h;
        float* F = (float*)(P.ws + WS_FP) + ((size_t)b * PT) * HB + h;
        float v[16]; float s = 0.f;
#pragma unroll
        for (int i = 0; i < 16; ++i) { v[i] = lf[(size_t)(C.tid * 16 + i) * HB]; s += v[i]; }
        float a = block_excl_scan(C, red, s);
#pragma unroll
        for (int i = 0; i < 16; ++i) { a += v[i]; F[(size_t)(C.tid * 16 + i) * HB] = a; }
        __syncthreads();
    } else if (C.blk < PB * HB + SB * HB) {
        const int q = C.blk - PB * HB, sb = q / HB, h = q % HB; constexpr int L = PAST + ST;
        const float* cl = P.in[6] + ((size_t)(layer * SB + sb) * PAST) * HB + h; const float* nl = P.out + O_BLF_S + ((size_t)(layer * SB + sb) * ST) * HB + h;
        float* F = (float*)(P.ws + WS_FS) + ((size_t)sb * L) * HB + h;
        float v[3]; float s = 0.f;
#pragma unroll
        for (int i = 0; i < 3; ++i) { const int p = C.tid * 3 + i; v[i] = p < PAST ? cl[(size_t)p * HB] : (p < L ? nl[(size_t)(p - PAST) * HB] : 0.f); s += v[i]; }
        float a = block_excl_scan(C, red, s);
#pragma unroll
        for (int i = 0; i < 3; ++i) { const int p = C.tid * 3 + i; a += v[i]; if (p < L) F[(size_t)p * HB] = a; }
        __syncthreads();
    }
}

namespace att {
constexpr int KROW = 272, VROW = 144;
constexpr int KBUF = 64 * KROW, VBUF = 128 * VROW;
constexpr int OFF_K = 0, OFF_V = 2 * KBUF, OFF_FB = OFF_V + 2 * VBUF, OFF_REL = OFF_FB + 512, OFF_VOTE = OFF_REL + 1040, OFF_QW = OFF_VOTE + 64;
static_assert(OFF_QW + 16 <= RING_BYTES && (OFF_REL % 16) == 0 && (OFF_VOTE % 16) == 0, "attention LDS map");
constexpr float STICK_STOP = -105.0f;

struct Unit {
    const bf16* q; int nq, qpos0, kv_len, new_pos0;
    const bf16 *kn, *vn, *kc, *vc; int cstride;
    int t_hi, t_lo;
    const float* F; float fref;
    const float* rel;
};

__device__ __forceinline__ float partner32(float x, int hi) {
    auto rr = __builtin_amdgcn_permlane32_swap(__float_as_uint(x), __float_as_uint(x), false, false);
    return __uint_as_float(hi ? rr[0] : rr[1]);
}
__device__ __forceinline__ bf16x8 pack8(float a0, float a1, float a2, float a3, float a4, float a5, float a6, float a7) {
    u32x4 w = {cvt_pk_bf16(a0, a1), cvt_pk_bf16(a2, a3), cvt_pk_bf16(a4, a5), cvt_pk_bf16(a6, a7)};
    return __builtin_bit_cast(bf16x8, w);
}

template <int MODE>
__device__ __forceinline__ void run_unit(LAS unsigned char* lds, const Unit& u, int tid, int wave, int lane) {
    const int qr = lane & 31, hi = lane >> 5;
    const bool active = wave * 32 < u.nq;
    const int qpos_w0 = u.qpos0 + wave * 32, qpos = qpos_w0 + qr;
    int w_hi, w_lo;
    if (MODE == 0) { const int n = qpos_w0 >> 6; w_hi = n; w_lo = n - 8 > 0 ? n - 8 : 0; }
    else if (MODE == 1) { w_hi = (qpos_w0 + 31) >> 6; w_lo = 0; }
    else { w_hi = (qpos_w0 + 30) >> 6; w_lo = 0; }
    const int near_lo = (qpos_w0 >> 6) - 2;
    bf16x8 qf[8];
    { const bf16* qp = u.q + (size_t)((active ? wave * 32 : 0) + qr) * LDQ + 8 * hi;
#pragma unroll
      for (int ds = 0; ds < 8; ++ds) qf[ds] = *(const bf16x8*)(qp + 16 * ds); }
    LAS float* rel_l = (LAS float*)(lds + OFF_REL);
    if (MODE == 0) { for (int i = tid; i < 257; i += 512) rel_l[i] = u.rel[i * HA] * INV_SCALE; }
    f32x16 o[4];
#pragma unroll
    for (int b = 0; b < 4; ++b)
#pragma unroll
        for (int r = 0; r < 16; ++r) o[b][r] = 0.f;
    float m_run = -1e30f, l_run = 0.f, carry = 0.f;
    const int k_key = tid >> 4, k_dc = tid & 15;
    const int k_lds = k_key * KROW + k_dc * 16;
    const int v_dc = lane & 15, v_kq = lane >> 4;
    const int v_key0 = 16 * (wave >> 1) + 4 * (wave & 1) + 2 * (v_kq & 1) + 8 * (v_kq >> 1);
    const int v_pos0 = (v_key0 & ~0xC) | ((v_key0 & 4) << 1) | ((v_key0 & 8) >> 1);
    const int v_lds = (8 * v_dc) * VROW + ((((v_pos0 >> 3) ^ ((v_dc >> 1) & 7))) << 4) + (v_pos0 & 7) * 2;
    const int kr_lds = qr * KROW + hi * 16;
    const int vr_lds = qr * VROW + ((hi ^ (qr >> 4)) << 4);
    u32x4 kreg[2], vreg[2]; float freg = 0.f;
    auto stage_load = [&](int j) {
        const int last = u.kv_len - 1;
#pragma unroll
        for (int i = 0; i < 2; ++i) { int pos = 64 * j + k_key + 32 * i; pos = pos < last ? pos : last;
            const bf16* src = pos >= u.new_pos0 ? u.kn + (size_t)(pos - u.new_pos0) * LDQ : u.kc + (size_t)pos * u.cstride;
            kreg[i] = *(const u32x4*)(src + 8 * k_dc); }
#pragma unroll
        for (int i = 0; i < 2; ++i) { int pos = 64 * j + v_key0 + i; pos = pos < last ? pos : last;
            const bf16* src = pos >= u.new_pos0 ? u.vn + (size_t)(pos - u.new_pos0) * LDQ : u.vc + (size_t)pos * u.cstride;
            vreg[i] = *(const u32x4*)(src + 8 * v_dc); }
        if (MODE == 1 && tid < 64) { int pos = 64 * j + tid; pos = pos < last ? pos : last; freg = (u.fref - u.F[(size_t)pos * HB]) * INV_SCALE; }
    };
    auto stage_store = [&](int buf) {
        LAS unsigned char* kb = lds + OFF_K + buf * KBUF + k_lds;
        *(LAS u32x4*)kb = kreg[0]; *(LAS u32x4*)(kb + 32 * KROW) = kreg[1];
        LAS unsigned char* vb = lds + OFF_V + buf * VBUF + v_lds;
        const unsigned a[4] = {vreg[0].x, vreg[0].y, vreg[0].z, vreg[0].w}, b[4] = {vreg[1].x, vreg[1].y, vreg[1].z, vreg[1].w};
#pragma unroll
        for (int i = 0; i < 4; ++i) {
            *(LAS unsigned*)(vb + (2 * i) * VROW) = (a[i] & 0xffffu) | (b[i] << 16);
            *(LAS unsigned*)(vb + (2 * i + 1) * VROW) = (a[i] >> 16) | (b[i] & 0xffff0000u); }
        if (MODE == 1 && tid < 64) ((LAS float*)(lds + OFF_FB + buf * 256))[tid] = freg;
    };
    stage_load(u.t_hi);
    stage_store(0);
    LDS_WAIT(); __syncthreads();
    bool wave_done = !active;
    for (int j = u.t_hi, it = 0;; --j, ++it) {
        const int cur = it & 1;
        const bool more = j > u.t_lo;
        if (more) stage_load(j - 1);
        if (active && j <= w_hi && j >= w_lo && !(MODE == 2 && wave_done)) {
            f32x16 p0, p1;
            if (MODE == 1) { const LAS f32x4* fb = (const LAS f32x4*)(lds + OFF_FB + cur * 256);
#pragma unroll
                for (int g = 0; g < 4; ++g) { const f32x4 a = fb[2 * g + hi], b = fb[8 + 2 * g + hi];
#pragma unroll
                    for (int i = 0; i < 4; ++i) { p0[4 * g + i] = a[i]; p1[4 * g + i] = b[i]; } } }
            else if (MODE == 0) {
                if (j >= near_lo) { const int base = qpos - 64 * j - 4 * hi + 128;
#pragma unroll
                    for (int r = 0; r < 16; ++r) { const int c = (r & 3) + 8 * (r >> 2); int i0 = base - c, i1 = base - c - 32; i0 = i0 < 256 ? i0 : 256; i1 = i1 < 256 ? i1 : 256;
                        p0[r] = rel_l[i0]; p1[r] = rel_l[i1]; } }
                else { const float cb = rel_l[256];
#pragma unroll
                    for (int r = 0; r < 16; ++r) { p0[r] = cb; p1[r] = cb; } } }
            else {
#pragma unroll
                for (int r = 0; r < 16; ++r) { p0[r] = 0.f; p1[r] = 0.f; } }
            { const LAS unsigned char* kb = lds + OFF_K + cur * KBUF + kr_lds;
#pragma unroll
              for (int ds = 0; ds < 8; ++ds) { const bf16x8 k0 = *(const LAS bf16x8*)(kb + 32 * ds), k1 = *(const LAS bf16x8*)(kb + 32 * KROW + 32 * ds);
                  p0 = __builtin_amdgcn_mfma_f32_32x32x16_bf16(k0, qf[ds], p0, 0, 0, 0); p1 = __builtin_amdgcn_mfma_f32_32x32x16_bf16(k1, qf[ds], p1, 0, 0, 0); } }
            const int kp0 = 64 * j + 4 * hi;
            if (MODE != 2) {
                const bool need_mask = MODE == 1 ? (64 * j + 63 > qpos_w0) : (64 * j + 63 >= u.kv_len);
                if (need_mask) { const int lim = MODE == 1 ? qpos + 1 : u.kv_len;
#pragma unroll
                    for (int r = 0; r < 16; ++r) { const int kp = kp0 + (r & 3) + 8 * (r >> 2);
                        if (kp >= lim) p0[r] = -__builtin_inff(); if (kp + 32 >= lim) p1[r] = -__builtin_inff(); } }
                float mx = fmaxf(p0[0], p1[0]);
#pragma unroll
                for (int r = 1; r < 16; ++r) mx = fmaxf(mx, fmaxf(p0[r], p1[r]));
                mx = fmaxf(mx, partner32(mx, hi));
                const float mn = fmaxf(m_run, mx);
                constexpr float C2 = ATT_SCALE * LOG2E;
                if (__any(mn > m_run)) { const float alpha = fast_exp2((m_run - mn) * C2); l_run *= alpha; m_run = mn;
#pragma unroll
                    for (int b = 0; b < 4; ++b)
#pragma unroll
                        for (int r = 0; r < 16; ++r) o[b][r] *= alpha; }
                const float mc = m_run * C2; float ps = 0.f;
#pragma unroll
                for (int r = 0; r < 16; ++r) { p0[r] = fast_exp2(p0[r] * C2 - mc); p1[r] = fast_exp2(p1[r] * C2 - mc); ps += p0[r] + p1[r]; }
                l_run += ps;
            } else {
                const bool need_mask = 64 * j + 63 >= qpos_w0;
                float ls0[16], ls1[16];
#pragma unroll
                for (int r = 0; r < 16; ++r) {
                    const float z0 = p0[r] * ATT_SCALE, z1 = p1[r] * ATT_SCALE;
                    const float sp0 = fmaxf(z0, 0.f) + LN2 * fast_log2(1.0f + fast_exp2(-fabsf(z0) * LOG2E)), sp1 = fmaxf(z1, 0.f) + LN2 * fast_log2(1.0f + fast_exp2(-fabsf(z1) * LOG2E));
                    p0[r] = z0 - sp0; p1[r] = z1 - sp1;
                    ls0[r] = -sp0; ls1[r] = -sp1; }
                if (need_mask) {
#pragma unroll
                    for (int r = 0; r < 16; ++r) { const int kp = kp0 + (r & 3) + 8 * (r >> 2);
                        if (kp >= qpos) { ls0[r] = 0.f; p0[r] = -__builtin_inff(); } if (kp + 32 >= qpos) { ls1[r] = 0.f; p1[r] = -__builtin_inff(); } } }
                float a[8], b[8], t[8];
#pragma unroll
                for (int g = 0; g < 4; ++g) { a[g] = (ls0[4 * g] + ls0[4 * g + 1]) + (ls0[4 * g + 2] + ls0[4 * g + 3]); a[4 + g] = (ls1[4 * g] + ls1[4 * g + 1]) + (ls1[4 * g + 2] + ls1[4 * g + 3]); }
#pragma unroll
                for (int g = 0; g < 8; ++g) { b[g] = partner32(a[g], hi); t[g] = a[g] + b[g]; }
                float ps = carry;
#pragma unroll
                for (int g = 7; g >= 0; --g) {
                    const float sg = ps + (hi ? 0.f : b[g]);
                    if (g < 4) { const float e3 = sg, e2 = e3 + ls0[4 * g + 3], e1 = e2 + ls0[4 * g + 2], e0 = e1 + ls0[4 * g + 1];
                        p0[4 * g + 3] = fast_exp2((p0[4 * g + 3] + e3) * LOG2E); p0[4 * g + 2] = fast_exp2((p0[4 * g + 2] + e2) * LOG2E);
                        p0[4 * g + 1] = fast_exp2((p0[4 * g + 1] + e1) * LOG2E); p0[4 * g] = fast_exp2((p0[4 * g] + e0) * LOG2E); }
                    else { const int gg = g - 4; const float e3 = sg, e2 = e3 + ls1[4 * gg + 3], e1 = e2 + ls1[4 * gg + 2], e0 = e1 + ls1[4 * gg + 1];
                        p1[4 * gg + 3] = fast_exp2((p1[4 * gg + 3] + e3) * LOG2E); p1[4 * gg + 2] = fast_exp2((p1[4 * gg + 2] + e2) * LOG2E);
                        p1[4 * gg + 1] = fast_exp2((p1[4 * gg + 1] + e1) * LOG2E); p1[4 * gg] = fast_exp2((p1[4 * gg] + e0) * LOG2E); }
                    ps += t[g];
                }
                carry = ps;
                wave_done = __all(carry < STICK_STOP) || j == 0;
            }
            { const LAS unsigned char* vb = lds + OFF_V + cur * VBUF + vr_lds;
#pragma unroll
              for (int s = 0; s < 4; ++s) {
                  bf16x8 pf;
                  if (s == 0) pf = pack8(p0[0], p0[1], p0[2], p0[3], p0[4], p0[5], p0[6], p0[7]);
                  else if (s == 1) pf = pack8(p0[8], p0[9], p0[10], p0[11], p0[12], p0[13], p0[14], p0[15]);
                  else if (s == 2) pf = pack8(p1[0], p1[1], p1[2], p1[3], p1[4], p1[5], p1[6], p1[7]);
                  else pf = pack8(p1[8], p1[9], p1[10], p1[11], p1[12], p1[13], p1[14], p1[15]);
#pragma unroll
                  for (int db = 0; db < 4; ++db) { const bf16x8 vf = *(const LAS bf16x8*)(vb + 32 * db * VROW + ((s ^ db) << 5));
                      o[db] = __builtin_amdgcn_mfma_f32_32x32x16_bf16(vf, pf, o[db], 0, 0, 0); } } }
        }
        if (more) stage_store(cur ^ 1);
        if (MODE == 2 && lane == 0) ((LAS unsigned*)(lds + OFF_VOTE))[cur * 8 + wave] = (wave_done || j - 1 < w_lo) ? 1u : 0u;
        LDS_WAIT(); __syncthreads();
        if (!more) break;
        if (MODE == 2) { const LAS u32x4* vv = (const LAS u32x4*)(lds + OFF_VOTE + cur * 32); const u32x4 x = vv[0], y = vv[1];
            if ((x.x & x.y & x.z & x.w & y.x & y.y & y.z & y.w) != 0u) break; }
    }
    if (active) {
        float inv = 1.0f;
        if (MODE != 2) { const float lt = l_run + partner32(l_run, hi); inv = 1.0f / lt; }
        bf16* op = (bf16*)u.q + (size_t)(wave * 32 + qr) * LDQ + 4 * hi;
#pragma unroll
        for (int db = 0; db < 4; ++db)
#pragma unroll
            for (int g = 0; g < 4; ++g) { u32x2 w; w.x = cvt_pk_bf16(o[db][4 * g] * inv, o[db][4 * g + 1] * inv); w.y = cvt_pk_bf16(o[db][4 * g + 2] * inv, o[db][4 * g + 3] * inv);
                *(u32x2*)(op + 32 * db + 8 * g) = w; }
    }
    __syncthreads();
}

__device__ __forceinline__ int pull(LAS unsigned char* lds, unsigned* counter, int tid) {
    LAS int* qw = (LAS int*)(lds + OFF_QW);
    if (tid == 0) *qw = (int)__hip_atomic_fetch_add(counter, 1u, __ATOMIC_RELAXED, __HIP_MEMORY_SCOPE_AGENT);
    LDS_WAIT(); __syncthreads();
    const int v = *qw;
    __syncthreads();
    return v;
}

template <int MODE>
__device__ __forceinline__ void mode_loop(const Params& P, const Ctx& C, int layer) {
    constexpr int NHG = MODE == 0 ? HA : HB;
    constexpr int H0 = MODE == 0 ? 0 : (MODE == 1 ? HA : HA + HB);
    constexpr int NPU = PB * NHG * (PT / 256), NSU = SB * NHG;
    unsigned* counter = (unsigned*)(P.ws + WS_CTL) + CW_QUEUE + 64 * (layer * 3 + MODE);
    const bf16* qkv = (const bf16*)(P.ws + WS_QKV);
    for (;;) {
        const int i = pull(C.lds, counter, C.tid);
        if (i >= NPU + NSU) break;
        Unit u;
        if (i < NPU) {
            const int qb = (PT / 256 - 1) - i / (PB * NHG), bh = i % (PB * NHG), b = bh / NHG, hg = bh % NHG, hh = H0 + hg;
            const size_t row0 = (size_t)b * PT;
            u.q = qkv + (row0 + (size_t)qb * 256) * LDQ + hh * HD; u.nq = 256; u.qpos0 = qb * 256; u.kv_len = PT; u.new_pos0 = 0;
            u.kn = qkv + row0 * LDQ + D + hh * HD; u.vn = qkv + row0 * LDQ + 2 * D + hh * HD; u.kc = u.kn; u.vc = u.vn; u.cstride = LDQ;
            u.t_hi = 4 * qb + 3; u.t_lo = MODE == 0 ? (4 * qb - 8 > 0 ? 4 * qb - 8 : 0) : 0;
            u.F = (const float*)(P.ws + WS_FP) + row0 * HB + hg; u.fref = MODE == 1 ? u.F[(size_t)u.qpos0 * HB] : 0.f;
            u.rel = P.in[17] + (size_t)layer * 257 * HA + hh;
        } else {
            const int s = i - NPU, sb = s / NHG, hg = s % NHG, hh = H0 + hg;
            constexpr int CL = MODE == 0 ? AWIN : PAST;
            const size_t row0 = (size_t)MP + (size_t)sb * ST;
            u.q = qkv + row0 * LDQ + hh * HD; u.nq = ST; u.qpos0 = CL; u.kv_len = CL + ST; u.new_pos0 = CL;
            u.kn = qkv + row0 * LDQ + D + hh * HD; u.vn = qkv + row0 * LDQ + 2 * D + hh * HD;
            const size_t coff = ((size_t)(layer * SB + sb) * CL * NHG + hg) * HD;
            u.kc = (const bf16*)(P.ws + (MODE == 0 ? WS_CAK : (MODE == 1 ? WS_CBK : WS_CCK))) + coff; u.vc = (const bf16*)(P.ws + (MODE == 0 ? WS_CAV : (MODE == 1 ? WS_CBV : WS_CCV))) + coff;
            u.cstride = NHG * HD;
            u.t_hi = (CL + ST - 1) >> 6; u.t_lo = 0;
            u.F = (const float*)(P.ws + WS_FS) + (size_t)sb * (PAST + ST) * HB + hg; u.fref = MODE == 1 ? u.F[(size_t)u.qpos0 * HB] : 0.f;
            u.rel = P.in[17] + (size_t)layer * 257 * HA + hh;
        }
        run_unit<MODE>(C.lds, u, C.tid, C.wave, C.lane);
    }
}
}

#ifndef PHASE_MASK
#define PHASE_MASK 0xFFF
#endif
#define PH(n) ((PHASE_MASK >> (n)) & 1)
typedef const Params __attribute__((address_space(4)))* KParams;
__device__ __forceinline__ const Params& kparams() {
    KParams p = (KParams)__builtin_amdgcn_kernarg_segment_ptr(); asm volatile("" : "+s"(p)); return *(const Params*)p;
}
#define P (kparams())
__device__ __forceinline__ Ctx make_ctx(LAS unsigned char* lds) {
    Ctx C; int t = threadIdx.x; asm volatile("" : "+v"(t));
    C.lds = lds; C.tid = t; C.lane = t & 63; C.wave = __builtin_amdgcn_readfirstlane(t >> 6); C.G = gridDim.x; C.blk = blockIdx.x; return C;
}
__global__ void __launch_bounds__(512, 2) hse_fwd(Params P_unused) {
    extern __shared__ __attribute__((aligned(16))) unsigned char lds_raw[];
    LAS unsigned char* const lds = (LAS unsigned char*)lds_raw;
    volatile LAS unsigned* MISC = (volatile LAS unsigned*)(lds + MISC_OFF);
    if (threadIdx.x < 64) MISC[threadIdx.x] = 0u;
    __syncthreads();
    XcdBarrier bar = xcd_barrier_post((unsigned*)(P.ws + WS_CTL) + CW_BAR, MISC + 8);

    if (PH(0)) { const Params& Q = P; const Ctx C = make_ctx(lds); p0_prologue(Q, C); }
    xcd_barrier(bar);


#pragma unroll 1
    for (int layer = 0; layer < 2; ++layer) {
        if (PH(1)) { const Params& Q = P; const Ctx C = make_ctx(lds); norm_phase<true>(Q, C, layer, layer == 0 ? Q.in[0] : Q.out + O_Y_P, layer == 0 ? Q.in[1] : Q.out + O_Y_S, Q.in[13] + layer * D, 0, D); }
        xcd_barrier(bar);
        if (PH(2)) { const Params& Q = P; const Ctx C = make_ctx(lds); fcum_phase(Q, C, layer); }
        if (PH(3)) { const Params& Q = P; const Ctx C = make_ctx(lds); pg8::Gemm g{(const bf16*)(Q.ws + WS_H), (const bf16*)(Q.ws + WS_WIN + layer * SZ_WIN)}; pg8::StaticOrder<MT / 256, NQKV / 256> S; S.init(C.G, C.blk);
          pg8::EpiQKV E{(bf16*)(Q.ws + WS_QKV), Q.out, layer};
          pg8::gemm_phase<pg8::EpiQKV, pg8::StaticOrder<MT / 256, NQKV / 256>, true, true, D, D>(C.lds + RING_OFF, g, S, E); }
        xcd_barrier(bar);
        if (PH(4)) { const Params& Q = P; const Ctx C = make_ctx(lds); att::mode_loop<1>(Q, C, layer); }
        if (PH(5)) { const Params& Q = P; const Ctx C = make_ctx(lds); att::mode_loop<0>(Q, C, layer); }
        if (PH(6)) { const Params& Q = P; const Ctx C = make_ctx(lds); att::mode_loop<2>(Q, C, layer); }
        xcd_barrier(bar);
        if (PH(7)) { const Params& Q = P; const Ctx C = make_ctx(lds); pg8::Gemm g{(const bf16*)(Q.ws + WS_QKV), (const bf16*)(Q.ws + WS_WO + layer * SZ_WO)}; pg8::StaticOrder<MT / 256, D / 256> S; S.init(C.G, C.blk);
          pg8::EpiResid E{layer == 0 ? Q.in[0] : Q.out + O_Y_P, layer == 0 ? Q.in[1] : Q.out + O_Y_S, Q.out + O_Y_P, Q.out + O_Y_S, (const float*)(Q.ws + WS_MOD) + (size_t)layer * NMIDX * NMOD + 2 * D};
          pg8::gemm_phase<pg8::EpiResid, pg8::StaticOrder<MT / 256, D / 256>, true, true, D, LDQ>(C.lds + RING_OFF, g, S, E); }
        xcd_barrier(bar);
        if (PH(8)) { const Params& Q = P; const Ctx C = make_ctx(lds); norm_phase<false>(Q, C, layer, Q.out + O_Y_P, Q.out + O_Y_S, Q.in[14] + layer * D, 3 * D, 4 * D); }
        xcd_barrier(bar);
        if (PH(9)) { const Params& Q = P; const Ctx C = make_ctx(lds); pg8::Gemm g{(const bf16*)(Q.ws + WS_H), (const bf16*)(Q.ws + WS_WGU + layer * SZ_WGU)}; pg8::StaticOrder<MT / 256, 2 * DFF / 256> S; S.init(C.G, C.blk);
          pg8::EpiSwiGLU E{(bf16*)(Q.ws + WS_QKV)};
          pg8::gemm_phase<pg8::EpiSwiGLU, pg8::StaticOrder<MT / 256, 2 * DFF / 256>, true, true, D, D>(C.lds + RING_OFF, g, S, E); }
        xcd_barrier(bar);
        if (PH(10)) { const Params& Q = P; const Ctx C = make_ctx(lds); pg8::Gemm g{(const bf16*)(Q.ws + WS_QKV), (const bf16*)(Q.ws + WS_WDN + layer * SZ_WDN)}; pg8::StaticOrder<MT / 256, D / 256> S; S.init(C.G, C.blk);
          pg8::EpiResid E{Q.out + O_Y_P, Q.out + O_Y_S, Q.out + O_Y_P, Q.out + O_Y_S, (const float*)(Q.ws + WS_MOD) + (size_t)layer * NMIDX * NMOD + 5 * D};
          pg8::gemm_phase<pg8::EpiResid, pg8::StaticOrder<MT / 256, D / 256>, true, true, DFF, DFF>(C.lds + RING_OFF, g, S, E); }
        xcd_barrier(bar);
    }
    if (PH(11)) { const Params& Q = P; const Ctx C = make_ctx(lds); final_norm(Q, C); }
}
#undef P

extern "C" void kernel_launch(void* const* d_in, const int* in_sizes, int n_in, void* d_out, int out_size, void* d_ws, size_t ws_size, hipStream_t stream) {
    static int grid = 0;
    if (grid == 0) {
        if (n_in != 23 || (size_t)out_size != O_END || ws_size < WS_END) {
            fprintf(stderr, "kernel_launch: unexpected shapes (n_in %d, out %d (want %zu), ws %zu (want >= %zu)); nothing launched\n", n_in, out_size, (size_t)O_END, ws_size, (size_t)WS_END); grid = -1; return; }
        int dev = 0, cus = 0, per_cu = 0;
        if (hipGetDevice(&dev) != hipSuccess || hipDeviceGetAttribute(&cus, hipDeviceAttributeMultiprocessorCount, dev) != hipSuccess) { grid = -1; return; }
        if (hipFuncSetAttribute((const void*)hse_fwd, hipFuncAttributeMaxDynamicSharedMemorySize, LDS_BYTES) != hipSuccess) { fprintf(stderr, "kernel_launch: hipFuncSetAttribute failed\n"); grid = -1; return; }
        if (hipOccupancyMaxActiveBlocksPerMultiprocessor(&per_cu, (const void*)hse_fwd, 512, LDS_BYTES) != hipSuccess || per_cu < 1) { fprintf(stderr, "kernel_launch: occupancy query says %d\n", per_cu); (void)hipGetLastError(); grid = -1; return; }
        grid = cus;
    }
    if (grid < 0) return;
    (void)in_sizes;
    if (hipMemsetAsync((char*)d_ws + WS_CTL, 0, CTL_ZERO_BYTES, stream) != hipSuccess) return;
    Params p{};
    for (int i = 0; i < 23; ++i) p.in[i] = (const float*)d_in[i];
    p.out = (float*)d_out; p.ws = (unsigned char*)d_ws;
    hipLaunchKernelGGL(hse_fwd, dim3(grid), dim3(512), LDS_BYTES, stream, p);
}
```

```cpp
#include <hip/hip_runtime.h>
#include <cstdio>
#include <cstdint>

#define LAS __attribute__((address_space(3)))
#define GAS __attribute__((address_space(1)))
typedef unsigned short bf16;
typedef short bf16x8 __attribute__((ext_vector_type(8)));
typedef float f32x4 __attribute__((ext_vector_type(4)));
typedef float f32x2 __attribute__((ext_vector_type(2)));
typedef float f32x16 __attribute__((ext_vector_type(16)));
typedef unsigned u32x4 __attribute__((ext_vector_type(4)));
typedef unsigned u32x2 __attribute__((ext_vector_type(2)));

constexpr int D = 2048, NH = 16, HD = 128, DFF = 5632, NQKV = 6144, NIN = 6150, NMOD = 6 * D;
constexpr int PB = 4, PT = 8192, SB = 8, ST = 32, PAST = 1024, AWIN = 512;
constexpr int HA = 4, HB = 6, HC = 6;
constexpr int MP = PB * PT, MS = SB * ST, MT = MP + MS;
constexpr int LDQ = NQKV;
constexpr float EPS = 1e-6f;
constexpr float ATT_SCALE = 0.08838834764831845f, INV_SCALE = 11.313708498984761f, LOG2E = 1.4426950408889634f, LN2 = 0.6931471805599453f;
constexpr int NMIDX = PB + SB;

constexpr size_t O_Y_P = 0;
constexpr size_t O_Y_S = O_Y_P + (size_t)MP * D;
constexpr size_t O_AK_P = O_Y_S + (size_t)MS * D;
constexpr size_t SZ_A_P = (size_t)2 * PB * AWIN * HA * HD, SZ_B_P = (size_t)2 * PB * PT * HB * HD, SZ_LF_P = (size_t)2 * PB * PT * HB;
constexpr size_t SZ_A_S = (size_t)2 * SB * ST * HA * HD, SZ_B_S = (size_t)2 * SB * ST * HB * HD, SZ_LF_S = (size_t)2 * SB * ST * HB;
constexpr size_t O_AV_P = O_AK_P + SZ_A_P, O_BK_P = O_AV_P + SZ_A_P, O_BV_P = O_BK_P + SZ_B_P, O_BLF_P = O_BV_P + SZ_B_P, O_CK_P = O_BLF_P + SZ_LF_P, O_CV_P = O_CK_P + SZ_B_P;
constexpr size_t O_AK_S = O_CV_P + SZ_B_P, O_AV_S = O_AK_S + SZ_A_S, O_BK_S = O_AV_S + SZ_A_S, O_BV_S = O_BK_S + SZ_B_S, O_BLF_S = O_BV_S + SZ_B_S, O_CK_S = O_BLF_S + SZ_LF_S, O_CV_S = O_CK_S + SZ_B_S;
constexpr size_t O_END = O_CV_S + SZ_B_S;

constexpr size_t MiB = 1u << 20;
constexpr size_t WS_CTL = 0, CTL_ZERO_BYTES = 4 * MiB;
constexpr size_t WS_MOD = 2 * MiB;
constexpr size_t SZ_WIN = (size_t)NQKV * D * 2, SZ_WO = (size_t)D * D * 2, SZ_WGU = (size_t)2 * DFF * D * 2, SZ_WDN = (size_t)D * DFF * 2;
constexpr size_t WS_WIN = 4 * MiB, WS_WO = WS_WIN + 2 * SZ_WIN, WS_WGU = WS_WO + 2 * SZ_WO, WS_WDN = WS_WGU + 2 * SZ_WGU;
constexpr size_t WS_H = WS_WDN + 2 * SZ_WDN;
constexpr size_t WS_QKV = WS_H + (size_t)MT * D * 2;
constexpr size_t WS_CACHE = WS_QKV + (size_t)MT * NQKV * 2;
constexpr size_t SZ_CA = (size_t)2 * SB * AWIN * HA * HD * 2, SZ_CB = (size_t)2 * SB * PAST * HB * HD * 2;
constexpr size_t WS_CAK = WS_CACHE, WS_CAV = WS_CAK + SZ_CA, WS_CBK = WS_CAV + SZ_CA, WS_CBV = WS_CBK + SZ_CB, WS_CCK = WS_CBV + SZ_CB, WS_CCV = WS_CCK + SZ_CB;
constexpr size_t WS_FP = WS_CCV + SZ_CB;
constexpr size_t WS_FS = WS_FP + (size_t)PB * PT * HB * 4;
constexpr size_t WS_PART = (WS_FS + (size_t)SB * (PAST + ST) * HB * 4 + 4095) / 4096 * 4096;
constexpr size_t WS_END = WS_PART + (size_t)8 * MS * NQKV * 4 + 4096;
static_assert((size_t)4 * MS * 2 * DFF * 4 <= (size_t)8 * MS * NQKV * 4 && (size_t)22 * MS * D * 4 <= (size_t)8 * MS * NQKV * 4, "partials buffer");
static_assert((size_t)MT * DFF * 2 <= (size_t)MT * NQKV * 2, "ACT overlays QKV");
constexpr int CW_TMO = 0, CW_BAR = 4096, CW_QUEUE = 16384;

constexpr int RING_OFF = 0, RING_BYTES = 131072;
constexpr int MISC_OFF = RING_BYTES;
constexpr int LDS_BYTES = 147456;

#define LDS_WAIT() asm volatile("s_waitcnt lgkmcnt(0)" ::: "memory")
#define VM_WAIT() asm volatile("s_waitcnt vmcnt(0)" ::: "memory")
__device__ __forceinline__ unsigned cvt_pk_bf16(float lo, float hi) { unsigned r; asm volatile("v_cvt_pk_bf16_f32 %0, %1, %2" : "=v"(r) : "v"(lo), "v"(hi)); return r; }
__device__ __forceinline__ float fast_exp2(float x) { return __builtin_amdgcn_exp2f(x); }
__device__ __forceinline__ float fast_log2(float x) { return __builtin_amdgcn_logf(x); }
__device__ __forceinline__ float fast_rcp(float x) { return __builtin_amdgcn_rcpf(x); }
__device__ __forceinline__ float wave_sum(float v) {
#pragma unroll
    for (int o = 1; o < 64; o <<= 1) v += __shfl_xor(v, o);
    return v;
}
namespace pg8 {
#define PG8_LAS __attribute__((address_space(3)))
typedef unsigned short bf16_t;
typedef short bf16x8 __attribute__((ext_vector_type(8)));
typedef float f32x4 __attribute__((ext_vector_type(4)));
typedef unsigned u32x4 __attribute__((ext_vector_type(4)));
constexpr int BM = 256, BK = 64, HALF = 128, HTB = HALF * BK * 2  , STAGE_BYTES = 8 * HTB, NXCD = 8, WGM = 8;

__host__ __device__ __forceinline__ int lds_byte(int r, int c) { const int st = (r >> 4) * 2 + (c >> 5), rr = r & 15, cc = c & 31, ob = rr * 64 + cc * 2; return st * 1024 + (ob ^ (((ob >> 9) & 1) << 5)); }
__host__ __device__ __forceinline__ void stage_rc(int b, int& R, int& C) { const int st = b / 1024, sb = b % 1024, swz = sb ^ (((sb >> 9) & 1) << 5); R = (st >> 1) * 16 + swz / 64; C = (st & 1) * 32 + (swz % 64) / 2; }
__host__ __device__ __forceinline__ int perm32(int rho) { const int n = rho >> 4, i = rho & 15; return 8 * (i >> 2) + 4 * n + (i & 3); }

struct Unit { int pm, pn, kc; };
struct Gemm { const bf16_t* A; const bf16_t* Bt; };

template <int NM, int NN> struct StaticOrder {
    int G, c;
    __host__ __device__ void init(int G_, int c_) { G = G_; c = c_; }
    __host__ __device__ bool next(int i, Unit& u) const {
        constexpr int nM = NM, nN = NN, nwg = NM * NN;
        const int L = i * G + c; if (L >= nwg) return false;
        int wgid = L; { constexpr int q = nwg / NXCD, r = nwg % NXCD; const int xcd = wgid % NXCD, off = wgid / NXCD; wgid = (xcd < r ? xcd * (q + 1) : r * (q + 1) + (xcd - r) * q) + off; }
        constexpr int nig = WGM * nN; const int gid = wgid / nig, fm = gid * WGM, gsz = (nM - fm) < WGM ? (nM - fm) : WGM;
        u.pm = fm + ((wgid % nig) % gsz); u.pn = (wgid % nig) / gsz; u.kc = 0; return true;
    }
    __device__ __forceinline__ void a_ready(const Unit&) const {}
    __device__ __forceinline__ void done(const Unit&) const {}
};

__device__ __forceinline__ unsigned cvt_pk_bf16(float lo, float hi) { unsigned r; asm volatile("v_cvt_pk_bf16_f32 %0, %1, %2" : "=v"(r) : "v"(lo), "v"(hi)); return r; }

struct EpiQKV {
    static constexpr bool PERM = true, AFTER_DRAIN = false, PROBE_DUP = true;
    bf16_t* QKV; float* out; int layer;
    __device__ __forceinline__ void operator()(const f32x4 (&acc)[2][2][4][2], const Unit& u, int wr, int wc, int fr, int fq) const {
        const int which = u.pn >> 3;
        const int rl0 = wr * 64 + fr;
        const int d0 = wc * 32 + 8 * fq;
        bf16_t* qbase = QKV + (size_t)(u.pm * BM + rl0) * ::LDQ + u.pn * BM + d0;
        float* fb[2]; int rstride[2]; bool en[2];
#pragma unroll
        for (int bj = 0; bj < 2; ++bj) {
            const int hh = (u.pn & 7) * 2 + bj;
            en[bj] = which != 0; fb[bj] = out; rstride[bj] = 0;
            if (which != 0) {
                const bool isv = which == 2;
                {
                    const int b = u.pm >> 5, t0 = (u.pm & 31) * 256;
                    if (hh < ::HA) { en[bj] = t0 >= ::PT - ::AWIN; rstride[bj] = ::HA * ::HD;
                        fb[bj] = out + (isv ? ::O_AV_P : ::O_AK_P) + ((size_t)((layer * ::PB + b) * ::AWIN + (t0 - (::PT - ::AWIN))) * ::HA + hh) * ::HD; }
                    else { const int hg = hh < ::HA + ::HB ? hh - ::HA : hh - ::HA - ::HB; rstride[bj] = ::HB * ::HD;
                        const size_t ob = hh < ::HA + ::HB ? (isv ? ::O_BV_P : ::O_BK_P) : (isv ? ::O_CV_P : ::O_CK_P);
                        fb[bj] = out + ob + ((size_t)((layer * ::PB + b) * ::PT + t0) * ::HB + hg) * ::HD; }
                }
            }
        }
#pragma unroll
        for (int ai = 0; ai < 2; ++ai)
#pragma unroll
            for (int m = 0; m < 4; ++m) { const int rl = rl0 + ai * HALF + m * 16; bf16_t* rowp = qbase + (size_t)(ai * HALF + m * 16) * ::LDQ;
#pragma unroll
                for (int bj = 0; bj < 2; ++bj) { const f32x4 v0 = acc[ai][bj][m][0], v1 = acc[ai][bj][m][1];
                    u32x4 w; w.x = cvt_pk_bf16(v0[0], v0[1]); w.y = cvt_pk_bf16(v0[2], v0[3]); w.z = cvt_pk_bf16(v1[0], v1[1]); w.w = cvt_pk_bf16(v1[2], v1[3]);
                    *(u32x4*)(rowp + bj * HALF) = w;
                    if (en[bj]) { float* fp = fb[bj] + (size_t)rl * rstride[bj] + d0; *(f32x4*)fp = v0; *(f32x4*)(fp + 4) = v1; } } }
    }
};
struct EpiResid {
    static constexpr bool PERM = false, AFTER_DRAIN = false, PROBE_DUP = false;
    const float* xin_p; float* xout_p; const float* gate;
    __device__ __forceinline__ void operator()(const f32x4 (&acc)[2][2][4][2], const Unit& u, int wr, int wc, int fr, int fq) const {
        const float* xi = xin_p + (size_t)u.pm * BM * ::D; float* xo = xout_p + (size_t)u.pm * BM * ::D;
        const int col0 = u.pn * BM + wc * 32 + 4 * fq; const float* gp = gate + (size_t)(u.pm >> 5) * ::NMOD + col0;
#pragma unroll
        for (int ai = 0; ai < 2; ++ai)
#pragma unroll
            for (int m = 0; m < 4; ++m) { const int rl = ai * HALF + wr * 64 + m * 16 + fr; const size_t off = (size_t)rl * ::D + col0;
#pragma unroll
                for (int bj = 0; bj < 2; ++bj) {
#pragma unroll
                    for (int n = 0; n < 2; ++n) { const f32x4 gv = *(const f32x4*)(gp + bj * HALF + n * 16); const f32x4 xv = *(const f32x4*)(xi + off + bj * HALF + n * 16);
                        *(f32x4*)(xo + off + bj * HALF + n * 16) = xv + gv * acc[ai][bj][m][n]; }
                    asm volatile("" ::: "memory"); } }
    }
};
struct EpiSwiGLU {
    static constexpr bool PERM = true, AFTER_DRAIN = false, PROBE_DUP = false;
    bf16_t* ACT;
    __device__ __forceinline__ void operator()(const f32x4 (&acc)[2][2][4][2], const Unit& u, int wr, int wc, int fr, int fq) const {
        bf16_t* base = ACT + (size_t)(u.pm * BM + wr * 64 + fr) * ::DFF + u.pn * HALF + wc * 32 + 8 * fq;
#pragma unroll
        for (int ai = 0; ai < 2; ++ai)
#pragma unroll
            for (int m = 0; m < 4; ++m) { float r[8];
#pragma unroll
                for (int n = 0; n < 2; ++n)
#pragma unroll
                    for (int j = 0; j < 4; ++j) { const float g = acc[ai][0][m][n][j], up = acc[ai][1][m][n][j];
                        r[4 * n + j] = g * __builtin_amdgcn_rcpf(1.0f + __builtin_amdgcn_exp2f(-g * ::LOG2E)) * up; }
                u32x4 w; w.x = cvt_pk_bf16(r[0], r[1]); w.y = cvt_pk_bf16(r[2], r[3]); w.z = cvt_pk_bf16(r[4], r[5]); w.w = cvt_pk_bf16(r[6], r[7]);
                *(u32x4*)(base + (size_t)(ai * HALF + m * 16) * ::DFF) = w; }
    }
};


template <int PM, int NN, int NKC> struct SampleOrder {
    int G, c;
    __host__ __device__ void init(int G_, int c_) { G = G_; c = c_; }
    __host__ __device__ bool next(int i, Unit& u) const { const int L = i * G + c; if (L >= NN * NKC) return false; u.pm = PM; u.pn = L % NN; u.kc = L / NN; return true; }
    __device__ __forceinline__ void a_ready(const Unit&) const {}
    __device__ __forceinline__ void done(const Unit&) const {}
};
template <int N> struct EpiPartial {
    static constexpr bool PERM = false, AFTER_DRAIN = false, PROBE_DUP = false;
    float* part;
    __device__ __forceinline__ void operator()(const f32x4 (&acc)[2][2][4][2], const Unit& u, int wr, int wc, int fr, int fq) const {
        float* base = part + ((size_t)u.kc * BM + wr * 64 + fr) * N + u.pn * BM + wc * 32 + 4 * fq;
#pragma unroll
        for (int ai = 0; ai < 2; ++ai)
#pragma unroll
            for (int m = 0; m < 4; ++m) { float* rowp = base + (size_t)(ai * HALF + m * 16) * N;
#pragma unroll
                for (int bj = 0; bj < 2; ++bj)
#pragma unroll
                    for (int n = 0; n < 2; ++n) *(f32x4*)(rowp + bj * HALF + n * 16) = acc[ai][bj][m][n]; }
    }
};


template <class Epi, class Sched, bool ALIGN_EPI, bool SP2, int KK, int LDA, int LDB = KK>
__device__ __forceinline__ void gemm_phase(PG8_LAS unsigned char* lds, const Gemm g, const Sched& S, const Epi& E) {
    int tid = threadIdx.x; asm volatile("" : "+v"(tid));
    const int wid = __builtin_amdgcn_readfirstlane(tid >> 6), lane = tid & 63, wr = wid >> 2, wc = wid & 3, fr = lane & 15, fq = lane >> 4;
    constexpr int K = KK, nt = K / BK, lda = LDA, ldb = LDB;
    unsigned voffA[2], voffB[2];
#pragma unroll
    for (int i = 0; i < 2; ++i) { int R, C; stage_rc(tid * 16 + i * 8192, R, C); const int Rb = Epi::PERM ? ((R & ~31) + perm32(R & 31)) : R;
        voffA[i] = (unsigned)(R * lda + C) * 2u; voffB[i] = (unsigned)(Rb * ldb + C) * 2u; }
    constexpr size_t kstep = (size_t)(BK * 2);
    constexpr size_t hstepA = (size_t)HALF * lda * 2, hstepB = (size_t)HALF * ldb * 2;
    constexpr size_t tstepA = 2 * hstepA, tstepB = 2 * hstepB;
    const unsigned ldsw = (unsigned)wid * 1024u;
    const int aoff = lds_byte(wr * 64 + fr, fq * 8), boff = lds_byte(wc * 32 + fr, fq * 8);
#define PG8_SA(b, h) (((b) * 2 + (h)) * HTB)
#define PG8_SB(b, h) ((4 + (b) * 2 + (h)) * HTB)
#define PG8_STAGE(bufoff, gbase, voff) do { _Pragma("unroll") for (int _i = 0; _i < 2; ++_i) \
        __builtin_amdgcn_global_load_lds((const unsigned*)((const char*)(gbase) + (voff)[_i]), (PG8_LAS unsigned*)(lds + (bufoff) + ldsw + _i * 8192), 16, 0, 0); } while (0)
#define PG8_LDA(dst, b, h) do { _Pragma("unroll") for (int m = 0; m < 4; ++m) _Pragma("unroll") for (int k = 0; k < 2; ++k) dst[m][k] = *(const PG8_LAS bf16x8*)(lds + PG8_SA(b, h) + aoff + m * 2048 + k * 1024); } while (0)
#define PG8_LDB(dst, b, h) do { _Pragma("unroll") for (int n = 0; n < 2; ++n) _Pragma("unroll") for (int k = 0; k < 2; ++k) dst[n][k] = *(const PG8_LAS bf16x8*)(lds + PG8_SB(b, h) + boff + n * 2048 + k * 1024); } while (0)
#define PG8_MMA(ai, bj, At, Bt) do { __builtin_amdgcn_s_setprio(1); _Pragma("unroll") for (int m = 0; m < 4; ++m) _Pragma("unroll") for (int n = 0; n < 2; ++n) _Pragma("unroll") for (int k = 0; k < 2; ++k) \
        acc[ai][bj][m][n] = __builtin_amdgcn_mfma_f32_16x16x32_bf16(Bt[n][k], At[m][k], acc[ai][bj][m][n], 0, 0, 0); __builtin_amdgcn_s_setprio(0); } while (0)
#define PG8_WAIT_V(n) asm volatile("s_waitcnt vmcnt(" #n ")" ::: "memory")
#define PG8_WAIT_L(n) asm volatile("s_waitcnt lgkmcnt(" #n ")" ::: "memory")
#define PG8_BAR __builtin_amdgcn_s_barrier()
#define PG8_SCHED __builtin_amdgcn_sched_barrier(0)
    Unit cur, nxt; int ui = 0;
    if (!S.next(0, cur)) return;
    f32x4 acc[2][2][4][2];
#pragma unroll
    for (int a = 0; a < 2; ++a)
#pragma unroll
        for (int b = 0; b < 2; ++b)
#pragma unroll
            for (int m = 0; m < 4; ++m)
#pragma unroll
                for (int n = 0; n < 2; ++n) acc[a][b][m][n] = (f32x4){0.f, 0.f, 0.f, 0.f};
    bf16x8 At[4][2], B0[2][2], B1[2][2];
    const char* cA = (const char*)g.A + (size_t)cur.pm * tstepA + (size_t)cur.kc * (K * 2); const char* cB = (const char*)g.Bt + (size_t)cur.pn * tstepB + (size_t)cur.kc * (K * 2);
    S.a_ready(cur);
    if constexpr (SP2) {
        PG8_STAGE(PG8_SB(0, 0), cB, voffB); PG8_STAGE(PG8_SB(0, 1), cB + hstepB, voffB); PG8_STAGE(PG8_SA(0, 0), cA, voffA); PG8_STAGE(PG8_SA(0, 1), cA + hstepA, voffA);
        if (wr == 1) PG8_BAR;
        PG8_WAIT_V(2); PG8_BAR;
        PG8_STAGE(PG8_SB(1, 0), cB + kstep, voffB); PG8_STAGE(PG8_SA(1, 0), cA + kstep, voffA); PG8_STAGE(PG8_SB(1, 1), cB + hstepB + kstep, voffB);
        PG8_WAIT_V(6); PG8_BAR;
    } else {
        PG8_STAGE(PG8_SB(0, 0), cB, voffB); PG8_STAGE(PG8_SA(0, 0), cA, voffA); PG8_STAGE(PG8_SB(0, 1), cB + hstepB, voffB); PG8_STAGE(PG8_SA(0, 1), cA + hstepA, voffA);
        if (wr == 1) PG8_BAR;
        PG8_WAIT_V(4); PG8_BAR;
        PG8_STAGE(PG8_SB(1, 0), cB + kstep, voffB); PG8_STAGE(PG8_SA(1, 0), cA + kstep, voffA); PG8_STAGE(PG8_SB(1, 1), cB + hstepB + kstep, voffB);
        PG8_WAIT_V(6); PG8_BAR;
    }
    for (;;) {
        const bool has_next = S.next(ui + 1, nxt);
        const char* nA = has_next ? (const char*)g.A + (size_t)nxt.pm * tstepA + (size_t)nxt.kc * (K * 2) : cA; const char* nB = has_next ? (const char*)g.Bt + (size_t)nxt.pn * tstepB + (size_t)nxt.kc * (K * 2) : cB;
#pragma unroll 1
        for (int t = 0; t < nt; t += 2) {
            const bool last = (t == nt - 2);
            const char* a1 = cA + (size_t)(t + 1) * kstep;
            const char* a2 = last ? nA : cA + (size_t)(t + 2) * kstep; const char* b2 = last ? nB : cB + (size_t)(t + 2) * kstep;
            const char* a3 = a2 + kstep; const char* b3 = b2 + kstep;
            if (last && has_next) S.a_ready(nxt);
            if constexpr (SP2) {
            PG8_LDB(B0, 0, 0); PG8_LDB(B1, 0, 1); PG8_SCHED; PG8_LDA(At, 0, 0); PG8_STAGE(PG8_SA(1, 1), a1 + hstepA, voffA);
            PG8_WAIT_V(8); PG8_WAIT_L(0); PG8_BAR; PG8_MMA(0, 0, At, B0); PG8_MMA(0, 1, At, B1); PG8_BAR; PG8_SCHED;
            PG8_LDA(At, 0, 1); PG8_STAGE(PG8_SB(0, 0), b2, voffB); PG8_STAGE(PG8_SB(0, 1), b2 + hstepB, voffB); PG8_STAGE(PG8_SA(0, 0), a2, voffA);
            PG8_WAIT_V(8); PG8_WAIT_L(0); PG8_BAR; PG8_MMA(1, 0, At, B0); PG8_MMA(1, 1, At, B1); PG8_BAR; PG8_SCHED;
            PG8_LDB(B0, 1, 0); PG8_LDB(B1, 1, 1); PG8_SCHED; PG8_LDA(At, 1, 0); PG8_STAGE(PG8_SA(0, 1), a2 + hstepA, voffA);
            PG8_WAIT_V(8); PG8_WAIT_L(0); PG8_BAR; PG8_MMA(0, 0, At, B0); PG8_MMA(0, 1, At, B1); PG8_BAR; PG8_SCHED;
            PG8_LDA(At, 1, 1); PG8_STAGE(PG8_SB(1, 0), b3, voffB); PG8_STAGE(PG8_SB(1, 1), b3 + hstepB, voffB); PG8_STAGE(PG8_SA(1, 0), a3, voffA);
            PG8_WAIT_V(8); PG8_WAIT_L(0); PG8_BAR; PG8_MMA(1, 0, At, B0); PG8_MMA(1, 1, At, B1); PG8_BAR; PG8_SCHED;
            } else {
            PG8_LDB(B0, 0, 0); PG8_SCHED; PG8_LDA(At, 0, 0); PG8_STAGE(PG8_SA(1, 1), a1 + hstepA, voffA);
            PG8_WAIT_L(8); PG8_BAR; PG8_WAIT_L(0); PG8_MMA(0, 0, At, B0); PG8_BAR; PG8_SCHED;
            PG8_LDB(B1, 0, 1); PG8_STAGE(PG8_SB(0, 0), b2, voffB);
            PG8_BAR; PG8_WAIT_L(0); PG8_MMA(0, 1, At, B1); PG8_BAR;
            PG8_LDA(At, 0, 1); PG8_STAGE(PG8_SA(0, 0), a2, voffA);
            PG8_BAR; PG8_WAIT_L(0); PG8_MMA(1, 0, At, B0); PG8_BAR; PG8_SCHED;
            PG8_STAGE(PG8_SB(0, 1), b2 + hstepB, voffB);
            PG8_WAIT_V(6); PG8_BAR; PG8_MMA(1, 1, At, B1); PG8_BAR;
            PG8_LDB(B0, 1, 0); PG8_SCHED; PG8_LDA(At, 1, 0); PG8_STAGE(PG8_SA(0, 1), a2 + hstepA, voffA);
            PG8_WAIT_L(8); PG8_BAR; PG8_WAIT_L(0); PG8_MMA(0, 0, At, B0); PG8_BAR; PG8_SCHED;
            PG8_LDB(B1, 1, 1); PG8_STAGE(PG8_SB(1, 0), b3, voffB);
            PG8_BAR; PG8_WAIT_L(0); PG8_MMA(0, 1, At, B1); PG8_BAR;
            PG8_LDA(At, 1, 1); PG8_STAGE(PG8_SA(1, 0), a3, voffA);
            PG8_BAR; PG8_WAIT_L(0); PG8_MMA(1, 0, At, B0); PG8_BAR; PG8_SCHED;
            PG8_STAGE(PG8_SB(1, 1), b3 + hstepB, voffB);
            PG8_WAIT_V(6); PG8_BAR; PG8_MMA(1, 1, At, B1); PG8_BAR;
            }
        }
        if constexpr (ALIGN_EPI) { if (wr == 0) PG8_BAR; }
        if constexpr (!Epi::AFTER_DRAIN) { E(acc, cur, wr, wc, fr, fq);
#ifdef PROBE_EPI_DUP
            if constexpr (Epi::PROBE_DUP) { asm volatile("" ::: "memory"); E(acc, cur, wr, wc, fr, fq); }
#endif
            S.done(cur); }
        if (!has_next) break;
#pragma unroll
        for (int a = 0; a < 2; ++a)
#pragma unroll
            for (int b = 0; b < 2; ++b)
#pragma unroll
                for (int m = 0; m < 4; ++m)
#pragma unroll
                    for (int n = 0; n < 2; ++n) acc[a][b][m][n] = (f32x4){0.f, 0.f, 0.f, 0.f};
        cur = nxt; cA = nA; cB = nB; ++ui;
        if constexpr (ALIGN_EPI) { if (wr == 1) PG8_BAR; }
    }
    PG8_WAIT_V(0);
    if constexpr (!ALIGN_EPI) { if (wr == 0) PG8_BAR; }
    PG8_BAR;
    if constexpr (Epi::AFTER_DRAIN) { E.fused(acc, cur, wr, wc, fr, fq, lds, wid, lane); S.done(cur); }
#undef PG8_SA
#undef PG8_SB
#undef PG8_STAGE
#undef PG8_LDA
#undef PG8_LDB
#undef PG8_MMA
#undef PG8_WAIT_V
#undef PG8_WAIT_L
#undef PG8_BAR
#undef PG8_SCHED
}
}

#define XB_TMO      128
#define XB_XCNT(j)  (256  + 64 * (j))
#define XB_XSUB(j)  (1280 + 64 * (j))
#define XB_XGEN(j)  (2304 + 64 * (j))
#define XB_TOP      3328
#define XB_TOPGEN   3392
#define XCD_BAR_WORDS 3456
#define XB_SPIN_CAP (1u << 18)

__device__ __forceinline__ unsigned xb_ld(unsigned* p)              { return __hip_atomic_load(p, __ATOMIC_RELAXED, __HIP_MEMORY_SCOPE_AGENT); }
__device__ __forceinline__ unsigned xb_add(unsigned* p, unsigned v) { return __hip_atomic_fetch_add(p, v, __ATOMIC_RELAXED, __HIP_MEMORY_SCOPE_AGENT); }
__device__ __forceinline__ unsigned xb_xcc_id() { return (unsigned)__builtin_amdgcn_s_getreg((3 << 11) | 20) & 0xFu; }
#define XB_SPIN(cond, bar) do { unsigned _sp = 0; while (cond) { __builtin_amdgcn_s_sleep(1); \
    if ((++_sp & 255u) == 0u) { if (xb_ld(&(bar)[XB_TMO])) break; if (_sp > XB_SPIN_CAP) { atomicAdd(&(bar)[XB_TMO], 1u); break; } } } } while (0)

struct XcdBarrier {
    unsigned* bar; unsigned x;
    volatile LAS unsigned* st;
};

__device__ __forceinline__ XcdBarrier xcd_barrier_post(unsigned* bar, volatile LAS unsigned* st) {
    XcdBarrier b; b.bar = bar; b.x = xb_xcc_id(); b.st = st;
    if (threadIdx.x == 0) (void)xb_add(&bar[XB_XCNT(b.x)], 1u);
    return b;
}
__device__ __forceinline__ void xcd_barrier_complete(unsigned* bar, unsigned x, unsigned& nloc, unsigned& nx) {
    const unsigned G = gridDim.x * gridDim.y * gridDim.z;
    unsigned sum, cnt, mine, sp = 0u;
    for (;;) {
        sum = 0u; cnt = 0u; mine = 0u;
#pragma unroll
        for (unsigned j = 0; j < 16; ++j) { const unsigned c = xb_ld(&bar[XB_XCNT(j)]); sum += c; cnt += (c > 0u) ? 1u : 0u; mine = (j == x) ? c : mine; }
        if (sum == G) break;
        __builtin_amdgcn_s_sleep(1);
        if ((++sp & 255u) == 0u) { if (xb_ld(&bar[XB_TMO])) break; if (sp > XB_SPIN_CAP) { atomicAdd(&bar[XB_TMO], 1u); break; } }
    }
    nloc = mine > 0u ? mine : 1u; nx = cnt > 0u ? cnt : 1u;
}

__device__ __forceinline__ void xcd_barrier(const XcdBarrier& b) {
    asm volatile("s_waitcnt vmcnt(0)" ::: "memory");
    __syncthreads();
    if (threadIdx.x == 0) {
        unsigned* bar = b.bar; asm volatile("" : "+s"(bar));
        __builtin_amdgcn_s_waitcnt(0);
        unsigned nloc = b.st[0], nx = b.st[1];
        unsigned bx = b.x; asm volatile("" : "+s"(bx));
        if (nloc == 0u) { xcd_barrier_complete(bar, bx, nloc, nx); b.st[0] = nloc; b.st[1] = nx; }
        const unsigned old = xb_add(&bar[XB_XSUB(bx)], 1u);
        const unsigned gen = old / nloc;
        if (old + 1u == (gen + 1u) * nloc) {
            __builtin_amdgcn_fence(__ATOMIC_RELEASE, "agent");
            asm volatile("s_waitcnt vmcnt(0)" ::: "memory");
            const unsigned og = xb_add(&bar[XB_TOP], 1u);
            const unsigned tg = og / nx;
            if (og + 1u == (tg + 1u) * nx) xb_add(&bar[XB_TOPGEN], 1u);
            else XB_SPIN(xb_ld(&bar[XB_TOPGEN]) == tg, bar);
            __builtin_amdgcn_fence(__ATOMIC_ACQUIRE, "agent");
            xb_add(&bar[XB_XGEN(bx)], 1u);
            asm volatile("s_waitcnt vmcnt(0)" ::: "memory");
        } else {
            XB_SPIN(xb_ld(&bar[XB_XGEN(bx)]) == gen, bar);
            __builtin_amdgcn_fence(__ATOMIC_ACQUIRE, "agent");
            asm volatile("s_waitcnt vmcnt(0)" ::: "memory");
        }
    }
    __syncthreads();
}
struct Params {
    const float* in[23];
    float* out;
    unsigned char* ws;
};

struct Ctx {
    LAS unsigned char* lds;
    int tid, lane, wave, G, blk;
};

__device__ __forceinline__ void transpose_item(const float* W, int ld, bf16* WT, int Kd, int k0, int n0, int drow0, LAS float* scr, int lane) {
#pragma unroll 8
    for (int i = 0; i < 32; ++i) { const int kk = 2 * i + (lane >> 5); scr[kk * 33 + (lane & 31)] = W[(size_t)(k0 + kk) * ld + n0 + (lane & 31)]; }
    LDS_WAIT(); asm volatile("" ::: "memory");
    const int c = lane & 7;
#pragma unroll
    for (int j = 0; j < 4; ++j) { const int n = (lane >> 3) + 8 * j; const LAS float* s = scr + (8 * c) * 33 + n;
        u32x4 o; o.x = cvt_pk_bf16(s[0 * 33], s[1 * 33]); o.y = cvt_pk_bf16(s[2 * 33], s[3 * 33]); o.z = cvt_pk_bf16(s[4 * 33], s[5 * 33]); o.w = cvt_pk_bf16(s[6 * 33], s[7 * 33]);
        *(u32x4*)(WT + (size_t)(drow0 + n) * Kd + k0 + 8 * c) = o; }
    LDS_WAIT(); asm volatile("" ::: "memory");
}

__device__ __forceinline__ void cvt_copy(const float* src, bf16* dst, size_t n8, size_t i0, size_t stride) {
    for (size_t i = i0; i < n8; i += stride) { const f32x4 a = *(const f32x4*)(src + i * 8), b = *(const f32x4*)(src + i * 8 + 4);
        u32x4 o; o.x = cvt_pk_bf16(a[0], a[1]); o.y = cvt_pk_bf16(a[2], a[3]); o.z = cvt_pk_bf16(b[0], b[1]); o.w = cvt_pk_bf16(b[2], b[3]);
        *(u32x4*)(dst + i * 8) = o; }
}

__device__ __forceinline__ void p0_prologue(const Params& P, const Ctx& C) {
    unsigned char* ws = P.ws;
    {
        LAS float* scr = (LAS float*)(C.lds + RING_OFF + C.wave * 16384);
        const int gw = C.blk * 8 + C.wave, NGW = C.G * 8;
        constexpr int I_IN = (D / 64) * (NQKV / 32), I_O = (D / 64) * (D / 32), I_G = (D / 64) * (DFF / 32), I_D = (DFF / 64) * (D / 32);
        constexpr int I_L = I_IN + I_O + 2 * I_G + I_D;
        for (int it = gw; it < 2 * I_L; it += NGW) {
            const int l = it / I_L; int r = it % I_L;
            if (r < I_IN) { const int nb = NQKV / 32, kb = r / nb, n0 = (r % nb) * 32;
                transpose_item(P.in[15] + (size_t)l * D * NIN, NIN, (bf16*)(ws + WS_WIN + l * SZ_WIN), D, kb * 64, n0, n0, scr, C.lane); continue; }
            r -= I_IN;
            if (r < I_O) { const int nb = D / 32, kb = r / nb, n0 = (r % nb) * 32;
                transpose_item(P.in[18] + (size_t)l * D * D, D, (bf16*)(ws + WS_WO + l * SZ_WO), D, kb * 64, n0, n0, scr, C.lane); continue; }
            r -= I_O;
            if (r < 2 * I_G) { const int up = r >= I_G; if (up) r -= I_G; const int nb = DFF / 32, kb = r / nb, n0 = (r % nb) * 32;
                const int drow0 = (n0 >> 7) * 256 + (n0 & 127) + (up ? 128 : 0);
                transpose_item(P.in[up ? 20 : 19] + (size_t)l * D * DFF, DFF, (bf16*)(ws + WS_WGU + l * SZ_WGU), D, kb * 64, n0, drow0, scr, C.lane); continue; }
            r -= 2 * I_G;
            { const int nb = D / 32, kb = r / nb, n0 = (r % nb) * 32;
                transpose_item(P.in[21] + (size_t)l * DFF * D, D, (bf16*)(ws + WS_WDN + l * SZ_WDN), DFF, kb * 64, n0, n0, scr, C.lane); }
        }
    }
    {
        const size_t i0 = (size_t)C.blk * 512 + C.tid, stride = (size_t)C.G * 512;
        cvt_copy(P.in[2], (bf16*)(ws + WS_CAK), SZ_CA / 16, i0, stride); cvt_copy(P.in[3], (bf16*)(ws + WS_CAV), SZ_CA / 16, i0, stride);
        cvt_copy(P.in[4], (bf16*)(ws + WS_CBK), SZ_CB / 16, i0, stride); cvt_copy(P.in[5], (bf16*)(ws + WS_CBV), SZ_CB / 16, i0, stride);
        cvt_copy(P.in[7], (bf16*)(ws + WS_CCK), SZ_CB / 16, i0, stride); cvt_copy(P.in[8], (bf16*)(ws + WS_CCV), SZ_CB / 16, i0, stride);
    }
    {
        __syncthreads();
        LAS float* st = (LAS float*)(C.lds + RING_OFF);
        for (int idx = C.tid; idx < NMIDX * D; idx += 512) { const int m = idx / D, k = idx % D;
            const float c = m < PB ? P.in[9][m * D + k] : P.in[10][(m - PB) * D + k];
            st[k * NMIDX + m] = c * fast_rcp(1.0f + fast_exp2(-c * LOG2E)); }
        __syncthreads();
        float* mod = (float*)(ws + WS_MOD);
        constexpr int KC = 256, NKC = D / KC, NNC = NMOD / 256;
        for (int it = C.wave * C.G + C.blk; it < 2 * NKC * NNC; it += 8 * C.G) {
            const int l = it / (NKC * NNC), r = it % (NKC * NNC), kc = r / NNC, nc = r % NNC, k0 = kc * KC, n0 = nc * 256 + C.lane * 4;
            const float* wp = P.in[11] + ((size_t)l * D + k0) * NMOD + n0;
            f32x4 acc[NMIDX];
#pragma unroll
            for (int m = 0; m < NMIDX; ++m) acc[m] = (f32x4){0.f, 0.f, 0.f, 0.f};
#pragma unroll 4
            for (int k = 0; k < KC; ++k) { const f32x4 w = *(const f32x4*)(wp + (size_t)k * NMOD);
                const LAS f32x4* sp = (const LAS f32x4*)(st + (k0 + k) * NMIDX); const f32x4 s0 = sp[0], s1 = sp[1], s2 = sp[2];
                acc[0] += w * s0[0]; acc[1] += w * s0[1]; acc[2] += w * s0[2]; acc[3] += w * s0[3];
                acc[4] += w * s1[0]; acc[5] += w * s1[1]; acc[6] += w * s1[2]; acc[7] += w * s1[3];
                acc[8] += w * s2[0]; acc[9] += w * s2[1]; acc[10] += w * s2[2]; acc[11] += w * s2[3]; }
            f32x4 bias = (f32x4){0.f, 0.f, 0.f, 0.f};
            if (kc == 0) bias = *(const f32x4*)(P.in[12] + (size_t)l * NMOD + n0);
#pragma unroll
            for (int m = 0; m < NMIDX; ++m) { float* mp = mod + ((size_t)l * NMIDX + m) * NMOD + n0;
#pragma unroll
                for (int j = 0; j < 4; ++j) __hip_atomic_fetch_add(mp + j, acc[m][j] + bias[j], __ATOMIC_RELAXED, __HIP_MEMORY_SCOPE_AGENT); }
        }
    }
}

template <bool WITH_LOGF>
__device__ __forceinline__ void norm_rows(const Ctx& C, const float* xrows, bf16* hrows, int nrows, const float* gvec, const float* shift, const float* scale,
                                          const LAS float* wf, const float* bf, float* lf_out) {
    f32x4 gm[8], sh[8];
#pragma unroll
    for (int j = 0; j < 8; ++j) { const int e = 4 * C.lane + 256 * j; const f32x4 g = *(const f32x4*)(gvec + e), sc = *(const f32x4*)(scale + e); sh[j] = *(const f32x4*)(shift + e); gm[j] = g * (sc + 1.0f); }
    for (int r = 0; r < nrows; ++r) {
        const float* xr = xrows + (size_t)r * D; f32x4 v[8]; float ss = 0.f;
#pragma unroll
        for (int j = 0; j < 8; ++j) { v[j] = *(const f32x4*)(xr + 4 * C.lane + 256 * j); ss += (v[j][0] * v[j][0] + v[j][1] * v[j][1]) + (v[j][2] * v[j][2] + v[j][3] * v[j][3]); }
        const float rstd = 1.0f / sqrtf(wave_sum(ss) * (1.0f / D) + EPS);
#pragma unroll
        for (int j = 0; j < 8; ++j) v[j] = v[j] * rstd * gm[j] + sh[j];
        bf16* hr = hrows + (size_t)r * D;
#pragma unroll
        for (int j = 0; j < 8; ++j) { u32x2 w; w.x = cvt_pk_bf16(v[j][0], v[j][1]); w.y = cvt_pk_bf16(v[j][2], v[j][3]); *(u32x2*)(hr + 4 * C.lane + 256 * j) = w; }
        if constexpr (WITH_LOGF) {
            float dots[6];
#pragma unroll
            for (int f = 0; f < 6; ++f) { float a = 0.f;
#pragma unroll
                for (int j = 0; j < 8; ++j) { const f32x4 w = *(const LAS f32x4*)(wf + f * D + 4 * C.lane + 256 * j); a += (v[j][0] * w[0] + v[j][1] * w[1]) + (v[j][2] * w[2] + v[j][3] * w[3]); }
                dots[f] = wave_sum(a); }
            if (C.lane < 6) { float z = C.lane == 0 ? dots[0] : C.lane == 1 ? dots[1] : C.lane == 2 ? dots[2] : C.lane == 3 ? dots[3] : C.lane == 4 ? dots[4] : dots[5];
                z += bf[C.lane];
                const float ls = fminf(z, 0.f) - LN2 * fast_log2(1.0f + fast_exp2(-fabsf(z) * LOG2E));
                lf_out[(size_t)r * HB + C.lane] = ls; }
        }
    }
}

__device__ __forceinline__ void sample_resid_row(const Ctx& C, const float* xin, float* xout, const float* part, int nkc, const float* gate) {
    f32x4 s[8];
#pragma unroll
    for (int j = 0; j < 8; ++j) s[j] = (f32x4){0.f, 0.f, 0.f, 0.f};
    for (int kc = 0; kc < nkc; ++kc) { const float* pp = part + (size_t)kc * MS * D;
#pragma unroll
        for (int j = 0; j < 8; ++j) s[j] += *(const f32x4*)(pp + 4 * C.lane + 256 * j); }
#pragma unroll
    for (int j = 0; j < 8; ++j) { const int e = 4 * C.lane + 256 * j; *(f32x4*)(xout + e) = *(const f32x4*)(xin + e) + *(const f32x4*)(gate + e) * s[j]; }
}
template <bool WITH_LOGF>
__device__ __forceinline__ void norm_phase(const Params& P, const Ctx& C, int layer, const float* xp, const float* xs, const float* gvec, int off_shift, int off_scale,
                                           int fix_nkc, const float* fix_mod, int fix_gate_off) {
    bf16* H = (bf16*)(P.ws + WS_H); const float* mod = (const float*)(P.ws + WS_MOD) + (size_t)layer * NMIDX * NMOD;
    LAS float* wf = (LAS float*)(C.lds + RING_OFF);
    if constexpr (WITH_LOGF) {
        const float* win = P.in[15] + (size_t)layer * D * NIN + NQKV;
        for (int idx = C.tid; idx < 6 * D; idx += 512) { const int k = idx / 6, f = idx % 6; wf[f * D + k] = win[(size_t)k * NIN + f]; }
        __syncthreads();
    }
    const float* bf = P.in[16] + layer * HB;
    float* lfp = P.out + O_BLF_P + (size_t)layer * PB * PT * HB; float* lfs = P.out + O_BLF_S + (size_t)layer * MS * HB;
    const int gw = C.blk * 8 + C.wave, NGW = C.G * 8;
    for (int it = gw; it < MP / 16; it += NGW) { const int r0 = it * 16, b = r0 >> 13; const float* mv = mod + (size_t)b * NMOD;
        norm_rows<WITH_LOGF>(C, xp + (size_t)r0 * D, H + (size_t)r0 * D, 16, gvec, mv + off_shift, mv + off_scale, wf, bf, lfp + (size_t)r0 * HB); }
    if (C.wave == 0) for (int r = C.blk; r < MS; r += C.G) { const float* mv = mod + (size_t)(PB + (r >> 5)) * NMOD; const float* xr = xs + (size_t)r * D;
        if (fix_nkc > 0) { float* xo = P.out + O_Y_S + (size_t)r * D;
            sample_resid_row(C, xr, xo, (const float*)(P.ws + WS_PART) + (size_t)r * D, fix_nkc, fix_mod + (size_t)(PB + (r >> 5)) * NMOD + fix_gate_off); xr = xo; }
        norm_rows<WITH_LOGF>(C, xr, H + (size_t)(MP + r) * D, 1, gvec, mv + off_shift, mv + off_scale, wf, bf, lfs + (size_t)r * HB); }
    __syncthreads();
}

__device__ __forceinline__ void final_norm(const Params& P, const Ctx& C) {
    const float* g = P.in[22]; f32x4 gm[8];
#pragma unroll
    for (int j = 0; j < 8; ++j) gm[j] = *(const f32x4*)(g + 4 * C.lane + 256 * j);
    const int gw = C.blk * 8 + C.wave, NGW = C.G * 8;
    for (int r = gw; r < MT; r += NGW) {
        float* xr = P.out + (size_t)r * D; f32x4 v[8]; float ss = 0.f;
        if (r >= MP) { const int rs = r - MP;
            sample_resid_row(C, xr, xr, (const float*)(P.ws + WS_PART) + (size_t)rs * D, DFF / 256, (const float*)(P.ws + WS_MOD) + ((size_t)NMIDX + PB + (rs >> 5)) * NMOD + 5 * D); }
#pragma unroll
        for (int j = 0; j < 8; ++j) { v[j] = *(const f32x4*)(xr + 4 * C.lane + 256 * j); ss += (v[j][0] * v[j][0] + v[j][1] * v[j][1]) + (v[j][2] * v[j][2] + v[j][3] * v[j][3]); }
        const float rstd = 1.0f / sqrtf(wave_sum(ss) * (1.0f / D) + EPS);
#pragma unroll
        for (int j = 0; j < 8; ++j) *(f32x4*)(xr + 4 * C.lane + 256 * j) = v[j] * rstd * gm[j];
    }
}


__device__ __forceinline__ float block_excl_scan(const Ctx& C, LAS float* red, float s) {
    float incl = s;
#pragma unroll
    for (int o = 1; o < 64; o <<= 1) { const float t = __shfl_up(incl, o); if (C.lane >= o) incl += t; }
    if (C.lane == 63) red[C.wave] = incl;
    __syncthreads();
    float base = 0.f;
    for (int w = 0; w < C.wave; ++w) base += red[w];
    return base + incl - s;
}

__device__ __forceinline__ void fcum_phase(const Params& P, const Ctx& C, int layer) {
    LAS float* red = (LAS float*)(C.lds + RING_OFF);
    if (C.blk < PB * HB) {
        const int b = C.blk / HB, h = C.blk % HB; const float* lf = P.out + O_BLF_P + ((size_t)(layer * PB + b) * PT) * HB + h;
        float* F = (float*)(P.ws + WS_FP) + ((size_t)b * PT) * HB + h;
        float v[16]; float s = 0.f;
#pragma unroll
        for (int i = 0; i < 16; ++i) { v[i] = lf[(size_t)(C.tid * 16 + i) * HB]; s += v[i]; }
        float a = block_excl_scan(C, red, s);
#pragma unroll
        for (int i = 0; i < 16; ++i) { a += v[i]; F[(size_t)(C.tid * 16 + i) * HB] = a; }
        __syncthreads();
    } else if (C.blk < PB * HB + SB * HB) {
        const int q = C.blk - PB * HB, sb = q / HB, h = q % HB; constexpr int L = PAST + ST;
        const float* cl = P.in[6] + ((size_t)(layer * SB + sb) * PAST) * HB + h; const float* nl = P.out + O_BLF_S + ((size_t)(layer * SB + sb) * ST) * HB + h;
        float* F = (float*)(P.ws + WS_FS) + ((size_t)sb * L) * HB + h;
        float v[3]; float s = 0.f;
#pragma unroll
        for (int i = 0; i < 3; ++i) { const int p = C.tid * 3 + i; v[i] = p < PAST ? cl[(size_t)p * HB] : (p < L ? nl[(size_t)(p - PAST) * HB] : 0.f); s += v[i]; }
        float a = block_excl_scan(C, red, s);
#pragma unroll
        for (int i = 0; i < 3; ++i) { const int p = C.tid * 3 + i; a += v[i]; if (p < L) F[(size_t)p * HB] = a; }
        __syncthreads();
    }
}

__device__ __forceinline__ void finish_qkv(const Params& P, const Ctx& C, int layer) {
    const float* part = (const float*)(P.ws + WS_PART); bf16* qkv = (bf16*)(P.ws + WS_QKV);
    for (int r = C.blk; r < MS; r += C.G)
        for (int c4 = C.tid; c4 < NQKV / 4; c4 += 512) { const int c = c4 * 4; f32x4 s = (f32x4){0.f, 0.f, 0.f, 0.f};
#pragma unroll
            for (int kc = 0; kc < 8; ++kc) s += *(const f32x4*)(part + ((size_t)kc * MS + r) * NQKV + c);
            u32x2 w; w.x = cvt_pk_bf16(s[0], s[1]); w.y = cvt_pk_bf16(s[2], s[3]); *(u32x2*)(qkv + (size_t)(MP + r) * LDQ + c) = w;
            const int which = c / D;
            if (which != 0) { const int hh = (c % D) / HD, d = c % HD; const bool isv = which == 2; float* dst;
                if (hh < HA) dst = P.out + (isv ? O_AV_S : O_AK_S) + ((size_t)(layer * MS + r) * HA + hh) * HD + d;
                else if (hh < HA + HB) dst = P.out + (isv ? O_BV_S : O_BK_S) + ((size_t)(layer * MS + r) * HB + (hh - HA)) * HD + d;
                else dst = P.out + (isv ? O_CV_S : O_CK_S) + ((size_t)(layer * MS + r) * HC + (hh - HA - HB)) * HD + d;
                *(f32x4*)dst = s; } }
}
__device__ __forceinline__ void finish_act(const Params& P, const Ctx& C) {
    const float* part = (const float*)(P.ws + WS_PART); bf16* act = (bf16*)(P.ws + WS_QKV);
    for (int r = C.blk; r < MS; r += C.G)
        for (int j4 = C.tid; j4 < DFF / 4; j4 += 512) { const int j = j4 * 4, cg = (j >> 7) * 256 + (j & 127); f32x4 g = (f32x4){0.f, 0.f, 0.f, 0.f}, up = g;
#pragma unroll
            for (int kc = 0; kc < 4; ++kc) { const float* pr = part + ((size_t)kc * MS + r) * (2 * DFF) + cg; g += *(const f32x4*)pr; up += *(const f32x4*)(pr + 128); }
            float o[4];
#pragma unroll
            for (int i = 0; i < 4; ++i) o[i] = g[i] * fast_rcp(1.0f + fast_exp2(-g[i] * LOG2E)) * up[i];
            u32x2 w; w.x = cvt_pk_bf16(o[0], o[1]); w.y = cvt_pk_bf16(o[2], o[3]); *(u32x2*)(act + (size_t)(MP + r) * DFF + j) = w; }
}

namespace att {
constexpr int KROW = 272, VROW = 144;
constexpr int KBUF = 64 * KROW, VBUF = 128 * VROW;
constexpr int OFF_K = 0, OFF_V = 2 * KBUF, OFF_FB = OFF_V + 2 * VBUF, OFF_REL = OFF_FB + 512, OFF_VOTE = OFF_REL + 1040, OFF_QW = OFF_VOTE + 64;
static_assert(OFF_QW + 16 <= RING_BYTES && (OFF_REL % 16) == 0 && (OFF_VOTE % 16) == 0, "attention LDS map");
constexpr float STICK_STOP = -105.0f;

struct Unit {
    const bf16* q; int nq, qpos0, kv_len, new_pos0;
    const bf16 *kn, *vn, *kc, *vc; int cstride;
    int t_hi, t_lo;
    const float* F; float fref;
    const float* rel;
};

__device__ __forceinline__ float partner32(float x, int hi) {
    auto rr = __builtin_amdgcn_permlane32_swap(__float_as_uint(x), __float_as_uint(x), false, false);
    return __uint_as_float(hi ? rr[0] : rr[1]);
}
__device__ __forceinline__ bf16x8 pack8(float a0, float a1, float a2, float a3, float a4, float a5, float a6, float a7) {
    u32x4 w = {cvt_pk_bf16(a0, a1), cvt_pk_bf16(a2, a3), cvt_pk_bf16(a4, a5), cvt_pk_bf16(a6, a7)};
    return __builtin_bit_cast(bf16x8, w);
}

template <int MODE>
__device__ __forceinline__ void run_unit(LAS unsigned char* lds, const Unit& u, int tid, int wave, int lane) {
    const int qr = lane & 31, hi = lane >> 5;
    const bool active = wave * 32 < u.nq;
    const int qpos_w0 = u.qpos0 + wave * 32, qpos = qpos_w0 + qr;
    int w_hi, w_lo;
    if (MODE == 0) { const int n = qpos_w0 >> 6; w_hi = n; w_lo = n - 8 > 0 ? n - 8 : 0; }
    else if (MODE == 1) { w_hi = (qpos_w0 + 31) >> 6; w_lo = 0; }
    else { w_hi = (qpos_w0 + 30) >> 6; w_lo = 0; }
    const int near_lo = (qpos_w0 >> 6) - 2;
    bf16x8 qf[8];
    { const bf16* qp = u.q + (size_t)((active ? wave * 32 : 0) + qr) * LDQ + 8 * hi;
#pragma unroll
      for (int ds = 0; ds < 8; ++ds) qf[ds] = *(const bf16x8*)(qp + 16 * ds); }
    LAS float* rel_l = (LAS float*)(lds + OFF_REL);
    if (MODE == 0) { for (int i = tid; i < 257; i += 512) rel_l[i] = u.rel[i * HA] * INV_SCALE; }
    f32x16 o[4];
#pragma unroll
    for (int b = 0; b < 4; ++b)
#pragma unroll
        for (int r = 0; r < 16; ++r) o[b][r] = 0.f;
    float m_run = -1e30f, l_run = 0.f, carry = 0.f;
    const int k_key = tid >> 4, k_dc = tid & 15;
    const int k_lds = k_key * KROW + k_dc * 16;
    const int v_dc = lane & 15, v_kq = lane >> 4;
    const int v_key0 = 16 * (wave >> 1) + 4 * (wave & 1) + 2 * (v_kq & 1) + 8 * (v_kq >> 1);
    const int v_pos0 = (v_key0 & ~0xC) | ((v_key0 & 4) << 1) | ((v_key0 & 8) >> 1);
    const int v_lds = (8 * v_dc) * VROW + ((((v_pos0 >> 3) ^ ((v_dc >> 1) & 7))) << 4) + (v_pos0 & 7) * 2;
    const int kr_lds = qr * KROW + hi * 16;
    const int vr_lds = qr * VROW + ((hi ^ (qr >> 4)) << 4);
    u32x4 kreg[2], vreg[2]; float freg = 0.f;
    auto stage_load = [&](int j) {
        const int last = u.kv_len - 1;
#pragma unroll
        for (int i = 0; i < 2; ++i) { int pos = 64 * j + k_key + 32 * i; pos = pos < last ? pos : last;
            const bf16* src = pos >= u.new_pos0 ? u.kn + (size_t)(pos - u.new_pos0) * LDQ : u.kc + (size_t)pos * u.cstride;
            kreg[i] = *(const u32x4*)(src + 8 * k_dc); }
#pragma unroll
        for (int i = 0; i < 2; ++i) { int pos = 64 * j + v_key0 + i; pos = pos < last ? pos : last;
            const bf16* src = pos >= u.new_pos0 ? u.vn + (size_t)(pos - u.new_pos0) * LDQ : u.vc + (size_t)pos * u.cstride;
            vreg[i] = *(const u32x4*)(src + 8 * v_dc); }
        if (MODE == 1 && tid < 64) { int pos = 64 * j + tid; pos = pos < last ? pos : last; freg = (u.fref - u.F[(size_t)pos * HB]) * INV_SCALE; }
    };
    auto stage_store = [&](int buf) {
        LAS unsigned char* kb = lds + OFF_K + buf * KBUF + k_lds;
        *(LAS u32x4*)kb = kreg[0]; *(LAS u32x4*)(kb + 32 * KROW) = kreg[1];
        LAS unsigned char* vb = lds + OFF_V + buf * VBUF + v_lds;
        const unsigned a[4] = {vreg[0].x, vreg[0].y, vreg[0].z, vreg[0].w}, b[4] = {vreg[1].x, vreg[1].y, vreg[1].z, vreg[1].w};
#pragma unroll
        for (int i = 0; i < 4; ++i) {
            *(LAS unsigned*)(vb + (2 * i) * VROW) = (a[i] & 0xffffu) | (b[i] << 16);
            *(LAS unsigned*)(vb + (2 * i + 1) * VROW) = (a[i] >> 16) | (b[i] & 0xffff0000u); }
        if (MODE == 1 && tid < 64) ((LAS float*)(lds + OFF_FB + buf * 256))[tid] = freg;
    };
    stage_load(u.t_hi);
    stage_store(0);
    LDS_WAIT(); __syncthreads();
    bool wave_done = !active;
    for (int j = u.t_hi, it = 0;; --j, ++it) {
        const int cur = it & 1;
        const bool more = j > u.t_lo;
        if (more) stage_load(j - 1);
        if (active && j <= w_hi && j >= w_lo && !(MODE == 2 && wave_done)) {
            f32x16 p0, p1;
            if (MODE == 1) { const LAS f32x4* fb = (const LAS f32x4*)(lds + OFF_FB + cur * 256);
#pragma unroll
                for (int g = 0; g < 4; ++g) { const f32x4 a = fb[2 * g + hi], b = fb[8 + 2 * g + hi];
#pragma unroll
                    for (int i = 0; i < 4; ++i) { p0[4 * g + i] = a[i]; p1[4 * g + i] = b[i]; } } }
            else if (MODE == 0) {
                if (j >= near_lo) { const int base = qpos - 64 * j - 4 * hi + 128;
#pragma unroll
                    for (int r = 0; r < 16; ++r) { const int c = (r & 3) + 8 * (r >> 2); int i0 = base - c, i1 = base - c - 32; i0 = i0 < 256 ? i0 : 256; i1 = i1 < 256 ? i1 : 256;
                        p0[r] = rel_l[i0]; p1[r] = rel_l[i1]; } }
                else { const float cb = rel_l[256];
#pragma unroll
                    for (int r = 0; r < 16; ++r) { p0[r] = cb; p1[r] = cb; } } }
            else {
#pragma unroll
                for (int r = 0; r < 16; ++r) { p0[r] = 0.f; p1[r] = 0.f; } }
            { const LAS unsigned char* kb = lds + OFF_K + cur * KBUF + kr_lds;
#pragma unroll
              for (int ds = 0; ds < 8; ++ds) { const bf16x8 k0 = *(const LAS bf16x8*)(kb + 32 * ds), k1 = *(const LAS bf16x8*)(kb + 32 * KROW + 32 * ds);
                  p0 = __builtin_amdgcn_mfma_f32_32x32x16_bf16(k0, qf[ds], p0, 0, 0, 0); p1 = __builtin_amdgcn_mfma_f32_32x32x16_bf16(k1, qf[ds], p1, 0, 0, 0); } }
            const int kp0 = 64 * j + 4 * hi;
            if (MODE != 2) {
                const bool need_mask = MODE == 1 ? (64 * j + 63 > qpos_w0) : (64 * j + 63 >= u.kv_len);
                if (need_mask) { const int lim = MODE == 1 ? qpos + 1 : u.kv_len;
#pragma unroll
                    for (int r = 0; r < 16; ++r) { const int kp = kp0 + (r & 3) + 8 * (r >> 2);
                        if (kp >= lim) p0[r] = -__builtin_inff(); if (kp + 32 >= lim) p1[r] = -__builtin_inff(); } }
                float mx = fmaxf(p0[0], p1[0]);
#pragma unroll
                for (int r = 1; r < 16; ++r) mx = fmaxf(mx, fmaxf(p0[r], p1[r]));
                mx = fmaxf(mx, partner32(mx, hi));
                const float mn = fmaxf(m_run, mx);
                constexpr float C2 = ATT_SCALE * LOG2E;
                if (__any(mn > m_run)) { const float alpha = fast_exp2((m_run - mn) * C2); l_run *= alpha; m_run = mn;
#pragma unroll
                    for (int b = 0; b < 4; ++b)
#pragma unroll
                        for (int r = 0; r < 16; ++r) o[b][r] *= alpha; }
                const float mc = m_run * C2; float ps = 0.f;
#pragma unroll
                for (int r = 0; r < 16; ++r) { p0[r] = fast_exp2(p0[r] * C2 - mc); p1[r] = fast_exp2(p1[r] * C2 - mc); ps += p0[r] + p1[r]; }
                l_run += ps;
            } else {
                const bool need_mask = 64 * j + 63 >= qpos_w0;
                float ls0[16], ls1[16];
#pragma unroll
                for (int r = 0; r < 16; ++r) {
                    const float z0 = p0[r] * ATT_SCALE, z1 = p1[r] * ATT_SCALE;
                    const float sp0 = fmaxf(z0, 0.f) + LN2 * fast_log2(1.0f + fast_exp2(-fabsf(z0) * LOG2E)), sp1 = fmaxf(z1, 0.f) + LN2 * fast_log2(1.0f + fast_exp2(-fabsf(z1) * LOG2E));
                    p0[r] = z0 - sp0; p1[r] = z1 - sp1;
                    ls0[r] = -sp0; ls1[r] = -sp1; }
                if (need_mask) {
#pragma unroll
                    for (int r = 0; r < 16; ++r) { const int kp = kp0 + (r & 3) + 8 * (r >> 2);
                        if (kp >= qpos) { ls0[r] = 0.f; p0[r] = -__builtin_inff(); } if (kp + 32 >= qpos) { ls1[r] = 0.f; p1[r] = -__builtin_inff(); } } }
                float a[8], b[8], t[8];
#pragma unroll
                for (int g = 0; g < 4; ++g) { a[g] = (ls0[4 * g] + ls0[4 * g + 1]) + (ls0[4 * g + 2] + ls0[4 * g + 3]); a[4 + g] = (ls1[4 * g] + ls1[4 * g + 1]) + (ls1[4 * g + 2] + ls1[4 * g + 3]); }
#pragma unroll
                for (int g = 0; g < 8; ++g) { b[g] = partner32(a[g], hi); t[g] = a[g] + b[g]; }
                float ps = carry;
#pragma unroll
                for (int g = 7; g >= 0; --g) {
                    const float sg = ps + (hi ? 0.f : b[g]);
                    if (g < 4) { const float e3 = sg, e2 = e3 + ls0[4 * g + 3], e1 = e2 + ls0[4 * g + 2], e0 = e1 + ls0[4 * g + 1];
                        p0[4 * g + 3] = fast_exp2((p0[4 * g + 3] + e3) * LOG2E); p0[4 * g + 2] = fast_exp2((p0[4 * g + 2] + e2) * LOG2E);
                        p0[4 * g + 1] = fast_exp2((p0[4 * g + 1] + e1) * LOG2E); p0[4 * g] = fast_exp2((p0[4 * g] + e0) * LOG2E); }
                    else { const int gg = g - 4; const float e3 = sg, e2 = e3 + ls1[4 * gg + 3], e1 = e2 + ls1[4 * gg + 2], e0 = e1 + ls1[4 * gg + 1];
                        p1[4 * gg + 3] = fast_exp2((p1[4 * gg + 3] + e3) * LOG2E); p1[4 * gg + 2] = fast_exp2((p1[4 * gg + 2] + e2) * LOG2E);
                        p1[4 * gg + 1] = fast_exp2((p1[4 * gg + 1] + e1) * LOG2E); p1[4 * gg] = fast_exp2((p1[4 * gg] + e0) * LOG2E); }
                    ps += t[g];
                }
                carry = ps;
                wave_done = __all(carry < STICK_STOP) || j == 0;
            }
            { const LAS unsigned char* vb = lds + OFF_V + cur * VBUF + vr_lds;
#pragma unroll
              for (int s = 0; s < 4; ++s) {
                  bf16x8 pf;
                  if (s == 0) pf = pack8(p0[0], p0[1], p0[2], p0[3], p0[4], p0[5], p0[6], p0[7]);
                  else if (s == 1) pf = pack8(p0[8], p0[9], p0[10], p0[11], p0[12], p0[13], p0[14], p0[15]);
                  else if (s == 2) pf = pack8(p1[0], p1[1], p1[2], p1[3], p1[4], p1[5], p1[6], p1[7]);
                  else pf = pack8(p1[8], p1[9], p1[10], p1[11], p1[12], p1[13], p1[14], p1[15]);
#pragma unroll
                  for (int db = 0; db < 4; ++db) { const bf16x8 vf = *(const LAS bf16x8*)(vb + 32 * db * VROW + ((s ^ db) << 5));
                      o[db] = __builtin_amdgcn_mfma_f32_32x32x16_bf16(vf, pf, o[db], 0, 0, 0); } } }
        }
        if (more) stage_store(cur ^ 1);
        if (MODE == 2 && lane == 0) ((LAS unsigned*)(lds + OFF_VOTE))[cur * 8 + wave] = (wave_done || j - 1 < w_lo) ? 1u : 0u;
        LDS_WAIT(); __syncthreads();
        if (!more) break;
        if (MODE == 2) { const LAS u32x4* vv = (const LAS u32x4*)(lds + OFF_VOTE + cur * 32); const u32x4 x = vv[0], y = vv[1];
            if ((x.x & x.y & x.z & x.w & y.x & y.y & y.z & y.w) != 0u) break; }
    }
    if (active) {
        float inv = 1.0f;
        if (MODE != 2) { const float lt = l_run + partner32(l_run, hi); inv = 1.0f / lt; }
        bf16* op = (bf16*)u.q + (size_t)(wave * 32 + qr) * LDQ + 4 * hi;
#pragma unroll
        for (int db = 0; db < 4; ++db)
#pragma unroll
            for (int g = 0; g < 4; ++g) { u32x2 w; w.x = cvt_pk_bf16(o[db][4 * g] * inv, o[db][4 * g + 1] * inv); w.y = cvt_pk_bf16(o[db][4 * g + 2] * inv, o[db][4 * g + 3] * inv);
                *(u32x2*)(op + 32 * db + 8 * g) = w; }
    }
    __syncthreads();
}

__device__ __forceinline__ int pull(LAS unsigned char* lds, unsigned* counter, int tid) {
    LAS int* qw = (LAS int*)(lds + OFF_QW);
    if (tid == 0) *qw = (int)__hip_atomic_fetch_add(counter, 1u, __ATOMIC_RELAXED, __HIP_MEMORY_SCOPE_AGENT);
    LDS_WAIT(); __syncthreads();
    const int v = *qw;
    __syncthreads();
    return v;
}

template <int MODE>
__device__ __forceinline__ void mode_loop(const Params& P, const Ctx& C, int layer) {
    constexpr int NHG = MODE == 0 ? HA : HB;
    constexpr int H0 = MODE == 0 ? 0 : (MODE == 1 ? HA : HA + HB);
    constexpr int NPU = PB * NHG * (PT / 256), NSU = SB * NHG;
    unsigned* counter = (unsigned*)(P.ws + WS_CTL) + CW_QUEUE + 64 * (layer * 3 + MODE);
    const bf16* qkv = (const bf16*)(P.ws + WS_QKV);
    for (;;) {
        const int i = pull(C.lds, counter, C.tid);
        if (i >= NPU + NSU) break;
        Unit u;
        if (i < NPU) {
            const int qb = (PT / 256 - 1) - i / (PB * NHG), bh = i % (PB * NHG), b = bh / NHG, hg = bh % NHG, hh = H0 + hg;
            const size_t row0 = (size_t)b * PT;
            u.q = qkv + (row0 + (size_t)qb * 256) * LDQ + hh * HD; u.nq = 256; u.qpos0 = qb * 256; u.kv_len = PT; u.new_pos0 = 0;
            u.kn = qkv + row0 * LDQ + D + hh * HD; u.vn = qkv + row0 * LDQ + 2 * D + hh * HD; u.kc = u.kn; u.vc = u.vn; u.cstride = LDQ;
            u.t_hi = 4 * qb + 3; u.t_lo = MODE == 0 ? (4 * qb - 8 > 0 ? 4 * qb - 8 : 0) : 0;
            u.F = (const float*)(P.ws + WS_FP) + row0 * HB + hg; u.fref = MODE == 1 ? u.F[(size_t)u.qpos0 * HB] : 0.f;
            u.rel = P.in[17] + (size_t)layer * 257 * HA + hh;
        } else {
            const int s = i - NPU, sb = s / NHG, hg = s % NHG, hh = H0 + hg;
            constexpr int CL = MODE == 0 ? AWIN : PAST;
            const size_t row0 = (size_t)MP + (size_t)sb * ST;
            u.q = qkv + row0 * LDQ + hh * HD; u.nq = ST; u.qpos0 = CL; u.kv_len = CL + ST; u.new_pos0 = CL;
            u.kn = qkv + row0 * LDQ + D + hh * HD; u.vn = qkv + row0 * LDQ + 2 * D + hh * HD;
            const size_t coff = ((size_t)(layer * SB + sb) * CL * NHG + hg) * HD;
            u.kc = (const bf16*)(P.ws + (MODE == 0 ? WS_CAK : (MODE == 1 ? WS_CBK : WS_CCK))) + coff; u.vc = (const bf16*)(P.ws + (MODE == 0 ? WS_CAV : (MODE == 1 ? WS_CBV : WS_CCV))) + coff;
            u.cstride = NHG * HD;
            u.t_hi = (CL + ST - 1) >> 6; u.t_lo = 0;
            u.F = (const float*)(P.ws + WS_FS) + (size_t)sb * (PAST + ST) * HB + hg; u.fref = MODE == 1 ? u.F[(size_t)u.qpos0 * HB] : 0.f;
            u.rel = P.in[17] + (size_t)layer * 257 * HA + hh;
        }
        run_unit<MODE>(C.lds, u, C.tid, C.wave, C.lane);
    }
}
}

#ifndef PHASE_MASK
#define PHASE_MASK 0xFFF
#endif
#define PH(n) ((PHASE_MASK >> (n)) & 1)
#ifndef DUP_MASK
#define DUP_MASK 0
#endif
#define DUP(n) ((DUP_MASK >> (n)) & 1)
typedef const Params __attribute__((address_space(4)))* KParams;
__device__ __forceinline__ const Params& kparams() {
    KParams p = (KParams)__builtin_amdgcn_kernarg_segment_ptr(); asm volatile("" : "+s"(p)); return *(const Params*)p;
}
#define P (kparams())
__device__ __forceinline__ Ctx make_ctx(LAS unsigned char* lds) {
    Ctx C; int t = threadIdx.x; asm volatile("" : "+v"(t));
    C.lds = lds; C.tid = t; C.lane = t & 63; C.wave = __builtin_amdgcn_readfirstlane(t >> 6); C.G = gridDim.x; C.blk = blockIdx.x; return C;
}
__global__ void __launch_bounds__(512, 2) hse_fwd(Params P_unused) {
    extern __shared__ __attribute__((aligned(16))) unsigned char lds_raw[];
    LAS unsigned char* const lds = (LAS unsigned char*)lds_raw;
    volatile LAS unsigned* MISC = (volatile LAS unsigned*)(lds + MISC_OFF);
    if (threadIdx.x < 64) MISC[threadIdx.x] = 0u;
    __syncthreads();
    XcdBarrier bar = xcd_barrier_post((unsigned*)(P.ws + WS_CTL) + CW_BAR, MISC + 8);

    if (PH(0)) { const Params& Q = P; const Ctx C = make_ctx(lds); p0_prologue(Q, C); }
    xcd_barrier(bar);


#pragma unroll 1
    for (int layer = 0; layer < 2; ++layer) {
        if (PH(1)) { const Params& Q = P; const Ctx C = make_ctx(lds); norm_phase<true>(Q, C, layer, layer == 0 ? Q.in[0] : Q.out + O_Y_P, layer == 0 ? Q.in[1] : Q.out + O_Y_S, Q.in[13] + layer * D, 0, D,
                                      layer == 0 ? 0 : DFF / 256, (const float*)(Q.ws + WS_MOD), 5 * D); }
        xcd_barrier(bar);
        if (PH(2)) { const Params& Q = P; const Ctx C = make_ctx(lds); fcum_phase(Q, C, layer); }
        if (PH(3)) { const Params& Q = P; const Ctx C = make_ctx(lds); pg8::Gemm g{(const bf16*)(Q.ws + WS_H), (const bf16*)(Q.ws + WS_WIN + layer * SZ_WIN)}; pg8::StaticOrder<MP / 256, NQKV / 256> S; S.init(C.G, C.blk);
          pg8::EpiQKV E{(bf16*)(Q.ws + WS_QKV), Q.out, layer};
          pg8::gemm_phase<pg8::EpiQKV, pg8::StaticOrder<MP / 256, NQKV / 256>, true, true, D, D>(C.lds + RING_OFF, g, S, E);
          if (DUP(3)) { __syncthreads(); pg8::gemm_phase<pg8::EpiQKV, pg8::StaticOrder<MP / 256, NQKV / 256>, true, true, D, D>(C.lds + RING_OFF, g, S, E); }
          pg8::SampleOrder<MP / 256, NQKV / 256, 8> SS; SS.init(C.G, C.blk); pg8::EpiPartial<NQKV> EP{(float*)(Q.ws + WS_PART)};
          pg8::gemm_phase<pg8::EpiPartial<NQKV>, pg8::SampleOrder<MP / 256, NQKV / 256, 8>, true, true, 256, D, D>(C.lds + RING_OFF, g, SS, EP); }
        xcd_barrier(bar);
        if (PH(3)) { const Params& Q = P; const Ctx C = make_ctx(lds); finish_qkv(Q, C, layer); }
        xcd_barrier(bar);
        if (PH(4)) { const Params& Q = P; const Ctx C = make_ctx(lds); att::mode_loop<1>(Q, C, layer); }
        if (PH(5)) { const Params& Q = P; const Ctx C = make_ctx(lds); att::mode_loop<0>(Q, C, layer); }
        if (PH(6)) { const Params& Q = P; const Ctx C = make_ctx(lds); att::mode_loop<2>(Q, C, layer); }
        xcd_barrier(bar);
        if (PH(7)) { const Params& Q = P; const Ctx C = make_ctx(lds); pg8::Gemm g{(const bf16*)(Q.ws + WS_QKV), (const bf16*)(Q.ws + WS_WO + layer * SZ_WO)}; pg8::StaticOrder<MP / 256, D / 256> S; S.init(C.G, C.blk);
          pg8::EpiResid E{layer == 0 ? Q.in[0] : Q.out + O_Y_P, Q.out + O_Y_P, (const float*)(Q.ws + WS_MOD) + (size_t)layer * NMIDX * NMOD + 2 * D};
          pg8::gemm_phase<pg8::EpiResid, pg8::StaticOrder<MP / 256, D / 256>, true, true, D, LDQ>(C.lds + RING_OFF, g, S, E);
          pg8::SampleOrder<MP / 256, D / 256, 8> SS; SS.init(C.G, C.blk); pg8::EpiPartial<D> EP{(float*)(Q.ws + WS_PART)};
          pg8::gemm_phase<pg8::EpiPartial<D>, pg8::SampleOrder<MP / 256, D / 256, 8>, true, true, 256, LDQ, D>(C.lds + RING_OFF, g, SS, EP); }
        xcd_barrier(bar);
        if (PH(8)) { const Params& Q = P; const Ctx C = make_ctx(lds); norm_phase<false>(Q, C, layer, Q.out + O_Y_P, layer == 0 ? Q.in[1] : Q.out + O_Y_S, Q.in[14] + layer * D, 3 * D, 4 * D,
                                       D / 256, (const float*)(Q.ws + WS_MOD) + (size_t)layer * NMIDX * NMOD, 2 * D); }
        xcd_barrier(bar);
        if (PH(9)) { const Params& Q = P; const Ctx C = make_ctx(lds); pg8::Gemm g{(const bf16*)(Q.ws + WS_H), (const bf16*)(Q.ws + WS_WGU + layer * SZ_WGU)}; pg8::StaticOrder<MP / 256, 2 * DFF / 256> S; S.init(C.G, C.blk);
          pg8::EpiSwiGLU E{(bf16*)(Q.ws + WS_QKV)};
          pg8::gemm_phase<pg8::EpiSwiGLU, pg8::StaticOrder<MP / 256, 2 * DFF / 256>, true, true, D, D>(C.lds + RING_OFF, g, S, E);
          if (DUP(9)) { __syncthreads(); pg8::gemm_phase<pg8::EpiSwiGLU, pg8::StaticOrder<MP / 256, 2 * DFF / 256>, true, true, D, D>(C.lds + RING_OFF, g, S, E); }
          pg8::SampleOrder<MP / 256, 2 * DFF / 256, 4> SS; SS.init(C.G, C.blk); pg8::EpiPartial<2 * DFF> EP{(float*)(Q.ws + WS_PART)};
          pg8::gemm_phase<pg8::EpiPartial<2 * DFF>, pg8::SampleOrder<MP / 256, 2 * DFF / 256, 4>, true, true, 512, D, D>(C.lds + RING_OFF, g, SS, EP); }
        xcd_barrier(bar);
        if (PH(9)) { const Params& Q = P; const Ctx C = make_ctx(lds); finish_act(Q, C); }
        xcd_barrier(bar);
        if (PH(10)) { const Params& Q = P; const Ctx C = make_ctx(lds); pg8::Gemm g{(const bf16*)(Q.ws + WS_QKV), (const bf16*)(Q.ws + WS_WDN + layer * SZ_WDN)}; pg8::StaticOrder<MP / 256, D / 256> S; S.init(C.G, C.blk);
          pg8::EpiResid E{Q.out + O_Y_P, Q.out + O_Y_P, (const float*)(Q.ws + WS_MOD) + (size_t)layer * NMIDX * NMOD + 5 * D};
          pg8::gemm_phase<pg8::EpiResid, pg8::StaticOrder<MP / 256, D / 256>, true, true, DFF, DFF>(C.lds + RING_OFF, g, S, E);
          pg8::SampleOrder<MP / 256, D / 256, DFF / 256> SS; SS.init(C.G, C.blk); pg8::EpiPartial<D> EP{(float*)(Q.ws + WS_PART)};
          pg8::gemm_phase<pg8::EpiPartial<D>, pg8::SampleOrder<MP / 256, D / 256, DFF / 256>, true, true, 256, DFF, DFF>(C.lds + RING_OFF, g, SS, EP); }
        xcd_barrier(bar);
    }
    if (PH(11)) { const Params& Q = P; const Ctx C = make_ctx(lds); final_norm(Q, C); }
}
#undef P

extern "C" void kernel_launch(void* const* d_in, const int* in_sizes, int n_in, void* d_out, int out_size, void* d_ws, size_t ws_size, hipStream_t stream) {
    static int grid = 0;
    if (grid == 0) {
        if (n_in != 23 || (size_t)out_size != O_END || ws_size < WS_END) {
            fprintf(stderr, "kernel_launch: unexpected shapes (n_in %d, out %d (want %zu), ws %zu (want >= %zu)); nothing launched\n", n_in, out_size, (size_t)O_END, ws_size, (size_t)WS_END); grid = -1; return; }
        int dev = 0, cus = 0, per_cu = 0;
        if (hipGetDevice(&dev) != hipSuccess || hipDeviceGetAttribute(&cus, hipDeviceAttributeMultiprocessorCount, dev) != hipSuccess) { grid = -1; return; }
        if (hipFuncSetAttribute((const void*)hse_fwd, hipFuncAttributeMaxDynamicSharedMemorySize, LDS_BYTES) != hipSuccess) { fprintf(stderr, "kernel_launch: hipFuncSetAttribute failed\n"); grid = -1; return; }
        if (hipOccupancyMaxActiveBlocksPerMultiprocessor(&per_cu, (const void*)hse_fwd, 512, LDS_BYTES) != hipSuccess || per_cu < 1) { fprintf(stderr, "kernel_launch: occupancy query says %d\n", per_cu); (void)hipGetLastError(); grid = -1; return; }
        grid = cus;
    }
    if (grid < 0) return;
    (void)in_sizes;
    if (hipMemsetAsync((char*)d_ws + WS_CTL, 0, CTL_ZERO_BYTES, stream) != hipSuccess) return;
    Params p{};
    for (int i = 0; i < 23; ++i) p.in[i] = (const float*)d_in[i];
    p.out = (float*)d_out; p.ws = (unsigned char*)d_ws;
    hipLaunchKernelGGL(hse_fwd, dim3(grid), dim3(512), LDS_BYTES, stream, p);
}
```

```cpp
#include <hip/hip_runtime.h>
#include <cstdio>
#include <cstdint>

#define LAS __attribute__((address_space(3)))
#define GAS __attribute__((address_space(1)))
typedef unsigned short bf16;
typedef short bf16x8 __attribute__((ext_vector_type(8)));
typedef float f32x4 __attribute__((ext_vector_type(4)));
typedef float f32x2 __attribute__((ext_vector_type(2)));
typedef float f32x16 __attribute__((ext_vector_type(16)));
typedef unsigned u32x4 __attribute__((ext_vector_type(4)));
typedef unsigned u32x2 __attribute__((ext_vector_type(2)));

constexpr int D = 2048, NH = 16, HD = 128, DFF = 5632, NQKV = 6144, NIN = 6150, NMOD = 6 * D;
constexpr int PB = 4, PT = 8192, SB = 8, ST = 32, PAST = 1024, AWIN = 512;
constexpr int HA = 4, HB = 6, HC = 6;
constexpr int MP = PB * PT, MS = SB * ST, MT = MP + MS;
#ifndef ROWPAD
#define ROWPAD 64
#endif
constexpr int LDQ = NQKV + ROWPAD, LDH = D + ROWPAD, LDACT = DFF + ROWPAD, LDW = D + ROWPAD, LDWD = DFF + ROWPAD;
constexpr float EPS = 1e-6f;
constexpr float ATT_SCALE = 0.08838834764831845f, INV_SCALE = 11.313708498984761f, LOG2E = 1.4426950408889634f, LN2 = 0.6931471805599453f;
constexpr int NMIDX = PB + SB;

constexpr size_t O_Y_P = 0;
constexpr size_t O_Y_S = O_Y_P + (size_t)MP * D;
constexpr size_t O_AK_P = O_Y_S + (size_t)MS * D;
constexpr size_t SZ_A_P = (size_t)2 * PB * AWIN * HA * HD, SZ_B_P = (size_t)2 * PB * PT * HB * HD, SZ_LF_P = (size_t)2 * PB * PT * HB;
constexpr size_t SZ_A_S = (size_t)2 * SB * ST * HA * HD, SZ_B_S = (size_t)2 * SB * ST * HB * HD, SZ_LF_S = (size_t)2 * SB * ST * HB;
constexpr size_t O_AV_P = O_AK_P + SZ_A_P, O_BK_P = O_AV_P + SZ_A_P, O_BV_P = O_BK_P + SZ_B_P, O_BLF_P = O_BV_P + SZ_B_P, O_CK_P = O_BLF_P + SZ_LF_P, O_CV_P = O_CK_P + SZ_B_P;
constexpr size_t O_AK_S = O_CV_P + SZ_B_P, O_AV_S = O_AK_S + SZ_A_S, O_BK_S = O_AV_S + SZ_A_S, O_BV_S = O_BK_S + SZ_B_S, O_BLF_S = O_BV_S + SZ_B_S, O_CK_S = O_BLF_S + SZ_LF_S, O_CV_S = O_CK_S + SZ_B_S;
constexpr size_t O_END = O_CV_S + SZ_B_S;

constexpr size_t MiB = 1u << 20;
constexpr size_t WS_CTL = 0, CTL_ZERO_BYTES = 6 * MiB;
constexpr size_t WS_MOD = 2 * MiB;
constexpr size_t SZ_WIN = (size_t)NQKV * LDW * 2, SZ_WO = (size_t)D * LDW * 2, SZ_WGU = (size_t)2 * DFF * LDW * 2, SZ_WDN = (size_t)D * LDWD * 2;
constexpr size_t WS_KN2 = 4 * MiB;
constexpr size_t WS_WIN = 6 * MiB, WS_WO = WS_WIN + 2 * SZ_WIN, WS_WGU = WS_WO + 2 * SZ_WO, WS_WDN = WS_WGU + 2 * SZ_WGU;
constexpr size_t WS_H = WS_WDN + 2 * SZ_WDN;
constexpr size_t WS_QKV = WS_H + (size_t)MT * LDH * 2;
constexpr size_t WS_CACHE = WS_QKV + (size_t)MT * LDQ * 2;
constexpr size_t SZ_CA = (size_t)2 * SB * AWIN * HA * HD * 2, SZ_CB = (size_t)2 * SB * PAST * HB * HD * 2;
constexpr size_t WS_CAK = WS_CACHE, WS_CAV = WS_CAK + SZ_CA, WS_CBK = WS_CAV + SZ_CA, WS_CBV = WS_CBK + SZ_CB, WS_CCK = WS_CBV + SZ_CB, WS_CCV = WS_CCK + SZ_CB;
constexpr size_t WS_FP = WS_CCV + SZ_CB;
constexpr size_t WS_FS = WS_FP + (size_t)PB * PT * HB * 4;
constexpr size_t WS_PART = (WS_FS + (size_t)SB * (PAST + ST) * HB * 4 + 4095) / 4096 * 4096;
constexpr size_t WS_END = WS_PART + (size_t)8 * MS * NQKV * 4 + 4096;
static_assert((size_t)4 * MS * 2 * DFF * 4 <= (size_t)8 * MS * NQKV * 4 && (size_t)22 * MS * D * 4 <= (size_t)8 * MS * NQKV * 4, "partials buffer");
static_assert((size_t)MT * LDACT * 2 <= (size_t)MT * LDQ * 2, "ACT overlays QKV");
constexpr int CW_TMO = 0, CW_BAR = 4096, CW_QUEUE = 16384;

constexpr int RING_OFF = 0, RING_BYTES = 131072;
constexpr int MISC_OFF = RING_BYTES;
constexpr int LDS_BYTES = 147456;

#define LDS_WAIT() asm volatile("s_waitcnt lgkmcnt(0)" ::: "memory")
#define VM_WAIT() asm volatile("s_waitcnt vmcnt(0)" ::: "memory")
__device__ __forceinline__ unsigned cvt_pk_bf16(float lo, float hi) { unsigned r; asm volatile("v_cvt_pk_bf16_f32 %0, %1, %2" : "=v"(r) : "v"(lo), "v"(hi)); return r; }
__device__ __forceinline__ float fast_exp2(float x) { return __builtin_amdgcn_exp2f(x); }
__device__ __forceinline__ float fast_log2(float x) { return __builtin_amdgcn_logf(x); }
__device__ __forceinline__ float fast_rcp(float x) { return __builtin_amdgcn_rcpf(x); }
__device__ __forceinline__ float wave_sum(float v) {
#pragma unroll
    for (int o = 1; o < 64; o <<= 1) v += __shfl_xor(v, o);
    return v;
}
namespace pg8 {
#define PG8_LAS __attribute__((address_space(3)))
typedef unsigned short bf16_t;
typedef short bf16x8 __attribute__((ext_vector_type(8)));
typedef float f32x4 __attribute__((ext_vector_type(4)));
typedef unsigned u32x4 __attribute__((ext_vector_type(4)));
constexpr int BM = 256, BK = 64, HALF = 128, HTB = HALF * BK * 2  , STAGE_BYTES = 8 * HTB, NXCD = 8, WGM = 8;

__host__ __device__ __forceinline__ int lds_byte(int r, int c) { const int st = (r >> 4) * 2 + (c >> 5), rr = r & 15, cc = c & 31, ob = rr * 64 + cc * 2; return st * 1024 + (ob ^ (((ob >> 9) & 1) << 5)); }
__host__ __device__ __forceinline__ void stage_rc(int b, int& R, int& C) { const int st = b / 1024, sb = b % 1024, swz = sb ^ (((sb >> 9) & 1) << 5); R = (st >> 1) * 16 + swz / 64; C = (st & 1) * 32 + (swz % 64) / 2; }
__host__ __device__ __forceinline__ int perm32(int rho) { const int n = rho >> 4, i = rho & 15; return 8 * (i >> 2) + 4 * n + (i & 3); }

struct Unit { int pm, pn, kc; };
struct Gemm { const bf16_t* A; const bf16_t* Bt; };

template <int NM, int NN> struct StaticOrder {
    int G, c;
    __host__ __device__ void init(int G_, int c_) { G = G_; c = c_; }
    __host__ __device__ bool next(int i, Unit& u) const {
        constexpr int nM = NM, nN = NN, nwg = NM * NN;
        const int L = i * G + c; if (L >= nwg) return false;
        int wgid = L; { constexpr int q = nwg / NXCD, r = nwg % NXCD; const int xcd = wgid % NXCD, off = wgid / NXCD; wgid = (xcd < r ? xcd * (q + 1) : r * (q + 1) + (xcd - r) * q) + off; }
        constexpr int nig = WGM * nN; const int gid = wgid / nig, fm = gid * WGM, gsz = (nM - fm) < WGM ? (nM - fm) : WGM;
        u.pm = fm + ((wgid % nig) % gsz); u.pn = (wgid % nig) / gsz; u.kc = 0; return true;
    }
    __device__ __forceinline__ void a_ready(const Unit&) const {}
    __device__ __forceinline__ void done(const Unit&) const {}
};

__device__ __forceinline__ unsigned cvt_pk_bf16(float lo, float hi) { unsigned r; asm volatile("v_cvt_pk_bf16_f32 %0, %1, %2" : "=v"(r) : "v"(lo), "v"(hi)); return r; }

struct EpiQKV {
    static constexpr bool PERM = true, AFTER_DRAIN = false, PROBE_DUP = true;
    bf16_t* QKV; float* out; int layer; float* kn2;
    __device__ __forceinline__ void operator()(const f32x4 (&acc)[2][2][4][2], const Unit& u, int wr, int wc, int fr, int fq) const {
        const int which = u.pn >> 3;
        const int rl0 = wr * 64 + fr;
        const int d0 = wc * 32 + 8 * fq;
        bf16_t* qbase = QKV + (size_t)(u.pm * BM + rl0) * ::LDQ + u.pn * BM + d0;
        float* fb[2]; int rstride[2]; bool en[2];
#pragma unroll
        for (int bj = 0; bj < 2; ++bj) {
            const int hh = (u.pn & 7) * 2 + bj;
            en[bj] = which != 0; fb[bj] = out; rstride[bj] = 0;
            if (which != 0) {
                const bool isv = which == 2;
                {
                    const int b = u.pm >> 5, t0 = (u.pm & 31) * 256;
                    if (hh < ::HA) { en[bj] = t0 >= ::PT - ::AWIN; rstride[bj] = ::HA * ::HD;
                        fb[bj] = out + (isv ? ::O_AV_P : ::O_AK_P) + ((size_t)((layer * ::PB + b) * ::AWIN + (t0 - (::PT - ::AWIN))) * ::HA + hh) * ::HD; }
                    else { const int hg = hh < ::HA + ::HB ? hh - ::HA : hh - ::HA - ::HB; rstride[bj] = ::HB * ::HD;
                        const size_t ob = hh < ::HA + ::HB ? (isv ? ::O_BV_P : ::O_BK_P) : (isv ? ::O_CV_P : ::O_CK_P);
                        fb[bj] = out + ob + ((size_t)((layer * ::PB + b) * ::PT + t0) * ::HB + hg) * ::HD; }
                }
            }
        }
#pragma unroll
        for (int ai = 0; ai < 2; ++ai)
#pragma unroll
            for (int m = 0; m < 4; ++m) { const int rl = rl0 + ai * HALF + m * 16; bf16_t* rowp = qbase + (size_t)(ai * HALF + m * 16) * ::LDQ;
#pragma unroll
                for (int bj = 0; bj < 2; ++bj) { const f32x4 v0 = acc[ai][bj][m][0], v1 = acc[ai][bj][m][1];
                    u32x4 w; w.x = cvt_pk_bf16(v0[0], v0[1]); w.y = cvt_pk_bf16(v0[2], v0[3]); w.z = cvt_pk_bf16(v1[0], v1[1]); w.w = cvt_pk_bf16(v1[2], v1[3]);
                    *(u32x4*)(rowp + bj * HALF) = w;
                    if (en[bj]) { float* fp = fb[bj] + (size_t)rl * rstride[bj] + d0; *(f32x4*)fp = v0; *(f32x4*)(fp + 4) = v1; }
                    if (which == 1) { const int hh = (u.pn & 7) * 2 + bj;
                        if (hh >= ::HA && hh < ::HA + ::HB) {
                            float s = (v0[0] * v0[0] + v0[1] * v0[1]) + (v0[2] * v0[2] + v0[3] * v0[3]) + (v1[0] * v1[0] + v1[1] * v1[1]) + (v1[2] * v1[2] + v1[3] * v1[3]);
                            s += __shfl_xor(s, 16); s += __shfl_xor(s, 32);
                            if (fq == 0) __hip_atomic_fetch_add(kn2 + (size_t)(u.pm * BM + rl) * ::HB + (hh - ::HA), s, __ATOMIC_RELAXED, __HIP_MEMORY_SCOPE_AGENT); } } } }
    }
};
struct EpiResid {
    static constexpr bool PERM = false, AFTER_DRAIN = false, PROBE_DUP = false;
    const float* xin_p; float* xout_p; const float* gate;
    __device__ __forceinline__ void operator()(const f32x4 (&acc)[2][2][4][2], const Unit& u, int wr, int wc, int fr, int fq) const {
        const float* xi = xin_p + (size_t)u.pm * BM * ::D; float* xo = xout_p + (size_t)u.pm * BM * ::D;
        const int col0 = u.pn * BM + wc * 32 + 4 * fq; const float* gp = gate + (size_t)(u.pm >> 5) * ::NMOD + col0;
#pragma unroll
        for (int ai = 0; ai < 2; ++ai)
#pragma unroll
            for (int m = 0; m < 4; ++m) { const int rl = ai * HALF + wr * 64 + m * 16 + fr; const size_t off = (size_t)rl * ::D + col0;
#pragma unroll
                for (int bj = 0; bj < 2; ++bj) {
#pragma unroll
                    for (int n = 0; n < 2; ++n) { const f32x4 gv = *(const f32x4*)(gp + bj * HALF + n * 16); const f32x4 xv = *(const f32x4*)(xi + off + bj * HALF + n * 16);
                        *(f32x4*)(xo + off + bj * HALF + n * 16) = xv + gv * acc[ai][bj][m][n]; }
                    asm volatile("" ::: "memory"); } }
    }
};
struct EpiSwiGLU {
    static constexpr bool PERM = true, AFTER_DRAIN = false, PROBE_DUP = false;
    bf16_t* ACT;
    __device__ __forceinline__ void operator()(const f32x4 (&acc)[2][2][4][2], const Unit& u, int wr, int wc, int fr, int fq) const {
        bf16_t* base = ACT + (size_t)(u.pm * BM + wr * 64 + fr) * ::LDACT + u.pn * HALF + wc * 32 + 8 * fq;
#pragma unroll
        for (int ai = 0; ai < 2; ++ai)
#pragma unroll
            for (int m = 0; m < 4; ++m) { float r[8];
#pragma unroll
                for (int n = 0; n < 2; ++n)
#pragma unroll
                    for (int j = 0; j < 4; ++j) { const float g = acc[ai][0][m][n][j], up = acc[ai][1][m][n][j];
                        r[4 * n + j] = g * __builtin_amdgcn_rcpf(1.0f + __builtin_amdgcn_exp2f(-g * ::LOG2E)) * up; }
                u32x4 w; w.x = cvt_pk_bf16(r[0], r[1]); w.y = cvt_pk_bf16(r[2], r[3]); w.z = cvt_pk_bf16(r[4], r[5]); w.w = cvt_pk_bf16(r[6], r[7]);
                *(u32x4*)(base + (size_t)(ai * HALF + m * 16) * ::LDACT) = w; }
    }
};


template <int PM, int NN, int NKC> struct SampleOrder {
    int G, c;
    __host__ __device__ void init(int G_, int c_) { G = G_; c = c_; }
    __host__ __device__ bool next(int i, Unit& u) const { const int L = i * G + c; if (L >= NN * NKC) return false; u.pm = PM; u.pn = L % NN; u.kc = L / NN; return true; }
    __device__ __forceinline__ void a_ready(const Unit&) const {}
    __device__ __forceinline__ void done(const Unit&) const {}
};
template <int N> struct EpiPartial {
    static constexpr bool PERM = false, AFTER_DRAIN = false, PROBE_DUP = false;
    float* part;
    __device__ __forceinline__ void operator()(const f32x4 (&acc)[2][2][4][2], const Unit& u, int wr, int wc, int fr, int fq) const {
        float* base = part + ((size_t)u.kc * BM + wr * 64 + fr) * N + u.pn * BM + wc * 32 + 4 * fq;
#pragma unroll
        for (int ai = 0; ai < 2; ++ai)
#pragma unroll
            for (int m = 0; m < 4; ++m) { float* rowp = base + (size_t)(ai * HALF + m * 16) * N;
#pragma unroll
                for (int bj = 0; bj < 2; ++bj)
#pragma unroll
                    for (int n = 0; n < 2; ++n) *(f32x4*)(rowp + bj * HALF + n * 16) = acc[ai][bj][m][n]; }
    }
};


template <class Epi, class Sched, bool ALIGN_EPI, bool SP2, int KK, int LDA, int LDB = KK>
__device__ __forceinline__ void gemm_phase(PG8_LAS unsigned char* lds, const Gemm g, const Sched& S, const Epi& E) {
    int tid = threadIdx.x; asm volatile("" : "+v"(tid));
    const int wid = __builtin_amdgcn_readfirstlane(tid >> 6), lane = tid & 63, wr = wid >> 2, wc = wid & 3, fr = lane & 15, fq = lane >> 4;
    constexpr int K = KK, nt = K / BK, lda = LDA, ldb = LDB;
    unsigned voffA[2], voffB[2];
#pragma unroll
    for (int i = 0; i < 2; ++i) { int R, C; stage_rc(tid * 16 + i * 8192, R, C); const int Rb = Epi::PERM ? ((R & ~31) + perm32(R & 31)) : R;
        voffA[i] = (unsigned)(R * lda + C) * 2u; voffB[i] = (unsigned)(Rb * ldb + C) * 2u; }
    constexpr size_t kstep = (size_t)(BK * 2);
    constexpr size_t hstepA = (size_t)HALF * lda * 2, hstepB = (size_t)HALF * ldb * 2;
    constexpr size_t tstepA = 2 * hstepA, tstepB = 2 * hstepB;
    const unsigned ldsw = (unsigned)wid * 1024u;
    const int aoff = lds_byte(wr * 64 + fr, fq * 8), boff = lds_byte(wc * 32 + fr, fq * 8);
#define PG8_SA(b, h) (((b) * 2 + (h)) * HTB)
#define PG8_SB(b, h) ((4 + (b) * 2 + (h)) * HTB)
#define PG8_STAGE(bufoff, gbase, voff) do { _Pragma("unroll") for (int _i = 0; _i < 2; ++_i) \
        __builtin_amdgcn_global_load_lds((const unsigned*)((const char*)(gbase) + (voff)[_i]), (PG8_LAS unsigned*)(lds + (bufoff) + ldsw + _i * 8192), 16, 0, 0); } while (0)
#define PG8_LDA(dst, b, h) do { _Pragma("unroll") for (int m = 0; m < 4; ++m) _Pragma("unroll") for (int k = 0; k < 2; ++k) dst[m][k] = *(const PG8_LAS bf16x8*)(lds + PG8_SA(b, h) + aoff + m * 2048 + k * 1024); } while (0)
#define PG8_LDB(dst, b, h) do { _Pragma("unroll") for (int n = 0; n < 2; ++n) _Pragma("unroll") for (int k = 0; k < 2; ++k) dst[n][k] = *(const PG8_LAS bf16x8*)(lds + PG8_SB(b, h) + boff + n * 2048 + k * 1024); } while (0)
#define PG8_MMA(ai, bj, At, Bt) do { __builtin_amdgcn_s_setprio(1); _Pragma("unroll") for (int m = 0; m < 4; ++m) _Pragma("unroll") for (int n = 0; n < 2; ++n) _Pragma("unroll") for (int k = 0; k < 2; ++k) \
        acc[ai][bj][m][n] = __builtin_amdgcn_mfma_f32_16x16x32_bf16(Bt[n][k], At[m][k], acc[ai][bj][m][n], 0, 0, 0); __builtin_amdgcn_s_setprio(0); } while (0)
#define PG8_WAIT_V(n) asm volatile("s_waitcnt vmcnt(" #n ")" ::: "memory")
#define PG8_WAIT_L(n) asm volatile("s_waitcnt lgkmcnt(" #n ")" ::: "memory")
#define PG8_BAR __builtin_amdgcn_s_barrier()
#define PG8_SCHED __builtin_amdgcn_sched_barrier(0)
    Unit cur, nxt; int ui = 0;
    if (!S.next(0, cur)) return;
    f32x4 acc[2][2][4][2];
#pragma unroll
    for (int a = 0; a < 2; ++a)
#pragma unroll
        for (int b = 0; b < 2; ++b)
#pragma unroll
            for (int m = 0; m < 4; ++m)
#pragma unroll
                for (int n = 0; n < 2; ++n) acc[a][b][m][n] = (f32x4){0.f, 0.f, 0.f, 0.f};
    bf16x8 At[4][2], B0[2][2], B1[2][2];
    const char* cA = (const char*)g.A + (size_t)cur.pm * tstepA + (size_t)cur.kc * (K * 2); const char* cB = (const char*)g.Bt + (size_t)cur.pn * tstepB + (size_t)cur.kc * (K * 2);
    S.a_ready(cur);
    if constexpr (SP2) {
        PG8_STAGE(PG8_SB(0, 0), cB, voffB); PG8_STAGE(PG8_SB(0, 1), cB + hstepB, voffB); PG8_STAGE(PG8_SA(0, 0), cA, voffA); PG8_STAGE(PG8_SA(0, 1), cA + hstepA, voffA);
        if (wr == 1) PG8_BAR;
        PG8_WAIT_V(2); PG8_BAR;
        PG8_STAGE(PG8_SB(1, 0), cB + kstep, voffB); PG8_STAGE(PG8_SA(1, 0), cA + kstep, voffA); PG8_STAGE(PG8_SB(1, 1), cB + hstepB + kstep, voffB);
        PG8_WAIT_V(6); PG8_BAR;
    } else {
        PG8_STAGE(PG8_SB(0, 0), cB, voffB); PG8_STAGE(PG8_SA(0, 0), cA, voffA); PG8_STAGE(PG8_SB(0, 1), cB + hstepB, voffB); PG8_STAGE(PG8_SA(0, 1), cA + hstepA, voffA);
        if (wr == 1) PG8_BAR;
        PG8_WAIT_V(4); PG8_BAR;
        PG8_STAGE(PG8_SB(1, 0), cB + kstep, voffB); PG8_STAGE(PG8_SA(1, 0), cA + kstep, voffA); PG8_STAGE(PG8_SB(1, 1), cB + hstepB + kstep, voffB);
        PG8_WAIT_V(6); PG8_BAR;
    }
    for (;;) {
        const bool has_next = S.next(ui + 1, nxt);
        const char* nA = has_next ? (const char*)g.A + (size_t)nxt.pm * tstepA + (size_t)nxt.kc * (K * 2) : cA; const char* nB = has_next ? (const char*)g.Bt + (size_t)nxt.pn * tstepB + (size_t)nxt.kc * (K * 2) : cB;
#pragma unroll 1
        for (int t = 0; t < nt; t += 2) {
            const bool last = (t == nt - 2);
            const char* a1 = cA + (size_t)(t + 1) * kstep;
            const char* a2 = last ? nA : cA + (size_t)(t + 2) * kstep; const char* b2 = last ? nB : cB + (size_t)(t + 2) * kstep;
            const char* a3 = a2 + kstep; const char* b3 = b2 + kstep;
            if (last && has_next) S.a_ready(nxt);
            if constexpr (SP2) {
            PG8_LDB(B0, 0, 0); PG8_LDB(B1, 0, 1); PG8_SCHED; PG8_LDA(At, 0, 0); PG8_STAGE(PG8_SA(1, 1), a1 + hstepA, voffA);
            PG8_WAIT_V(8); PG8_WAIT_L(0); PG8_BAR; PG8_MMA(0, 0, At, B0); PG8_MMA(0, 1, At, B1); PG8_BAR; PG8_SCHED;
            PG8_LDA(At, 0, 1); PG8_STAGE(PG8_SB(0, 0), b2, voffB); PG8_STAGE(PG8_SB(0, 1), b2 + hstepB, voffB); PG8_STAGE(PG8_SA(0, 0), a2, voffA);
            PG8_WAIT_V(8); PG8_WAIT_L(0); PG8_BAR; PG8_MMA(1, 0, At, B0); PG8_MMA(1, 1, At, B1); PG8_BAR; PG8_SCHED;
            PG8_LDB(B0, 1, 0); PG8_LDB(B1, 1, 1); PG8_SCHED; PG8_LDA(At, 1, 0); PG8_STAGE(PG8_SA(0, 1), a2 + hstepA, voffA);
            PG8_WAIT_V(8); PG8_WAIT_L(0); PG8_BAR; PG8_MMA(0, 0, At, B0); PG8_MMA(0, 1, At, B1); PG8_BAR; PG8_SCHED;
            PG8_LDA(At, 1, 1); PG8_STAGE(PG8_SB(1, 0), b3, voffB); PG8_STAGE(PG8_SB(1, 1), b3 + hstepB, voffB); PG8_STAGE(PG8_SA(1, 0), a3, voffA);
            PG8_WAIT_V(8); PG8_WAIT_L(0); PG8_BAR; PG8_MMA(1, 0, At, B0); PG8_MMA(1, 1, At, B1); PG8_BAR; PG8_SCHED;
            } else {
            PG8_LDB(B0, 0, 0); PG8_SCHED; PG8_LDA(At, 0, 0); PG8_STAGE(PG8_SA(1, 1), a1 + hstepA, voffA);
            PG8_WAIT_L(8); PG8_BAR; PG8_WAIT_L(0); PG8_MMA(0, 0, At, B0); PG8_BAR; PG8_SCHED;
            PG8_LDB(B1, 0, 1); PG8_STAGE(PG8_SB(0, 0), b2, voffB);
            PG8_BAR; PG8_WAIT_L(0); PG8_MMA(0, 1, At, B1); PG8_BAR;
            PG8_LDA(At, 0, 1); PG8_STAGE(PG8_SA(0, 0), a2, voffA);
            PG8_BAR; PG8_WAIT_L(0); PG8_MMA(1, 0, At, B0); PG8_BAR; PG8_SCHED;
            PG8_STAGE(PG8_SB(0, 1), b2 + hstepB, voffB);
            PG8_WAIT_V(6); PG8_BAR; PG8_MMA(1, 1, At, B1); PG8_BAR;
            PG8_LDB(B0, 1, 0); PG8_SCHED; PG8_LDA(At, 1, 0); PG8_STAGE(PG8_SA(0, 1), a2 + hstepA, voffA);
            PG8_WAIT_L(8); PG8_BAR; PG8_WAIT_L(0); PG8_MMA(0, 0, At, B0); PG8_BAR; PG8_SCHED;
            PG8_LDB(B1, 1, 1); PG8_STAGE(PG8_SB(1, 0), b3, voffB);
            PG8_BAR; PG8_WAIT_L(0); PG8_MMA(0, 1, At, B1); PG8_BAR;
            PG8_LDA(At, 1, 1); PG8_STAGE(PG8_SA(1, 0), a3, voffA);
            PG8_BAR; PG8_WAIT_L(0); PG8_MMA(1, 0, At, B0); PG8_BAR; PG8_SCHED;
            PG8_STAGE(PG8_SB(1, 1), b3 + hstepB, voffB);
            PG8_WAIT_V(6); PG8_BAR; PG8_MMA(1, 1, At, B1); PG8_BAR;
            }
        }
        if constexpr (ALIGN_EPI) { if (wr == 0) PG8_BAR; }
        if constexpr (!Epi::AFTER_DRAIN) { E(acc, cur, wr, wc, fr, fq);
#ifdef PROBE_EPI_DUP
            if constexpr (Epi::PROBE_DUP) { asm volatile("" ::: "memory"); E(acc, cur, wr, wc, fr, fq); }
#endif
            S.done(cur); }
        if (!has_next) break;
#pragma unroll
        for (int a = 0; a < 2; ++a)
#pragma unroll
            for (int b = 0; b < 2; ++b)
#pragma unroll
                for (int m = 0; m < 4; ++m)
#pragma unroll
                    for (int n = 0; n < 2; ++n) acc[a][b][m][n] = (f32x4){0.f, 0.f, 0.f, 0.f};
        cur = nxt; cA = nA; cB = nB; ++ui;
        if constexpr (ALIGN_EPI) { if (wr == 1) PG8_BAR; }
    }
    PG8_WAIT_V(0);
    if constexpr (!ALIGN_EPI) { if (wr == 0) PG8_BAR; }
    PG8_BAR;
    if constexpr (Epi::AFTER_DRAIN) { E.fused(acc, cur, wr, wc, fr, fq, lds, wid, lane); S.done(cur); }
#undef PG8_SA
#undef PG8_SB
#undef PG8_STAGE
#undef PG8_LDA
#undef PG8_LDB
#undef PG8_MMA
#undef PG8_WAIT_V
#undef PG8_WAIT_L
#undef PG8_BAR
#undef PG8_SCHED
}
}

#define XB_TMO      128
#define XB_XCNT(j)  (256  + 64 * (j))
#define XB_XSUB(j)  (1280 + 64 * (j))
#define XB_XGEN(j)  (2304 + 64 * (j))
#define XB_TOP      3328
#define XB_TOPGEN   3392
#define XCD_BAR_WORDS 3456
#define XB_SPIN_CAP (1u << 18)

__device__ __forceinline__ unsigned xb_ld(unsigned* p)              { return __hip_atomic_load(p, __ATOMIC_RELAXED, __HIP_MEMORY_SCOPE_AGENT); }
__device__ __forceinline__ unsigned xb_add(unsigned* p, unsigned v) { return __hip_atomic_fetch_add(p, v, __ATOMIC_RELAXED, __HIP_MEMORY_SCOPE_AGENT); }
__device__ __forceinline__ unsigned xb_xcc_id() { return (unsigned)__builtin_amdgcn_s_getreg((3 << 11) | 20) & 0xFu; }
#define XB_SPIN(cond, bar) do { unsigned _sp = 0; while (cond) { __builtin_amdgcn_s_sleep(1); \
    if ((++_sp & 255u) == 0u) { if (xb_ld(&(bar)[XB_TMO])) break; if (_sp > XB_SPIN_CAP) { atomicAdd(&(bar)[XB_TMO], 1u); break; } } } } while (0)

struct XcdBarrier {
    unsigned* bar; unsigned x;
    volatile LAS unsigned* st;
};

__device__ __forceinline__ XcdBarrier xcd_barrier_post(unsigned* bar, volatile LAS unsigned* st) {
    XcdBarrier b; b.bar = bar; b.x = xb_xcc_id(); b.st = st;
    if (threadIdx.x == 0) (void)xb_add(&bar[XB_XCNT(b.x)], 1u);
    return b;
}
__device__ __forceinline__ void xcd_barrier_complete(unsigned* bar, unsigned x, unsigned& nloc, unsigned& nx) {
    const unsigned G = gridDim.x * gridDim.y * gridDim.z;
    unsigned sum, cnt, mine, sp = 0u;
    for (;;) {
        sum = 0u; cnt = 0u; mine = 0u;
#pragma unroll
        for (unsigned j = 0; j < 16; ++j) { const unsigned c = xb_ld(&bar[XB_XCNT(j)]); sum += c; cnt += (c > 0u) ? 1u : 0u; mine = (j == x) ? c : mine; }
        if (sum == G) break;
        __builtin_amdgcn_s_sleep(1);
        if ((++sp & 255u) == 0u) { if (xb_ld(&bar[XB_TMO])) break; if (sp > XB_SPIN_CAP) { atomicAdd(&bar[XB_TMO], 1u); break; } }
    }
    nloc = mine > 0u ? mine : 1u; nx = cnt > 0u ? cnt : 1u;
}

__device__ __forceinline__ void xcd_barrier(const XcdBarrier& b) {
    asm volatile("s_waitcnt vmcnt(0)" ::: "memory");
    __syncthreads();
    if (threadIdx.x == 0) {
        unsigned* bar = b.bar; asm volatile("" : "+s"(bar));
        __builtin_amdgcn_s_waitcnt(0);
        unsigned nloc = b.st[0], nx = b.st[1];
        unsigned bx = b.x; asm volatile("" : "+s"(bx));
        if (nloc == 0u) { xcd_barrier_complete(bar, bx, nloc, nx); b.st[0] = nloc; b.st[1] = nx; }
        const unsigned old = xb_add(&bar[XB_XSUB(bx)], 1u);
        const unsigned gen = old / nloc;
        if (old + 1u == (gen + 1u) * nloc) {
            __builtin_amdgcn_fence(__ATOMIC_RELEASE, "agent");
            asm volatile("s_waitcnt vmcnt(0)" ::: "memory");
            const unsigned og = xb_add(&bar[XB_TOP], 1u);
            const unsigned tg = og / nx;
            if (og + 1u == (tg + 1u) * nx) xb_add(&bar[XB_TOPGEN], 1u);
            else XB_SPIN(xb_ld(&bar[XB_TOPGEN]) == tg, bar);
            __builtin_amdgcn_fence(__ATOMIC_ACQUIRE, "agent");
            xb_add(&bar[XB_XGEN(bx)], 1u);
            asm volatile("s_waitcnt vmcnt(0)" ::: "memory");
        } else {
            XB_SPIN(xb_ld(&bar[XB_XGEN(bx)]) == gen, bar);
            __builtin_amdgcn_fence(__ATOMIC_ACQUIRE, "agent");
            asm volatile("s_waitcnt vmcnt(0)" ::: "memory");
        }
    }
    __syncthreads();
}
struct Params {
    const float* in[23];
    float* out;
    unsigned char* ws;
};

struct Ctx {
    LAS unsigned char* lds;
    int tid, lane, wave, G, blk;
};

__device__ __forceinline__ void transpose_item(const float* W, int ld, bf16* WT, int Kd, int k0, int n0, int drow0, LAS float* scr, int lane) {
#pragma unroll 8
    for (int i = 0; i < 32; ++i) { const int kk = 2 * i + (lane >> 5); scr[kk * 33 + (lane & 31)] = W[(size_t)(k0 + kk) * ld + n0 + (lane & 31)]; }
    LDS_WAIT(); asm volatile("" ::: "memory");
    const int c = lane & 7;
#pragma unroll
    for (int j = 0; j < 4; ++j) { const int n = (lane >> 3) + 8 * j; const LAS float* s = scr + (8 * c) * 33 + n;
        u32x4 o; o.x = cvt_pk_bf16(s[0 * 33], s[1 * 33]); o.y = cvt_pk_bf16(s[2 * 33], s[3 * 33]); o.z = cvt_pk_bf16(s[4 * 33], s[5 * 33]); o.w = cvt_pk_bf16(s[6 * 33], s[7 * 33]);
        *(u32x4*)(WT + (size_t)(drow0 + n) * Kd + k0 + 8 * c) = o; }
    LDS_WAIT(); asm volatile("" ::: "memory");
}

__device__ __forceinline__ void cvt_copy(const float* src, bf16* dst, size_t n8, size_t i0, size_t stride) {
    for (size_t i = i0; i < n8; i += stride) { const f32x4 a = *(const f32x4*)(src + i * 8), b = *(const f32x4*)(src + i * 8 + 4);
        u32x4 o; o.x = cvt_pk_bf16(a[0], a[1]); o.y = cvt_pk_bf16(a[2], a[3]); o.z = cvt_pk_bf16(b[0], b[1]); o.w = cvt_pk_bf16(b[2], b[3]);
        *(u32x4*)(dst + i * 8) = o; }
}

__device__ __forceinline__ void p0_prologue(const Params& P, const Ctx& C) {
    unsigned char* ws = P.ws;
    {
        LAS float* scr = (LAS float*)(C.lds + RING_OFF + C.wave * 16384);
        const int gw = C.blk * 8 + C.wave, NGW = C.G * 8;
        constexpr int I_IN = (D / 64) * (NQKV / 32), I_O = (D / 64) * (D / 32), I_G = (D / 64) * (DFF / 32), I_D = (DFF / 64) * (D / 32);
        constexpr int I_L = I_IN + I_O + 2 * I_G + I_D;
        for (int it = gw; it < 2 * I_L; it += NGW) {
            const int l = it / I_L; int r = it % I_L;
            if (r < I_IN) { const int nb = NQKV / 32, kb = r / nb, n0 = (r % nb) * 32;
                transpose_item(P.in[15] + (size_t)l * D * NIN, NIN, (bf16*)(ws + WS_WIN + l * SZ_WIN), LDW, kb * 64, n0, n0, scr, C.lane); continue; }
            r -= I_IN;
            if (r < I_O) { const int nb = D / 32, kb = r / nb, n0 = (r % nb) * 32;
                transpose_item(P.in[18] + (size_t)l * D * D, D, (bf16*)(ws + WS_WO + l * SZ_WO), LDW, kb * 64, n0, n0, scr, C.lane); continue; }
            r -= I_O;
            if (r < 2 * I_G) { const int up = r >= I_G; if (up) r -= I_G; const int nb = DFF / 32, kb = r / nb, n0 = (r % nb) * 32;
                const int drow0 = (n0 >> 7) * 256 + (n0 & 127) + (up ? 128 : 0);
                transpose_item(P.in[up ? 20 : 19] + (size_t)l * D * DFF, DFF, (bf16*)(ws + WS_WGU + l * SZ_WGU), LDW, kb * 64, n0, drow0, scr, C.lane); continue; }
            r -= 2 * I_G;
            { const int nb = D / 32, kb = r / nb, n0 = (r % nb) * 32;
                transpose_item(P.in[21] + (size_t)l * DFF * D, D, (bf16*)(ws + WS_WDN + l * SZ_WDN), LDWD, kb * 64, n0, n0, scr, C.lane); }
        }
    }
    {
        const size_t i0 = (size_t)C.blk * 512 + C.tid, stride = (size_t)C.G * 512;
        cvt_copy(P.in[2], (bf16*)(ws + WS_CAK), SZ_CA / 16, i0, stride); cvt_copy(P.in[3], (bf16*)(ws + WS_CAV), SZ_CA / 16, i0, stride);
        cvt_copy(P.in[4], (bf16*)(ws + WS_CBK), SZ_CB / 16, i0, stride); cvt_copy(P.in[5], (bf16*)(ws + WS_CBV), SZ_CB / 16, i0, stride);
        cvt_copy(P.in[7], (bf16*)(ws + WS_CCK), SZ_CB / 16, i0, stride); cvt_copy(P.in[8], (bf16*)(ws + WS_CCV), SZ_CB / 16, i0, stride);
    }
    {
        __syncthreads();
        LAS float* st = (LAS float*)(C.lds + RING_OFF);
        for (int idx = C.tid; idx < NMIDX * D; idx += 512) { const int m = idx / D, k = idx % D;
            const float c = m < PB ? P.in[9][m * D + k] : P.in[10][(m - PB) * D + k];
            st[k * NMIDX + m] = c * fast_rcp(1.0f + fast_exp2(-c * LOG2E)); }
        __syncthreads();
        float* mod = (float*)(ws + WS_MOD);
        constexpr int KC = 256, NKC = D / KC, NNC = NMOD / 256;
        for (int it = C.wave * C.G + C.blk; it < 2 * NKC * NNC; it += 8 * C.G) {
            const int l = it / (NKC * NNC), r = it % (NKC * NNC), kc = r / NNC, nc = r % NNC, k0 = kc * KC, n0 = nc * 256 + C.lane * 4;
            const float* wp = P.in[11] + ((size_t)l * D + k0) * NMOD + n0;
            f32x4 acc[NMIDX];
#pragma unroll
            for (int m = 0; m < NMIDX; ++m) acc[m] = (f32x4){0.f, 0.f, 0.f, 0.f};
#pragma unroll 4
            for (int k = 0; k < KC; ++k) { const f32x4 w = *(const f32x4*)(wp + (size_t)k * NMOD);
                const LAS f32x4* sp = (const LAS f32x4*)(st + (k0 + k) * NMIDX); const f32x4 s0 = sp[0], s1 = sp[1], s2 = sp[2];
                acc[0] += w * s0[0]; acc[1] += w * s0[1]; acc[2] += w * s0[2]; acc[3] += w * s0[3];
                acc[4] += w * s1[0]; acc[5] += w * s1[1]; acc[6] += w * s1[2]; acc[7] += w * s1[3];
                acc[8] += w * s2[0]; acc[9] += w * s2[1]; acc[10] += w * s2[2]; acc[11] += w * s2[3]; }
            f32x4 bias = (f32x4){0.f, 0.f, 0.f, 0.f};
            if (kc == 0) bias = *(const f32x4*)(P.in[12] + (size_t)l * NMOD + n0);
#pragma unroll
            for (int m = 0; m < NMIDX; ++m) { float* mp = mod + ((size_t)l * NMIDX + m) * NMOD + n0;
#pragma unroll
                for (int j = 0; j < 4; ++j) __hip_atomic_fetch_add(mp + j, acc[m][j] + bias[j], __ATOMIC_RELAXED, __HIP_MEMORY_SCOPE_AGENT); }
        }
    }
}

template <bool WITH_LOGF>
__device__ __forceinline__ void norm_rows(const Ctx& C, const float* xrows, bf16* hrows, int nrows, const float* gvec, const float* shift, const float* scale,
                                          const LAS float* wf, const float* bf, float* lf_out) {
    f32x4 gm[8], sh[8];
#pragma unroll
    for (int j = 0; j < 8; ++j) { const int e = 4 * C.lane + 256 * j; const f32x4 g = *(const f32x4*)(gvec + e), sc = *(const f32x4*)(scale + e); sh[j] = *(const f32x4*)(shift + e); gm[j] = g * (sc + 1.0f); }
    for (int r = 0; r < nrows; ++r) {
        const float* xr = xrows + (size_t)r * D; f32x4 v[8]; float ss = 0.f;
#pragma unroll
        for (int j = 0; j < 8; ++j) { v[j] = *(const f32x4*)(xr + 4 * C.lane + 256 * j); ss += (v[j][0] * v[j][0] + v[j][1] * v[j][1]) + (v[j][2] * v[j][2] + v[j][3] * v[j][3]); }
        const float rstd = 1.0f / sqrtf(wave_sum(ss) * (1.0f / D) + EPS);
#pragma unroll
        for (int j = 0; j < 8; ++j) v[j] = v[j] * rstd * gm[j] + sh[j];
        bf16* hr = hrows + (size_t)r * LDH;
#pragma unroll
        for (int j = 0; j < 8; ++j) { u32x2 w; w.x = cvt_pk_bf16(v[j][0], v[j][1]); w.y = cvt_pk_bf16(v[j][2], v[j][3]); *(u32x2*)(hr + 4 * C.lane + 256 * j) = w; }
        if constexpr (WITH_LOGF) {
            float dots[6];
#pragma unroll
            for (int f = 0; f < 6; ++f) { float a = 0.f;
#pragma unroll
                for (int j = 0; j < 8; ++j) { const f32x4 w = *(const LAS f32x4*)(wf + f * D + 4 * C.lane + 256 * j); a += (v[j][0] * w[0] + v[j][1] * w[1]) + (v[j][2] * w[2] + v[j][3] * w[3]); }
                dots[f] = wave_sum(a); }
            if (C.lane < 6) { float z = C.lane == 0 ? dots[0] : C.lane == 1 ? dots[1] : C.lane == 2 ? dots[2] : C.lane == 3 ? dots[3] : C.lane == 4 ? dots[4] : dots[5];
                z += bf[C.lane];
                const float ls = fminf(z, 0.f) - LN2 * fast_log2(1.0f + fast_exp2(-fabsf(z) * LOG2E));
                lf_out[(size_t)r * HB + C.lane] = ls; }
        }
    }
}

__device__ __forceinline__ void sample_resid_row(const Ctx& C, const float* xin, float* xout, const float* part, int nkc, const float* gate) {
    f32x4 s[8];
#pragma unroll
    for (int j = 0; j < 8; ++j) s[j] = (f32x4){0.f, 0.f, 0.f, 0.f};
    for (int kc = 0; kc < nkc; ++kc) { const float* pp = part + (size_t)kc * MS * D;
#pragma unroll
        for (int j = 0; j < 8; ++j) s[j] += *(const f32x4*)(pp + 4 * C.lane + 256 * j); }
#pragma unroll
    for (int j = 0; j < 8; ++j) { const int e = 4 * C.lane + 256 * j; *(f32x4*)(xout + e) = *(const f32x4*)(xin + e) + *(const f32x4*)(gate + e) * s[j]; }
}
template <bool WITH_LOGF>
__device__ __forceinline__ void norm_phase(const Params& P, const Ctx& C, int layer, const float* xp, const float* xs, const float* gvec, int off_shift, int off_scale,
                                           int fix_nkc, const float* fix_mod, int fix_gate_off) {
    bf16* H = (bf16*)(P.ws + WS_H); const float* mod = (const float*)(P.ws + WS_MOD) + (size_t)layer * NMIDX * NMOD;
    LAS float* wf = (LAS float*)(C.lds + RING_OFF);
    if constexpr (WITH_LOGF) {
        const float* win = P.in[15] + (size_t)layer * D * NIN + NQKV;
        for (int idx = C.tid; idx < 6 * D; idx += 512) { const int k = idx / 6, f = idx % 6; wf[f * D + k] = win[(size_t)k * NIN + f]; }
        __syncthreads();
    }
    const float* bf = P.in[16] + layer * HB;
    float* lfp = P.out + O_BLF_P + (size_t)layer * PB * PT * HB; float* lfs = P.out + O_BLF_S + (size_t)layer * MS * HB;
    const int gw = C.blk * 8 + C.wave, NGW = C.G * 8;
    for (int it = gw; it < MP / 16; it += NGW) { const int r0 = it * 16, b = r0 >> 13; const float* mv = mod + (size_t)b * NMOD;
        norm_rows<WITH_LOGF>(C, xp + (size_t)r0 * D, H + (size_t)r0 * LDH, 16, gvec, mv + off_shift, mv + off_scale, wf, bf, lfp + (size_t)r0 * HB); }
    if (C.wave == 0) for (int r = C.blk; r < MS; r += C.G) { const float* mv = mod + (size_t)(PB + (r >> 5)) * NMOD; const float* xr = xs + (size_t)r * D;
        if (fix_nkc > 0) { float* xo = P.out + O_Y_S + (size_t)r * D;
            sample_resid_row(C, xr, xo, (const float*)(P.ws + WS_PART) + (size_t)r * D, fix_nkc, fix_mod + (size_t)(PB + (r >> 5)) * NMOD + fix_gate_off); xr = xo; }
        norm_rows<WITH_LOGF>(C, xr, H + (size_t)(MP + r) * LDH, 1, gvec, mv + off_shift, mv + off_scale, wf, bf, lfs + (size_t)r * HB); }
    __syncthreads();
}

__device__ __forceinline__ void final_norm(const Params& P, const Ctx& C) {
    const float* g = P.in[22]; f32x4 gm[8];
#pragma unroll
    for (int j = 0; j < 8; ++j) gm[j] = *(const f32x4*)(g + 4 * C.lane + 256 * j);
    const int gw = C.blk * 8 + C.wave, NGW = C.G * 8;
    for (int r = gw; r < MT; r += NGW) {
        float* xr = P.out + (size_t)r * D; f32x4 v[8]; float ss = 0.f;
        if (r >= MP) { const int rs = r - MP;
            sample_resid_row(C, xr, xr, (const float*)(P.ws + WS_PART) + (size_t)rs * D, DFF / 256, (const float*)(P.ws + WS_MOD) + ((size_t)NMIDX + PB + (rs >> 5)) * NMOD + 5 * D); }
#pragma unroll
        for (int j = 0; j < 8; ++j) { v[j] = *(const f32x4*)(xr + 4 * C.lane + 256 * j); ss += (v[j][0] * v[j][0] + v[j][1] * v[j][1]) + (v[j][2] * v[j][2] + v[j][3] * v[j][3]); }
        const float rstd = 1.0f / sqrtf(wave_sum(ss) * (1.0f / D) + EPS);
#pragma unroll
        for (int j = 0; j < 8; ++j) *(f32x4*)(xr + 4 * C.lane + 256 * j) = v[j] * rstd * gm[j];
    }
}


__device__ __forceinline__ float block_excl_scan(const Ctx& C, LAS float* red, float s) {
    float incl = s;
#pragma unroll
    for (int o = 1; o < 64; o <<= 1) { const float t = __shfl_up(incl, o); if (C.lane >= o) incl += t; }
    if (C.lane == 63) red[C.wave] = incl;
    __syncthreads();
    float base = 0.f;
    for (int w = 0; w < C.wave; ++w) base += red[w];
    return base + incl - s;
}

__device__ __forceinline__ void fcum_phase(const Params& P, const Ctx& C, int layer) {
    LAS float* red = (LAS float*)(C.lds + RING_OFF);
    if (C.blk < PB * HB) {
        const int b = C.blk / HB, h = C.blk % HB; const float* lf = P.out + O_BLF_P + ((size_t)(layer * PB + b) * PT) * HB + h;
        float* F = (float*)(P.ws + WS_FP) + ((size_t)b * PT) * HB + h;
        float v[16]; float s = 0.f;
#pragma unroll
        for (int i = 0; i < 16; ++i) { v[i] = lf[(size_t)(C.tid * 16 + i) * HB]; s += v[i]; }
        float a = block_excl_scan(C, red, s);
#pragma unroll
        for (int i = 0; i < 16; ++i) { a += v[i]; F[(size_t)(C.tid * 16 + i) * HB] = a; }
        __syncthreads();
    } else if (C.blk < PB * HB + SB * HB) {
        const int q = C.blk - PB * HB, sb = q / HB, h = q % HB; constexpr int L = PAST + ST;
        const float* cl = P.in[6] + ((size_t)(layer * SB + sb) * PAST) * HB + h; const float* nl = P.out + O_BLF_S + ((size_t)(layer * SB + sb) * ST) * HB + h;
        float* F = (float*)(P.ws + WS_FS) + ((size_t)sb * L) * HB + h;
        float v[3]; float s = 0.f;
#pragma unroll
        for (int i = 0; i < 3; ++i) { const int p = C.tid * 3 + i; v[i] = p < PAST ? cl[(size_t)p * HB] : (p < L ? nl[(size_t)(p - PAST) * HB] : 0.f); s += v[i]; }
        float a = block_excl_scan(C, red, s);
#pragma unroll
        for (int i = 0; i < 3; ++i) { const int p = C.tid * 3 + i; a += v[i]; if (p < L) F[(size_t)p * HB] = a; }
        __syncthreads();
    }
}

__device__ __forceinline__ void finish_qkv(const Params& P, const Ctx& C, int layer) {
    const float* part = (const float*)(P.ws + WS_PART); bf16* qkv = (bf16*)(P.ws + WS_QKV);
    for (int r = C.blk; r < MS; r += C.G)
        for (int c4 = C.tid; c4 < NQKV / 4; c4 += 512) { const int c = c4 * 4; f32x4 s = (f32x4){0.f, 0.f, 0.f, 0.f};
#pragma unroll
            for (int kc = 0; kc < 8; ++kc) s += *(const f32x4*)(part + ((size_t)kc * MS + r) * NQKV + c);
            u32x2 w; w.x = cvt_pk_bf16(s[0], s[1]); w.y = cvt_pk_bf16(s[2], s[3]); *(u32x2*)(qkv + (size_t)(MP + r) * LDQ + c) = w;
            const int which = c / D;
            if (which != 0) { const int hh = (c % D) / HD, d = c % HD; const bool isv = which == 2; float* dst;
                if (hh < HA) dst = P.out + (isv ? O_AV_S : O_AK_S) + ((size_t)(layer * MS + r) * HA + hh) * HD + d;
                else if (hh < HA + HB) dst = P.out + (isv ? O_BV_S : O_BK_S) + ((size_t)(layer * MS + r) * HB + (hh - HA)) * HD + d;
                else dst = P.out + (isv ? O_CV_S : O_CK_S) + ((size_t)(layer * MS + r) * HC + (hh - HA - HB)) * HD + d;
                *(f32x4*)dst = s; } }
}
__device__ __forceinline__ void finish_act(const Params& P, const Ctx& C) {
    const float* part = (const float*)(P.ws + WS_PART); bf16* act = (bf16*)(P.ws + WS_QKV);
    for (int r = C.blk; r < MS; r += C.G)
        for (int j4 = C.tid; j4 < DFF / 4; j4 += 512) { const int j = j4 * 4, cg = (j >> 7) * 256 + (j & 127); f32x4 g = (f32x4){0.f, 0.f, 0.f, 0.f}, up = g;
#pragma unroll
            for (int kc = 0; kc < 4; ++kc) { const float* pr = part + ((size_t)kc * MS + r) * (2 * DFF) + cg; g += *(const f32x4*)pr; up += *(const f32x4*)(pr + 128); }
            float o[4];
#pragma unroll
            for (int i = 0; i < 4; ++i) o[i] = g[i] * fast_rcp(1.0f + fast_exp2(-g[i] * LOG2E)) * up[i];
            u32x2 w; w.x = cvt_pk_bf16(o[0], o[1]); w.y = cvt_pk_bf16(o[2], o[3]); *(u32x2*)(act + (size_t)(MP + r) * LDACT + j) = w; }
}

namespace att {
constexpr int KROW = 272, VROW = 144;
constexpr int KBUF = 64 * KROW, VBUF = 128 * VROW;
constexpr int OFF_K = 0, OFF_V = 2 * KBUF, OFF_FB = OFF_V + 2 * VBUF, OFF_REL = OFF_FB + 512, OFF_VOTE = OFF_REL + 1040, OFF_QW = OFF_VOTE + 64;
static_assert(OFF_QW + 16 <= RING_BYTES && (OFF_REL % 16) == 0 && (OFF_VOTE % 16) == 0, "attention LDS map");
constexpr float STICK_STOP = -105.0f;

struct Unit {
    const bf16* q; bf16* o; int ostride; int nq, qpos0, kv_len, new_pos0;
    const bf16 *kn, *vn, *kc, *vc; int cstride;
    int t_hi, t_lo;
    const float* F; float fref; float kmax;
    const float* rel;
};

__device__ __forceinline__ float partner32(float x, int hi) {
    auto rr = __builtin_amdgcn_permlane32_swap(__float_as_uint(x), __float_as_uint(x), false, false);
    return __uint_as_float(hi ? rr[0] : rr[1]);
}
__device__ __forceinline__ bf16x8 pack8(float a0, float a1, float a2, float a3, float a4, float a5, float a6, float a7) {
    u32x4 w = {cvt_pk_bf16(a0, a1), cvt_pk_bf16(a2, a3), cvt_pk_bf16(a4, a5), cvt_pk_bf16(a6, a7)};
    return __builtin_bit_cast(bf16x8, w);
}

template <int MODE>
__device__ __forceinline__ void run_unit(LAS unsigned char* lds, const Unit& u, int tid, int wave, int lane) {
    const int qr = lane & 31, hi = lane >> 5;
    const bool active = wave * 32 < u.nq;
    const int qpos_w0 = u.qpos0 + wave * 32, qpos = qpos_w0 + qr;
    int w_hi, w_lo;
    if (MODE == 0) { const int n = qpos_w0 >> 6; w_hi = n; w_lo = n - 8 > 0 ? n - 8 : 0; }
    else if (MODE == 1) { w_hi = (qpos_w0 + 31) >> 6; w_lo = 0; }
    else { w_hi = (qpos_w0 + 30) >> 6; w_lo = 0; }
    const int near_lo = (qpos_w0 >> 6) - 2;
    bf16x8 qf[8];
    { const bf16* qp = u.q + (size_t)((active ? wave * 32 : 0) + qr) * LDQ + 8 * hi;
#pragma unroll
      for (int ds = 0; ds < 8; ++ds) qf[ds] = *(const bf16x8*)(qp + 16 * ds); }
    float qk_bound = 0.f;
    if (MODE == 1) { float s = 0.f;
#pragma unroll
        for (int ds = 0; ds < 8; ++ds) { const u32x4 w = __builtin_bit_cast(u32x4, qf[ds]);
#pragma unroll
            for (int i = 0; i < 4; ++i) { const float lo = __uint_as_float(w[i] << 16), hi2 = __uint_as_float(w[i] & 0xffff0000u); s += lo * lo + hi2 * hi2; } }
        s += partner32(s, hi); qk_bound = sqrtf(s) * u.kmax; }
    LAS float* rel_l = (LAS float*)(lds + OFF_REL);
    if (MODE == 0) { for (int i = tid; i < 257; i += 512) rel_l[i] = u.rel[i * HA] * INV_SCALE; }
    f32x16 o[4];
#pragma unroll
    for (int b = 0; b < 4; ++b)
#pragma unroll
        for (int r = 0; r < 16; ++r) o[b][r] = 0.f;
    float m_run = -1e30f, l_run = 0.f, carry = 0.f;
    const int k_key = tid >> 4, k_dc = tid & 15;
    const int k_lds = k_key * KROW + k_dc * 16;
    const int v_dc = lane & 15, v_kq = lane >> 4;
    const int v_key0 = 16 * (wave >> 1) + 4 * (wave & 1) + 2 * (v_kq & 1) + 8 * (v_kq >> 1);
    const int v_pos0 = (v_key0 & ~0xC) | ((v_key0 & 4) << 1) | ((v_key0 & 8) >> 1);
    const int v_lds = (8 * v_dc) * VROW + ((((v_pos0 >> 3) ^ ((v_dc >> 1) & 7))) << 4) + (v_pos0 & 7) * 2;
    const int kr_lds = qr * KROW + hi * 16;
    const int vr_lds = qr * VROW + ((hi ^ (qr >> 4)) << 4);
    u32x4 kreg[2], vreg[2]; float freg = 0.f;
    auto stage_load = [&](int j) {
        const int last = u.kv_len - 1;
#pragma unroll
        for (int i = 0; i < 2; ++i) { int pos = 64 * j + k_key + 32 * i; pos = pos < last ? pos : last;
            const bf16* src = pos >= u.new_pos0 ? u.kn + (size_t)(pos - u.new_pos0) * LDQ : u.kc + (size_t)pos * u.cstride;
            kreg[i] = *(const u32x4*)(src + 8 * k_dc); }
#pragma unroll
        for (int i = 0; i < 2; ++i) { int pos = 64 * j + v_key0 + i; pos = pos < last ? pos : last;
            const bf16* src = pos >= u.new_pos0 ? u.vn + (size_t)(pos - u.new_pos0) * LDQ : u.vc + (size_t)pos * u.cstride;
            vreg[i] = *(const u32x4*)(src + 8 * v_dc); }
        if (MODE == 1 && tid < 64) { int pos = 64 * j + tid; pos = pos < last ? pos : last; freg = (u.fref - u.F[(size_t)pos * HB]) * INV_SCALE; }
    };
    auto stage_store = [&](int buf) {
        LAS unsigned char* kb = lds + OFF_K + buf * KBUF + k_lds;
        *(LAS u32x4*)kb = kreg[0]; *(LAS u32x4*)(kb + 32 * KROW) = kreg[1];
        LAS unsigned char* vb = lds + OFF_V + buf * VBUF + v_lds;
        const unsigned a[4] = {vreg[0].x, vreg[0].y, vreg[0].z, vreg[0].w}, b[4] = {vreg[1].x, vreg[1].y, vreg[1].z, vreg[1].w};
#pragma unroll
        for (int i = 0; i < 4; ++i) {
            *(LAS unsigned*)(vb + (2 * i) * VROW) = (a[i] & 0xffffu) | (b[i] << 16);
            *(LAS unsigned*)(vb + (2 * i + 1) * VROW) = (a[i] >> 16) | (b[i] & 0xffff0000u); }
        if (MODE == 1 && tid < 64) ((LAS float*)(lds + OFF_FB + buf * 256))[tid] = freg;
    };
    stage_load(u.t_hi);
    stage_store(0);
    LDS_WAIT(); __syncthreads();
    bool wave_done = !active;
    for (int j = u.t_hi, it = 0;; --j, ++it) {
        const int cur = it & 1;
        const bool more = j > u.t_lo;
        if (more) stage_load(j - 1);
        if (active && j <= w_hi && j >= w_lo && !(MODE != 0 && wave_done)) {
            f32x16 p0, p1;
            if (MODE == 1) { const LAS f32x4* fb = (const LAS f32x4*)(lds + OFF_FB + cur * 256);
#pragma unroll
                for (int g = 0; g < 4; ++g) { const f32x4 a = fb[2 * g + hi], b = fb[8 + 2 * g + hi];
#pragma unroll
                    for (int i = 0; i < 4; ++i) { p0[4 * g + i] = a[i]; p1[4 * g + i] = b[i]; } } }
            else if (MODE == 0) {
                if (j >= near_lo) { const int base = qpos - 64 * j - 4 * hi + 128;
#pragma unroll
                    for (int r = 0; r < 16; ++r) { const int c = (r & 3) + 8 * (r >> 2); int i0 = base - c, i1 = base - c - 32; i0 = i0 < 256 ? i0 : 256; i1 = i1 < 256 ? i1 : 256;
                        p0[r] = rel_l[i0]; p1[r] = rel_l[i1]; } }
                else { const float cb = rel_l[256];
#pragma unroll
                    for (int r = 0; r < 16; ++r) { p0[r] = cb; p1[r] = cb; } } }
            else {
#pragma unroll
                for (int r = 0; r < 16; ++r) { p0[r] = 0.f; p1[r] = 0.f; } }
            { const LAS unsigned char* kb = lds + OFF_K + cur * KBUF + kr_lds;
#pragma unroll
              for (int ds = 0; ds < 8; ++ds) { const bf16x8 k0 = *(const LAS bf16x8*)(kb + 32 * ds), k1 = *(const LAS bf16x8*)(kb + 32 * KROW + 32 * ds);
                  p0 = __builtin_amdgcn_mfma_f32_32x32x16_bf16(k0, qf[ds], p0, 0, 0, 0); p1 = __builtin_amdgcn_mfma_f32_32x32x16_bf16(k1, qf[ds], p1, 0, 0, 0); } }
            const int kp0 = 64 * j + 4 * hi;
            if (MODE != 2) {
                const bool need_mask = MODE == 1 ? (64 * j + 63 > qpos_w0) : (64 * j + 63 >= u.kv_len);
                if (need_mask) { const int lim = MODE == 1 ? qpos + 1 : u.kv_len;
#pragma unroll
                    for (int r = 0; r < 16; ++r) { const int kp = kp0 + (r & 3) + 8 * (r >> 2);
                        if (kp >= lim) p0[r] = -__builtin_inff(); if (kp + 32 >= lim) p1[r] = -__builtin_inff(); } }
                float mx = fmaxf(p0[0], p1[0]);
#pragma unroll
                for (int r = 1; r < 16; ++r) mx = fmaxf(mx, fmaxf(p0[r], p1[r]));
                mx = fmaxf(mx, partner32(mx, hi));
                const float mn = fmaxf(m_run, mx);
                constexpr float C2 = ATT_SCALE * LOG2E;
                if (__any(mn > m_run)) { const float alpha = fast_exp2((m_run - mn) * C2); l_run *= alpha; m_run = mn;
#pragma unroll
                    for (int b = 0; b < 4; ++b)
#pragma unroll
                        for (int r = 0; r < 16; ++r) o[b][r] *= alpha; }
                const float mc = m_run * C2; float ps = 0.f;
#pragma unroll
                for (int r = 0; r < 16; ++r) { p0[r] = fast_exp2(p0[r] * C2 - mc); p1[r] = fast_exp2(p1[r] * C2 - mc); ps += p0[r] + p1[r]; }
                l_run += ps;
                if (MODE == 1) {
                    const float bmax = ((const LAS float*)(lds + OFF_FB + cur * 256))[0];
                    wave_done = __all((qk_bound + bmax - m_run) * C2 < -150.0f); }
            } else {
                const bool need_mask = 64 * j + 63 >= qpos_w0;
                float ls0[16], ls1[16];
#pragma unroll
                for (int r = 0; r < 16; ++r) {
                    const float z0 = p0[r] * ATT_SCALE, z1 = p1[r] * ATT_SCALE;
                    const float sp0 = fmaxf(z0, 0.f) + LN2 * fast_log2(1.0f + fast_exp2(-fabsf(z0) * LOG2E)), sp1 = fmaxf(z1, 0.f) + LN2 * fast_log2(1.0f + fast_exp2(-fabsf(z1) * LOG2E));
                    p0[r] = z0 - sp0; p1[r] = z1 - sp1;
                    ls0[r] = -sp0; ls1[r] = -sp1; }
                if (need_mask) {
#pragma unroll
                    for (int r = 0; r < 16; ++r) { const int kp = kp0 + (r & 3) + 8 * (r >> 2);
                        if (kp >= qpos) { ls0[r] = 0.f; p0[r] = -__builtin_inff(); } if (kp + 32 >= qpos) { ls1[r] = 0.f; p1[r] = -__builtin_inff(); } } }
                float a[8], b[8], t[8];
#pragma unroll
                for (int g = 0; g < 4; ++g) { a[g] = (ls0[4 * g] + ls0[4 * g + 1]) + (ls0[4 * g + 2] + ls0[4 * g + 3]); a[4 + g] = (ls1[4 * g] + ls1[4 * g + 1]) + (ls1[4 * g + 2] + ls1[4 * g + 3]); }
#pragma unroll
                for (int g = 0; g < 8; ++g) { b[g] = partner32(a[g], hi); t[g] = a[g] + b[g]; }
                float ps = carry;
#pragma unroll
                for (int g = 7; g >= 0; --g) {
                    const float sg = ps + (hi ? 0.f : b[g]);
                    if (g < 4) { const float e3 = sg, e2 = e3 + ls0[4 * g + 3], e1 = e2 + ls0[4 * g + 2], e0 = e1 + ls0[4 * g + 1];
                        p0[4 * g + 3] = fast_exp2((p0[4 * g + 3] + e3) * LOG2E); p0[4 * g + 2] = fast_exp2((p0[4 * g + 2] + e2) * LOG2E);
                        p0[4 * g + 1] = fast_exp2((p0[4 * g + 1] + e1) * LOG2E); p0[4 * g] = fast_exp2((p0[4 * g] + e0) * LOG2E); }
                    else { const int gg = g - 4; const float e3 = sg, e2 = e3 + ls1[4 * gg + 3], e1 = e2 + ls1[4 * gg + 2], e0 = e1 + ls1[4 * gg + 1];
                        p1[4 * gg + 3] = fast_exp2((p1[4 * gg + 3] + e3) * LOG2E); p1[4 * gg + 2] = fast_exp2((p1[4 * gg + 2] + e2) * LOG2E);
                        p1[4 * gg + 1] = fast_exp2((p1[4 * gg + 1] + e1) * LOG2E); p1[4 * gg] = fast_exp2((p1[4 * gg] + e0) * LOG2E); }
                    ps += t[g];
                }
                carry = ps;
                wave_done = __all(carry < STICK_STOP) || j == 0;
            }
            { const LAS unsigned char* vb = lds + OFF_V + cur * VBUF + vr_lds;
#pragma unroll
              for (int s = 0; s < 4; ++s) {
                  bf16x8 pf;
                  if (s == 0) pf = pack8(p0[0], p0[1], p0[2], p0[3], p0[4], p0[5], p0[6], p0[7]);
                  else if (s == 1) pf = pack8(p0[8], p0[9], p0[10], p0[11], p0[12], p0[13], p0[14], p0[15]);
                  else if (s == 2) pf = pack8(p1[0], p1[1], p1[2], p1[3], p1[4], p1[5], p1[6], p1[7]);
                  else pf = pack8(p1[8], p1[9], p1[10], p1[11], p1[12], p1[13], p1[14], p1[15]);
#pragma unroll
                  for (int db = 0; db < 4; ++db) { const bf16x8 vf = *(const LAS bf16x8*)(vb + 32 * db * VROW + ((s ^ db) << 5));
                      o[db] = __builtin_amdgcn_mfma_f32_32x32x16_bf16(vf, pf, o[db], 0, 0, 0); } } }
        }
        if (more) stage_store(cur ^ 1);
        if (MODE != 0 && lane == 0) ((LAS unsigned*)(lds + OFF_VOTE))[cur * 8 + wave] = (wave_done || j - 1 < w_lo) ? 1u : 0u;
        LDS_WAIT(); __syncthreads();
        if (!more) break;
        if (MODE != 0) { const LAS u32x4* vv = (const LAS u32x4*)(lds + OFF_VOTE + cur * 32); const u32x4 x = vv[0], y = vv[1];
            if ((x.x & x.y & x.z & x.w & y.x & y.y & y.z & y.w) != 0u) break; }
    }
    if (active) {
        float inv = 1.0f;
        if (MODE != 2) { const float lt = l_run + partner32(l_run, hi); inv = 1.0f / lt; }
        bf16* op = u.o + (size_t)(wave * 32 + qr) * u.ostride + 4 * hi;
#pragma unroll
        for (int db = 0; db < 4; ++db)
#pragma unroll
            for (int g = 0; g < 4; ++g) { u32x2 w; w.x = cvt_pk_bf16(o[db][4 * g] * inv, o[db][4 * g + 1] * inv); w.y = cvt_pk_bf16(o[db][4 * g + 2] * inv, o[db][4 * g + 3] * inv);
                *(u32x2*)(op + 32 * db + 8 * g) = w; }
    }
    __syncthreads();
}

__device__ __forceinline__ int pull(LAS unsigned char* lds, unsigned* counter, int tid) {
    LAS int* qw = (LAS int*)(lds + OFF_QW);
    if (tid == 0) *qw = (int)__hip_atomic_fetch_add(counter, 1u, __ATOMIC_RELAXED, __HIP_MEMORY_SCOPE_AGENT);
    LDS_WAIT(); __syncthreads();
    const int v = *qw;
    __syncthreads();
    return v;
}

template <int MODE>
__device__ __forceinline__ void mode_loop(const Params& P, const Ctx& C, int layer, int probe_pass) {
    constexpr int NHG = MODE == 0 ? HA : HB;
    constexpr int H0 = MODE == 0 ? 0 : (MODE == 1 ? HA : HA + HB);
    constexpr int NPU = PB * NHG * (PT / 256), NSU = SB * NHG;
    unsigned* counter = (unsigned*)(P.ws + WS_CTL) + CW_QUEUE + 64 * (layer * 3 + MODE + 8 * probe_pass);
    const bf16* qkv = (const bf16*)(P.ws + WS_QKV);
    for (;;) {
        const int i = pull(C.lds, counter, C.tid);
        if (i >= NPU + NSU) break;
        Unit u;
        if (i < NPU) {
            const int qb = (PT / 256 - 1) - i / (PB * NHG), bh = i % (PB * NHG), b = bh / NHG, hg = bh % NHG, hh = H0 + hg;
            const size_t row0 = (size_t)b * PT;
            u.q = qkv + (row0 + (size_t)qb * 256) * LDQ + hh * HD; u.nq = 256; u.qpos0 = qb * 256; u.kv_len = PT; u.new_pos0 = 0;
            u.kn = qkv + row0 * LDQ + D + hh * HD; u.vn = qkv + row0 * LDQ + 2 * D + hh * HD; u.kc = u.kn; u.vc = u.vn; u.cstride = LDQ;
            u.t_hi = 4 * qb + 3; u.t_lo = MODE == 0 ? (4 * qb - 8 > 0 ? 4 * qb - 8 : 0) : 0;
            u.F = (const float*)(P.ws + WS_FP) + row0 * HB + hg; u.fref = MODE == 1 ? u.F[(size_t)u.qpos0 * HB] : 0.f;
            u.rel = P.in[17] + (size_t)layer * 257 * HA + hh;
            u.kmax = 0.f;
            if (MODE == 1) {
                const float* kn2 = (const float*)(P.ws + WS_KN2) + ((size_t)layer * MP + row0) * HB + hg; float mx = 0.f;
                for (int t = C.tid; t < u.qpos0 + 256; t += 512) mx = fmaxf(mx, kn2[(size_t)t * HB]);
#pragma unroll
                for (int o = 1; o < 64; o <<= 1) mx = fmaxf(mx, __shfl_xor(mx, o));
                LAS float* red = (LAS float*)(C.lds + OFF_VOTE);
                if (C.lane == 0) red[C.wave] = mx;
                LDS_WAIT(); __syncthreads();
                mx = fmaxf(fmaxf(fmaxf(red[0], red[1]), fmaxf(red[2], red[3])), fmaxf(fmaxf(red[4], red[5]), fmaxf(red[6], red[7])));
                __syncthreads();
                u.kmax = sqrtf(mx) * 1.01f; }
        } else {
            const int s = i - NPU, sb = s / NHG, hg = s % NHG, hh = H0 + hg;
            constexpr int CL = MODE == 0 ? AWIN : PAST;
            const size_t row0 = (size_t)MP + (size_t)sb * ST;
            u.q = qkv + row0 * LDQ + hh * HD; u.nq = ST; u.qpos0 = CL; u.kv_len = CL + ST; u.new_pos0 = CL;
            u.kn = qkv + row0 * LDQ + D + hh * HD; u.vn = qkv + row0 * LDQ + 2 * D + hh * HD;
            const size_t coff = ((size_t)(layer * SB + sb) * CL * NHG + hg) * HD;
            u.kc = (const bf16*)(P.ws + (MODE == 0 ? WS_CAK : (MODE == 1 ? WS_CBK : WS_CCK))) + coff; u.vc = (const bf16*)(P.ws + (MODE == 0 ? WS_CAV : (MODE == 1 ? WS_CBV : WS_CCV))) + coff;
            u.cstride = NHG * HD;
            u.t_hi = (CL + ST - 1) >> 6; u.t_lo = 0;
            u.F = (const float*)(P.ws + WS_FS) + (size_t)sb * (PAST + ST) * HB + hg; u.fref = MODE == 1 ? u.F[(size_t)u.qpos0 * HB] : 0.f;
            u.rel = P.in[17] + (size_t)layer * 257 * HA + hh; u.kmax = __builtin_inff();
        }
        u.o = (bf16*)u.q; u.ostride = LDQ;
        if (probe_pass) { u.o = (bf16*)(P.ws + WS_H) + (u.q - qkv) / LDQ * LDH + (u.q - qkv) % LDQ; u.ostride = LDH; }
        run_unit<MODE>(C.lds, u, C.tid, C.wave, C.lane);
    }
}
}

#ifndef PHASE_MASK
#define PHASE_MASK 0xFFF
#endif
#define PH(n) ((PHASE_MASK >> (n)) & 1)
#ifndef DUP_MASK
#define DUP_MASK 0
#endif
#define DUP(n) ((DUP_MASK >> (n)) & 1)
typedef const Params __attribute__((address_space(4)))* KParams;
__device__ __forceinline__ const Params& kparams() {
    KParams p = (KParams)__builtin_amdgcn_kernarg_segment_ptr(); asm volatile("" : "+s"(p)); return *(const Params*)p;
}
#define P (kparams())
__device__ __forceinline__ Ctx make_ctx(LAS unsigned char* lds) {
    Ctx C; int t = threadIdx.x; asm volatile("" : "+v"(t));
    C.lds = lds; C.tid = t; C.lane = t & 63; C.wave = __builtin_amdgcn_readfirstlane(t >> 6); C.G = gridDim.x; C.blk = blockIdx.x; return C;
}
__global__ void __launch_bounds__(512, 2) hse_fwd(Params P_unused) {
    extern __shared__ __attribute__((aligned(16))) unsigned char lds_raw[];
    LAS unsigned char* const lds = (LAS unsigned char*)lds_raw;
    volatile LAS unsigned* MISC = (volatile LAS unsigned*)(lds + MISC_OFF);
    if (threadIdx.x < 64) MISC[threadIdx.x] = 0u;
    __syncthreads();
    XcdBarrier bar = xcd_barrier_post((unsigned*)(P.ws + WS_CTL) + CW_BAR, MISC + 8);

    if (PH(0)) { const Params& Q = P; const Ctx C = make_ctx(lds); p0_prologue(Q, C); }
    xcd_barrier(bar);


#pragma unroll 1
    for (int layer = 0; layer < 2; ++layer) {
        if (PH(1)) { const Params& Q = P; const Ctx C = make_ctx(lds); norm_phase<true>(Q, C, layer, layer == 0 ? Q.in[0] : Q.out + O_Y_P, layer == 0 ? Q.in[1] : Q.out + O_Y_S, Q.in[13] + layer * D, 0, D,
                                      layer == 0 ? 0 : DFF / 256, (const float*)(Q.ws + WS_MOD), 5 * D); }
        xcd_barrier(bar);
        if (PH(2)) { const Params& Q = P; const Ctx C = make_ctx(lds); fcum_phase(Q, C, layer); }
#ifdef PROBE_CLOCK
        if (layer == PROBE_CLOCK - 1 && blockIdx.x == 0 && threadIdx.x == 0) { const unsigned long long c = clock64(), t = wall_clock64(); MISC[16] = (unsigned)c; MISC[17] = (unsigned)(c >> 32); MISC[18] = (unsigned)t; MISC[19] = (unsigned)(t >> 32); }
#endif
        if (PH(3)) { const Params& Q = P; const Ctx C = make_ctx(lds); pg8::Gemm g{(const bf16*)(Q.ws + WS_H), (const bf16*)(Q.ws + WS_WIN + layer * SZ_WIN)}; pg8::StaticOrder<MP / 256, NQKV / 256> S; S.init(C.G, C.blk);
          pg8::EpiQKV E{(bf16*)(Q.ws + WS_QKV), Q.out, layer, (float*)(Q.ws + WS_KN2) + (size_t)layer * MP * HB};
          pg8::gemm_phase<pg8::EpiQKV, pg8::StaticOrder<MP / 256, NQKV / 256>, true, true, D, LDH, LDW>(C.lds + RING_OFF, g, S, E);
          if (DUP(3)) { __syncthreads(); pg8::gemm_phase<pg8::EpiQKV, pg8::StaticOrder<MP / 256, NQKV / 256>, true, true, D, LDH, LDW>(C.lds + RING_OFF, g, S, E); }
          pg8::SampleOrder<MP / 256, NQKV / 256, 8> SS; SS.init(C.G, C.blk); pg8::EpiPartial<NQKV> EP{(float*)(Q.ws + WS_PART)};
          pg8::gemm_phase<pg8::EpiPartial<NQKV>, pg8::SampleOrder<MP / 256, NQKV / 256, 8>, true, true, 256, LDH, LDW>(C.lds + RING_OFF, g, SS, EP); }
#ifdef PROBE_CLOCK
        if (layer == PROBE_CLOCK - 1 && blockIdx.x == 0 && threadIdx.x == 0) { const unsigned long long c = clock64(), t = wall_clock64();
            const unsigned long long c0 = ((unsigned long long)MISC[17] << 32) | MISC[16], t0 = ((unsigned long long)MISC[19] << 32) | MISC[18];
            MISC[20] = (unsigned)(((c - c0) * 100ull) / (t - t0)); }
#endif
        xcd_barrier(bar);
        if (PH(3)) { const Params& Q = P; const Ctx C = make_ctx(lds); finish_qkv(Q, C, layer); }
        xcd_barrier(bar);
#if DUP_MASK & 0x70
        if (DUP(4)) { const Params& Q = P; const Ctx C = make_ctx(lds); att::mode_loop<1>(Q, C, layer, 1); }
        if (DUP(5)) { const Params& Q = P; const Ctx C = make_ctx(lds); att::mode_loop<0>(Q, C, layer, 1); }
        if (DUP(6)) { const Params& Q = P; const Ctx C = make_ctx(lds); att::mode_loop<2>(Q, C, layer, 1); }
#endif
        if (PH(4)) { const Params& Q = P; const Ctx C = make_ctx(lds); att::mode_loop<1>(Q, C, layer, 0); }
        if (PH(5)) { const Params& Q = P; const Ctx C = make_ctx(lds); att::mode_loop<0>(Q, C, layer, 0); }
        if (PH(6)) { const Params& Q = P; const Ctx C = make_ctx(lds); att::mode_loop<2>(Q, C, layer, 0); }
        xcd_barrier(bar);
        if (PH(7)) { const Params& Q = P; const Ctx C = make_ctx(lds); pg8::Gemm g{(const bf16*)(Q.ws + WS_QKV), (const bf16*)(Q.ws + WS_WO + layer * SZ_WO)}; pg8::StaticOrder<MP / 256, D / 256> S; S.init(C.G, C.blk);
          pg8::EpiResid E{layer == 0 ? Q.in[0] : Q.out + O_Y_P, Q.out + O_Y_P, (const float*)(Q.ws + WS_MOD) + (size_t)layer * NMIDX * NMOD + 2 * D};
          pg8::gemm_phase<pg8::EpiResid, pg8::StaticOrder<MP / 256, D / 256>, true, true, D, LDQ, LDW>(C.lds + RING_OFF, g, S, E);
          pg8::SampleOrder<MP / 256, D / 256, 8> SS; SS.init(C.G, C.blk); pg8::EpiPartial<D> EP{(float*)(Q.ws + WS_PART)};
          pg8::gemm_phase<pg8::EpiPartial<D>, pg8::SampleOrder<MP / 256, D / 256, 8>, true, true, 256, LDQ, LDW>(C.lds + RING_OFF, g, SS, EP); }
        xcd_barrier(bar);
        if (PH(8)) { const Params& Q = P; const Ctx C = make_ctx(lds); norm_phase<false>(Q, C, layer, Q.out + O_Y_P, layer == 0 ? Q.in[1] : Q.out + O_Y_S, Q.in[14] + layer * D, 3 * D, 4 * D,
                                       D / 256, (const float*)(Q.ws + WS_MOD) + (size_t)layer * NMIDX * NMOD, 2 * D); }
        xcd_barrier(bar);
        if (PH(9)) { const Params& Q = P; const Ctx C = make_ctx(lds); pg8::Gemm g{(const bf16*)(Q.ws + WS_H), (const bf16*)(Q.ws + WS_WGU + layer * SZ_WGU)}; pg8::StaticOrder<MP / 256, 2 * DFF / 256> S; S.init(C.G, C.blk);
          pg8::EpiSwiGLU E{(bf16*)(Q.ws + WS_QKV)};
          pg8::gemm_phase<pg8::EpiSwiGLU, pg8::StaticOrder<MP / 256, 2 * DFF / 256>, true, true, D, LDH, LDW>(C.lds + RING_OFF, g, S, E);
          if (DUP(9)) { __syncthreads(); pg8::gemm_phase<pg8::EpiSwiGLU, pg8::StaticOrder<MP / 256, 2 * DFF / 256>, true, true, D, LDH, LDW>(C.lds + RING_OFF, g, S, E); }
          pg8::SampleOrder<MP / 256, 2 * DFF / 256, 4> SS; SS.init(C.G, C.blk); pg8::EpiPartial<2 * DFF> EP{(float*)(Q.ws + WS_PART)};
          pg8::gemm_phase<pg8::EpiPartial<2 * DFF>, pg8::SampleOrder<MP / 256, 2 * DFF / 256, 4>, true, true, 512, LDH, LDW>(C.lds + RING_OFF, g, SS, EP); }
        xcd_barrier(bar);
        if (PH(9)) { const Params& Q = P; const Ctx C = make_ctx(lds); finish_act(Q, C); }
        xcd_barrier(bar);
        if (PH(10)) { const Params& Q = P; const Ctx C = make_ctx(lds); pg8::Gemm g{(const bf16*)(Q.ws + WS_QKV), (const bf16*)(Q.ws + WS_WDN + layer * SZ_WDN)}; pg8::StaticOrder<MP / 256, D / 256> S; S.init(C.G, C.blk);
          pg8::EpiResid E{Q.out + O_Y_P, Q.out + O_Y_P, (const float*)(Q.ws + WS_MOD) + (size_t)layer * NMIDX * NMOD + 5 * D};
          pg8::gemm_phase<pg8::EpiResid, pg8::StaticOrder<MP / 256, D / 256>, true, true, DFF, LDACT, LDWD>(C.lds + RING_OFF, g, S, E);
          pg8::SampleOrder<MP / 256, D / 256, DFF / 256> SS; SS.init(C.G, C.blk); pg8::EpiPartial<D> EP{(float*)(Q.ws + WS_PART)};
          pg8::gemm_phase<pg8::EpiPartial<D>, pg8::SampleOrder<MP / 256, D / 256, DFF / 256>, true, true, 256, LDACT, LDWD>(C.lds + RING_OFF, g, SS, EP); }
        xcd_barrier(bar);
    }
    if (PH(11)) { const Params& Q = P; const Ctx C = make_ctx(lds); final_norm(Q, C); }
#ifdef PROBE_CLOCK
    if (blockIdx.x == 0 && threadIdx.x == 0) { const unsigned long long t0 = wall_clock64(), wait = (unsigned long long)MISC[20] * 100ull; while (wall_clock64() - t0 < wait) __builtin_amdgcn_s_sleep(8); }
#endif
}
#undef P

extern "C" void kernel_launch(void* const* d_in, const int* in_sizes, int n_in, void* d_out, int out_size, void* d_ws, size_t ws_size, hipStream_t stream) {
    static int grid = 0;
    if (grid == 0) {
        if (n_in != 23 || (size_t)out_size != O_END || ws_size < WS_END) {
            fprintf(stderr, "kernel_launch: unexpected shapes (n_in %d, out %d (want %zu), ws %zu (want >= %zu)); nothing launched\n", n_in, out_size, (size_t)O_END, ws_size, (size_t)WS_END); grid = -1; return; }
        int dev = 0, cus = 0, per_cu = 0;
        if (hipGetDevice(&dev) != hipSuccess || hipDeviceGetAttribute(&cus, hipDeviceAttributeMultiprocessorCount, dev) != hipSuccess) { grid = -1; return; }
        if (hipFuncSetAttribute((const void*)hse_fwd, hipFuncAttributeMaxDynamicSharedMemorySize, LDS_BYTES) != hipSuccess) { fprintf(stderr, "kernel_launch: hipFuncSetAttribute failed\n"); grid = -1; return; }
        if (hipOccupancyMaxActiveBlocksPerMultiprocessor(&per_cu, (const void*)hse_fwd, 512, LDS_BYTES) != hipSuccess || per_cu < 1) { fprintf(stderr, "kernel_launch: occupancy query says %d\n", per_cu); (void)hipGetLastError(); grid = -1; return; }
        grid = cus;
    }
    if (grid < 0) return;
    (void)in_sizes;
    if (hipMemsetAsync((char*)d_ws + WS_CTL, 0, CTL_ZERO_BYTES, stream) != hipSuccess) return;
    Params p{};
    for (int i = 0; i < 23; ++i) p.in[i] = (const float*)d_in[i];
    p.out = (float*)d_out; p.ws = (unsigned char*)d_ws;
    hipLaunchKernelGGL(hse_fwd, dim3(grid), dim3(512), LDS_BYTES, stream, p);
}
```

```cpp
#include <hip/hip_runtime.h>
#include <cstdio>
#include <cstdint>

#define LAS __attribute__((address_space(3)))
#define GAS __attribute__((address_space(1)))
typedef unsigned short bf16;
typedef short bf16x8 __attribute__((ext_vector_type(8)));
typedef float f32x4 __attribute__((ext_vector_type(4)));
typedef float f32x2 __attribute__((ext_vector_type(2)));
typedef float f32x16 __attribute__((ext_vector_type(16)));
typedef unsigned u32x4 __attribute__((ext_vector_type(4)));
typedef unsigned u32x2 __attribute__((ext_vector_type(2)));

constexpr int D = 2048, NH = 16, HD = 128, DFF = 5632, NQKV = 6144, NIN = 6150, NMOD = 6 * D;
constexpr int PB = 4, PT = 8192, SB = 8, ST = 32, PAST = 1024, AWIN = 512;
constexpr int HA = 4, HB = 6, HC = 6;
constexpr int MP = PB * PT, MS = SB * ST, MT = MP + MS;
#ifndef ROWPAD
#define ROWPAD 64
#endif
constexpr int LDQ = NQKV + ROWPAD, LDH = D + ROWPAD, LDACT = DFF + ROWPAD, LDW = D + ROWPAD, LDWD = DFF + ROWPAD;
constexpr float EPS = 1e-6f;
constexpr float ATT_SCALE = 0.08838834764831845f, INV_SCALE = 11.313708498984761f, LOG2E = 1.4426950408889634f, LN2 = 0.6931471805599453f;
constexpr int NMIDX = PB + SB;

constexpr size_t O_Y_P = 0;
constexpr size_t O_Y_S = O_Y_P + (size_t)MP * D;
constexpr size_t O_AK_P = O_Y_S + (size_t)MS * D;
constexpr size_t SZ_A_P = (size_t)2 * PB * AWIN * HA * HD, SZ_B_P = (size_t)2 * PB * PT * HB * HD, SZ_LF_P = (size_t)2 * PB * PT * HB;
constexpr size_t SZ_A_S = (size_t)2 * SB * ST * HA * HD, SZ_B_S = (size_t)2 * SB * ST * HB * HD, SZ_LF_S = (size_t)2 * SB * ST * HB;
constexpr size_t O_AV_P = O_AK_P + SZ_A_P, O_BK_P = O_AV_P + SZ_A_P, O_BV_P = O_BK_P + SZ_B_P, O_BLF_P = O_BV_P + SZ_B_P, O_CK_P = O_BLF_P + SZ_LF_P, O_CV_P = O_CK_P + SZ_B_P;
constexpr size_t O_AK_S = O_CV_P + SZ_B_P, O_AV_S = O_AK_S + SZ_A_S, O_BK_S = O_AV_S + SZ_A_S, O_BV_S = O_BK_S + SZ_B_S, O_BLF_S = O_BV_S + SZ_B_S, O_CK_S = O_BLF_S + SZ_LF_S, O_CV_S = O_CK_S + SZ_B_S;
constexpr size_t O_END = O_CV_S + SZ_B_S;

constexpr size_t MiB = 1u << 20;
constexpr size_t WS_CTL = 0, CTL_ZERO_BYTES = 6 * MiB;
constexpr size_t WS_MOD = 2 * MiB;
constexpr size_t SZ_WIN = (size_t)NQKV * LDW * 2, SZ_WO = (size_t)D * LDW * 2, SZ_WGU = (size_t)2 * DFF * LDW * 2, SZ_WDN = (size_t)D * LDWD * 2;
constexpr size_t WS_KN2 = 4 * MiB;
constexpr size_t WS_WIN = 6 * MiB, WS_WO = WS_WIN + 2 * SZ_WIN, WS_WGU = WS_WO + 2 * SZ_WO, WS_WDN = WS_WGU + 2 * SZ_WGU;
constexpr size_t WS_H = WS_WDN + 2 * SZ_WDN;
constexpr size_t WS_QKV = WS_H + (size_t)MT * LDH * 2;
constexpr size_t WS_CACHE = WS_QKV + (size_t)MT * LDQ * 2;
constexpr size_t SZ_CA = (size_t)2 * SB * AWIN * HA * HD * 2, SZ_CB = (size_t)2 * SB * PAST * HB * HD * 2;
constexpr size_t WS_CAK = WS_CACHE, WS_CAV = WS_CAK + SZ_CA, WS_CBK = WS_CAV + SZ_CA, WS_CBV = WS_CBK + SZ_CB, WS_CCK = WS_CBV + SZ_CB, WS_CCV = WS_CCK + SZ_CB;
constexpr size_t WS_FP = WS_CCV + SZ_CB;
constexpr size_t WS_FS = WS_FP + (size_t)PB * PT * HB * 4;
constexpr size_t WS_PART = (WS_FS + (size_t)SB * (PAST + ST) * HB * 4 + 4095) / 4096 * 4096;
constexpr size_t WS_END = WS_PART + (size_t)8 * MS * NQKV * 4 + 4096;
static_assert((size_t)4 * MS * 2 * DFF * 4 <= (size_t)8 * MS * NQKV * 4 && (size_t)22 * MS * D * 4 <= (size_t)8 * MS * NQKV * 4, "partials buffer");
static_assert((size_t)MT * LDACT * 2 <= (size_t)MT * LDQ * 2, "ACT overlays QKV");
constexpr int CW_TMO = 0, CW_BAR = 4096, CW_QUEUE = 16384;

constexpr int RING_OFF = 0, RING_BYTES = 131072;
constexpr int MISC_OFF = RING_BYTES;
constexpr int LDS_BYTES = 147456;

#define LDS_WAIT() asm volatile("s_waitcnt lgkmcnt(0)" ::: "memory")
#define VM_WAIT() asm volatile("s_waitcnt vmcnt(0)" ::: "memory")
__device__ __forceinline__ unsigned cvt_pk_bf16(float lo, float hi) { unsigned r; asm volatile("v_cvt_pk_bf16_f32 %0, %1, %2" : "=v"(r) : "v"(lo), "v"(hi)); return r; }
__device__ __forceinline__ float fast_exp2(float x) { return __builtin_amdgcn_exp2f(x); }
__device__ __forceinline__ float fast_log2(float x) { return __builtin_amdgcn_logf(x); }
__device__ __forceinline__ float fast_rcp(float x) { return __builtin_amdgcn_rcpf(x); }
template <int CTRL, int ROWMASK> __device__ __forceinline__ float dpp_take(float v) {
    return __builtin_bit_cast(float, __builtin_amdgcn_update_dpp(0, __builtin_bit_cast(int, v), CTRL, ROWMASK, 0xf, false));
}
__device__ __forceinline__ float wave_sum(float v) {
    v += dpp_take<0x111, 0xf>(v); v += dpp_take<0x112, 0xf>(v); v += dpp_take<0x114, 0xf>(v); v += dpp_take<0x118, 0xf>(v);
    v += dpp_take<0x142, 0xa>(v); v += dpp_take<0x143, 0xc>(v);
    return __builtin_bit_cast(float, __builtin_amdgcn_readlane(__builtin_bit_cast(int, v), 63));
}
namespace pg8 {
#define PG8_LAS __attribute__((address_space(3)))
typedef unsigned short bf16_t;
typedef short bf16x8 __attribute__((ext_vector_type(8)));
typedef float f32x4 __attribute__((ext_vector_type(4)));
typedef unsigned u32x4 __attribute__((ext_vector_type(4)));
constexpr int BM = 256, BK = 64, HALF = 128, HTB = HALF * BK * 2  , STAGE_BYTES = 8 * HTB, NXCD = 8, WGM = 8;

__host__ __device__ __forceinline__ int lds_byte(int r, int c) { const int st = (r >> 4) * 2 + (c >> 5), rr = r & 15, cc = c & 31, ob = rr * 64 + cc * 2; return st * 1024 + (ob ^ (((ob >> 9) & 1) << 5)); }
__host__ __device__ __forceinline__ void stage_rc(int b, int& R, int& C) { const int st = b / 1024, sb = b % 1024, swz = sb ^ (((sb >> 9) & 1) << 5); R = (st >> 1) * 16 + swz / 64; C = (st & 1) * 32 + (swz % 64) / 2; }
__host__ __device__ __forceinline__ int perm32(int rho) { const int n = rho >> 4, i = rho & 15; return 8 * (i >> 2) + 4 * n + (i & 3); }

struct Unit { int pm, pn, kc; };
struct Gemm { const bf16_t* A; const bf16_t* Bt; };

template <int NM, int NN> struct StaticOrder {
    int G, c;
    __host__ __device__ void init(int G_, int c_) { G = G_; c = c_; }
    __host__ __device__ bool next(int i, Unit& u) const {
        constexpr int nM = NM, nN = NN, nwg = NM * NN;
        const int L = i * G + c; if (L >= nwg) return false;
        int wgid = L; { constexpr int q = nwg / NXCD, r = nwg % NXCD; const int xcd = wgid % NXCD, off = wgid / NXCD; wgid = (xcd < r ? xcd * (q + 1) : r * (q + 1) + (xcd - r) * q) + off; }
        constexpr int nig = WGM * nN; const int gid = wgid / nig, fm = gid * WGM, gsz = (nM - fm) < WGM ? (nM - fm) : WGM;
        u.pm = fm + ((wgid % nig) % gsz); u.pn = (wgid % nig) / gsz; u.kc = 0; return true;
    }
    __device__ __forceinline__ void a_ready(const Unit&) const {}
    __device__ __forceinline__ void done(const Unit&) const {}
};

__device__ __forceinline__ unsigned cvt_pk_bf16(float lo, float hi) { unsigned r; asm volatile("v_cvt_pk_bf16_f32 %0, %1, %2" : "=v"(r) : "v"(lo), "v"(hi)); return r; }

struct EpiQKV {
    static constexpr bool PERM = true, AFTER_DRAIN = false, PROBE_DUP = true;
    bf16_t* QKV; float* out; int layer; float* kn2;
    __device__ __forceinline__ void operator()(const f32x4 (&acc)[2][2][4][2], const Unit& u, int wr, int wc, int fr, int fq) const {
        const int which = u.pn >> 3;
        const int rl0 = wr * 64 + fr;
        const int d0 = wc * 32 + 8 * fq;
        bf16_t* qbase = QKV + (size_t)(u.pm * BM + rl0) * ::LDQ + u.pn * BM + d0;
        float* fb[2]; int rstride[2]; bool en[2];
#pragma unroll
        for (int bj = 0; bj < 2; ++bj) {
            const int hh = (u.pn & 7) * 2 + bj;
            en[bj] = which != 0; fb[bj] = out; rstride[bj] = 0;
            if (which != 0) {
                const bool isv = which == 2;
                {
                    const int b = u.pm >> 5, t0 = (u.pm & 31) * 256;
                    if (hh < ::HA) { en[bj] = t0 >= ::PT - ::AWIN; rstride[bj] = ::HA * ::HD;
                        fb[bj] = out + (isv ? ::O_AV_P : ::O_AK_P) + ((size_t)((layer * ::PB + b) * ::AWIN + (t0 - (::PT - ::AWIN))) * ::HA + hh) * ::HD; }
                    else { const int hg = hh < ::HA + ::HB ? hh - ::HA : hh - ::HA - ::HB; rstride[bj] = ::HB * ::HD;
                        const size_t ob = hh < ::HA + ::HB ? (isv ? ::O_BV_P : ::O_BK_P) : (isv ? ::O_CV_P : ::O_CK_P);
                        fb[bj] = out + ob + ((size_t)((layer * ::PB + b) * ::PT + t0) * ::HB + hg) * ::HD; }
                }
            }
        }
#pragma unroll
        for (int ai = 0; ai < 2; ++ai)
#pragma unroll
            for (int m = 0; m < 4; ++m) { const int rl = rl0 + ai * HALF + m * 16; bf16_t* rowp = qbase + (size_t)(ai * HALF + m * 16) * ::LDQ;
#pragma unroll
                for (int bj = 0; bj < 2; ++bj) { const f32x4 v0 = acc[ai][bj][m][0], v1 = acc[ai][bj][m][1];
                    u32x4 w; w.x = cvt_pk_bf16(v0[0], v0[1]); w.y = cvt_pk_bf16(v0[2], v0[3]); w.z = cvt_pk_bf16(v1[0], v1[1]); w.w = cvt_pk_bf16(v1[2], v1[3]);
                    *(u32x4*)(rowp + bj * HALF) = w;
                    if (en[bj]) { float* fp = fb[bj] + (size_t)rl * rstride[bj] + d0; *(f32x4*)fp = v0; *(f32x4*)(fp + 4) = v1; }
                    if (which == 1) { const int hh = (u.pn & 7) * 2 + bj;
                        if (hh >= ::HA && hh < ::HA + ::HB) {
                            float s = (v0[0] * v0[0] + v0[1] * v0[1]) + (v0[2] * v0[2] + v0[3] * v0[3]) + (v1[0] * v1[0] + v1[1] * v1[1]) + (v1[2] * v1[2] + v1[3] * v1[3]);
                            s += __shfl_xor(s, 16); s += __shfl_xor(s, 32);
                            if (fq == 0) __hip_atomic_fetch_add(kn2 + (size_t)(u.pm * BM + rl) * ::HB + (hh - ::HA), s, __ATOMIC_RELAXED, __HIP_MEMORY_SCOPE_AGENT); } } } }
    }
};
struct EpiResid {
    static constexpr bool PERM = false, AFTER_DRAIN = false, PROBE_DUP = false;
    const float* xin_p; float* xout_p; const float* gate;
    __device__ __forceinline__ void operator()(const f32x4 (&acc)[2][2][4][2], const Unit& u, int wr, int wc, int fr, int fq) const {
        const float* xi = xin_p + (size_t)u.pm * BM * ::D; float* xo = xout_p + (size_t)u.pm * BM * ::D;
        const int col0 = u.pn * BM + wc * 32 + 4 * fq; const float* gp = gate + (size_t)(u.pm >> 5) * ::NMOD + col0;
#pragma unroll
        for (int ai = 0; ai < 2; ++ai)
#pragma unroll
            for (int m = 0; m < 4; ++m) { const int rl = ai * HALF + wr * 64 + m * 16 + fr; const size_t off = (size_t)rl * ::D + col0;
#pragma unroll
                for (int bj = 0; bj < 2; ++bj) {
#pragma unroll
                    for (int n = 0; n < 2; ++n) { const f32x4 gv = *(const f32x4*)(gp + bj * HALF + n * 16); const f32x4 xv = *(const f32x4*)(xi + off + bj * HALF + n * 16);
                        *(f32x4*)(xo + off + bj * HALF + n * 16) = xv + gv * acc[ai][bj][m][n]; }
                    asm volatile("" ::: "memory"); } }
    }
};
struct EpiSwiGLU {
    static constexpr bool PERM = true, AFTER_DRAIN = false, PROBE_DUP = false;
    bf16_t* ACT;
    __device__ __forceinline__ void operator()(const f32x4 (&acc)[2][2][4][2], const Unit& u, int wr, int wc, int fr, int fq) const {
        bf16_t* base = ACT + (size_t)(u.pm * BM + wr * 64 + fr) * ::LDACT + u.pn * HALF + wc * 32 + 8 * fq;
#pragma unroll
        for (int ai = 0; ai < 2; ++ai)
#pragma unroll
            for (int m = 0; m < 4; ++m) { float r[8];
#pragma unroll
                for (int n = 0; n < 2; ++n)
#pragma unroll
                    for (int j = 0; j < 4; ++j) { const float g = acc[ai][0][m][n][j], up = acc[ai][1][m][n][j];
                        r[4 * n + j] = g * __builtin_amdgcn_rcpf(1.0f + __builtin_amdgcn_exp2f(-g * ::LOG2E)) * up; }
                u32x4 w; w.x = cvt_pk_bf16(r[0], r[1]); w.y = cvt_pk_bf16(r[2], r[3]); w.z = cvt_pk_bf16(r[4], r[5]); w.w = cvt_pk_bf16(r[6], r[7]);
                *(u32x4*)(base + (size_t)(ai * HALF + m * 16) * ::LDACT) = w; }
    }
};


template <int PM, int NN, int NKC> struct SampleOrder {
    int G, c;
    __host__ __device__ void init(int G_, int c_) { G = G_; c = c_; }
    __host__ __device__ bool next(int i, Unit& u) const { const int L = i * G + c; if (L >= NN * NKC) return false; u.pm = PM; u.pn = L % NN; u.kc = L / NN; return true; }
    __device__ __forceinline__ void a_ready(const Unit&) const {}
    __device__ __forceinline__ void done(const Unit&) const {}
};
template <int N> struct EpiPartial {
    static constexpr bool PERM = false, AFTER_DRAIN = false, PROBE_DUP = false;
    float* part;
    __device__ __forceinline__ void operator()(const f32x4 (&acc)[2][2][4][2], const Unit& u, int wr, int wc, int fr, int fq) const {
        float* base = part + ((size_t)u.kc * BM + wr * 64 + fr) * N + u.pn * BM + wc * 32 + 4 * fq;
#pragma unroll
        for (int ai = 0; ai < 2; ++ai)
#pragma unroll
            for (int m = 0; m < 4; ++m) { float* rowp = base + (size_t)(ai * HALF + m * 16) * N;
#pragma unroll
                for (int bj = 0; bj < 2; ++bj)
#pragma unroll
                    for (int n = 0; n < 2; ++n) *(f32x4*)(rowp + bj * HALF + n * 16) = acc[ai][bj][m][n]; }
    }
};


template <class Epi, class Sched, bool ALIGN_EPI, bool SP2, int KK, int LDA, int LDB = KK>
__device__ __forceinline__ void gemm_phase(PG8_LAS unsigned char* lds, const Gemm g, const Sched& S, const Epi& E) {
    int tid = threadIdx.x; asm volatile("" : "+v"(tid));
    const int wid = __builtin_amdgcn_readfirstlane(tid >> 6), lane = tid & 63, wr = wid >> 2, wc = wid & 3, fr = lane & 15, fq = lane >> 4;
    constexpr int K = KK, nt = K / BK, lda = LDA, ldb = LDB;
    unsigned voffA[2], voffB[2];
#pragma unroll
    for (int i = 0; i < 2; ++i) { int R, C; stage_rc(tid * 16 + i * 8192, R, C); const int Rb = Epi::PERM ? ((R & ~31) + perm32(R & 31)) : R;
        voffA[i] = (unsigned)(R * lda + C) * 2u; voffB[i] = (unsigned)(Rb * ldb + C) * 2u; }
    constexpr size_t kstep = (size_t)(BK * 2);
    constexpr size_t hstepA = (size_t)HALF * lda * 2, hstepB = (size_t)HALF * ldb * 2;
    constexpr size_t tstepA = 2 * hstepA, tstepB = 2 * hstepB;
    const unsigned ldsw = (unsigned)wid * 1024u;
    const int aoff = lds_byte(wr * 64 + fr, fq * 8), boff = lds_byte(wc * 32 + fr, fq * 8);
#define PG8_SA(b, h) (((b) * 2 + (h)) * HTB)
#define PG8_SB(b, h) ((4 + (b) * 2 + (h)) * HTB)
#define PG8_STAGE(bufoff, gbase, voff) do { _Pragma("unroll") for (int _i = 0; _i < 2; ++_i) \
        __builtin_amdgcn_global_load_lds((const unsigned*)((const char*)(gbase) + (voff)[_i]), (PG8_LAS unsigned*)(lds + (bufoff) + ldsw + _i * 8192), 16, 0, 0); } while (0)
#define PG8_LDA(dst, b, h) do { _Pragma("unroll") for (int m = 0; m < 4; ++m) _Pragma("unroll") for (int k = 0; k < 2; ++k) dst[m][k] = *(const PG8_LAS bf16x8*)(lds + PG8_SA(b, h) + aoff + m * 2048 + k * 1024); } while (0)
#define PG8_LDB(dst, b, h) do { _Pragma("unroll") for (int n = 0; n < 2; ++n) _Pragma("unroll") for (int k = 0; k < 2; ++k) dst[n][k] = *(const PG8_LAS bf16x8*)(lds + PG8_SB(b, h) + boff + n * 2048 + k * 1024); } while (0)
#define PG8_MMA(ai, bj, At, Bt) do { __builtin_amdgcn_s_setprio(1); _Pragma("unroll") for (int m = 0; m < 4; ++m) _Pragma("unroll") for (int n = 0; n < 2; ++n) _Pragma("unroll") for (int k = 0; k < 2; ++k) \
        acc[ai][bj][m][n] = __builtin_amdgcn_mfma_f32_16x16x32_bf16(Bt[n][k], At[m][k], acc[ai][bj][m][n], 0, 0, 0); __builtin_amdgcn_s_setprio(0); } while (0)
#define PG8_WAIT_V(n) asm volatile("s_waitcnt vmcnt(" #n ")" ::: "memory")
#define PG8_WAIT_L(n) asm volatile("s_waitcnt lgkmcnt(" #n ")" ::: "memory")
#define PG8_BAR __builtin_amdgcn_s_barrier()
#define PG8_SCHED __builtin_amdgcn_sched_barrier(0)
    Unit cur, nxt; int ui = 0;
    if (!S.next(0, cur)) return;
    f32x4 acc[2][2][4][2];
#pragma unroll
    for (int a = 0; a < 2; ++a)
#pragma unroll
        for (int b = 0; b < 2; ++b)
#pragma unroll
            for (int m = 0; m < 4; ++m)
#pragma unroll
                for (int n = 0; n < 2; ++n) acc[a][b][m][n] = (f32x4){0.f, 0.f, 0.f, 0.f};
    bf16x8 At[4][2], B0[2][2], B1[2][2];
    const char* cA = (const char*)g.A + (size_t)cur.pm * tstepA + (size_t)cur.kc * (K * 2); const char* cB = (const char*)g.Bt + (size_t)cur.pn * tstepB + (size_t)cur.kc * (K * 2);
    S.a_ready(cur);
    if constexpr (SP2) {
        PG8_STAGE(PG8_SB(0, 0), cB, voffB); PG8_STAGE(PG8_SB(0, 1), cB + hstepB, voffB); PG8_STAGE(PG8_SA(0, 0), cA, voffA); PG8_STAGE(PG8_SA(0, 1), cA + hstepA, voffA);
        if (wr == 1) PG8_BAR;
        PG8_WAIT_V(2); PG8_BAR;
        PG8_STAGE(PG8_SB(1, 0), cB + kstep, voffB); PG8_STAGE(PG8_SA(1, 0), cA + kstep, voffA); PG8_STAGE(PG8_SB(1, 1), cB + hstepB + kstep, voffB);
        PG8_WAIT_V(6); PG8_BAR;
    } else {
        PG8_STAGE(PG8_SB(0, 0), cB, voffB); PG8_STAGE(PG8_SA(0, 0), cA, voffA); PG8_STAGE(PG8_SB(0, 1), cB + hstepB, voffB); PG8_STAGE(PG8_SA(0, 1), cA + hstepA, voffA);
        if (wr == 1) PG8_BAR;
        PG8_WAIT_V(4); PG8_BAR;
        PG8_STAGE(PG8_SB(1, 0), cB + kstep, voffB); PG8_STAGE(PG8_SA(1, 0), cA + kstep, voffA); PG8_STAGE(PG8_SB(1, 1), cB + hstepB + kstep, voffB);
        PG8_WAIT_V(6); PG8_BAR;
    }
    for (;;) {
        const bool has_next = S.next(ui + 1, nxt);
        const char* nA = has_next ? (const char*)g.A + (size_t)nxt.pm * tstepA + (size_t)nxt.kc * (K * 2) : cA; const char* nB = has_next ? (const char*)g.Bt + (size_t)nxt.pn * tstepB + (size_t)nxt.kc * (K * 2) : cB;
#pragma unroll 1
        for (int t = 0; t < nt; t += 2) {
            const bool last = (t == nt - 2);
            const char* a1 = cA + (size_t)(t + 1) * kstep;
            const char* a2 = last ? nA : cA + (size_t)(t + 2) * kstep; const char* b2 = last ? nB : cB + (size_t)(t + 2) * kstep;
            const char* a3 = a2 + kstep; const char* b3 = b2 + kstep;
            if (last && has_next) S.a_ready(nxt);
            if constexpr (SP2) {
            PG8_LDB(B0, 0, 0); PG8_LDB(B1, 0, 1); PG8_SCHED; PG8_LDA(At, 0, 0); PG8_STAGE(PG8_SA(1, 1), a1 + hstepA, voffA);
            PG8_WAIT_V(8); PG8_WAIT_L(0); PG8_BAR; PG8_MMA(0, 0, At, B0); PG8_MMA(0, 1, At, B1); PG8_BAR; PG8_SCHED;
            PG8_LDA(At, 0, 1); PG8_STAGE(PG8_SB(0, 0), b2, voffB); PG8_STAGE(PG8_SB(0, 1), b2 + hstepB, voffB); PG8_STAGE(PG8_SA(0, 0), a2, voffA);
            PG8_WAIT_V(8); PG8_WAIT_L(0); PG8_BAR; PG8_MMA(1, 0, At, B0); PG8_MMA(1, 1, At, B1); PG8_BAR; PG8_SCHED;
            PG8_LDB(B0, 1, 0); PG8_LDB(B1, 1, 1); PG8_SCHED; PG8_LDA(At, 1, 0); PG8_STAGE(PG8_SA(0, 1), a2 + hstepA, voffA);
            PG8_WAIT_V(8); PG8_WAIT_L(0); PG8_BAR; PG8_MMA(0, 0, At, B0); PG8_MMA(0, 1, At, B1); PG8_BAR; PG8_SCHED;
            PG8_LDA(At, 1, 1); PG8_STAGE(PG8_SB(1, 0), b3, voffB); PG8_STAGE(PG8_SB(1, 1), b3 + hstepB, voffB); PG8_STAGE(PG8_SA(1, 0), a3, voffA);
            PG8_WAIT_V(8); PG8_WAIT_L(0); PG8_BAR; PG8_MMA(1, 0, At, B0); PG8_MMA(1, 1, At, B1); PG8_BAR; PG8_SCHED;
            } else {
            PG8_LDB(B0, 0, 0); PG8_SCHED; PG8_LDA(At, 0, 0); PG8_STAGE(PG8_SA(1, 1), a1 + hstepA, voffA);
            PG8_WAIT_L(8); PG8_BAR; PG8_WAIT_L(0); PG8_MMA(0, 0, At, B0); PG8_BAR; PG8_SCHED;
            PG8_LDB(B1, 0, 1); PG8_STAGE(PG8_SB(0, 0), b2, voffB);
            PG8_BAR; PG8_WAIT_L(0); PG8_MMA(0, 1, At, B1); PG8_BAR;
            PG8_LDA(At, 0, 1); PG8_STAGE(PG8_SA(0, 0), a2, voffA);
            PG8_BAR; PG8_WAIT_L(0); PG8_MMA(1, 0, At, B0); PG8_BAR; PG8_SCHED;
            PG8_STAGE(PG8_SB(0, 1), b2 + hstepB, voffB);
            PG8_WAIT_V(6); PG8_BAR; PG8_MMA(1, 1, At, B1); PG8_BAR;
            PG8_LDB(B0, 1, 0); PG8_SCHED; PG8_LDA(At, 1, 0); PG8_STAGE(PG8_SA(0, 1), a2 + hstepA, voffA);
            PG8_WAIT_L(8); PG8_BAR; PG8_WAIT_L(0); PG8_MMA(0, 0, At, B0); PG8_BAR; PG8_SCHED;
            PG8_LDB(B1, 1, 1); PG8_STAGE(PG8_SB(1, 0), b3, voffB);
            PG8_BAR; PG8_WAIT_L(0); PG8_MMA(0, 1, At, B1); PG8_BAR;
            PG8_LDA(At, 1, 1); PG8_STAGE(PG8_SA(1, 0), a3, voffA);
            PG8_BAR; PG8_WAIT_L(0); PG8_MMA(1, 0, At, B0); PG8_BAR; PG8_SCHED;
            PG8_STAGE(PG8_SB(1, 1), b3 + hstepB, voffB);
            PG8_WAIT_V(6); PG8_BAR; PG8_MMA(1, 1, At, B1); PG8_BAR;
            }
        }
        if constexpr (ALIGN_EPI) { if (wr == 0) PG8_BAR; }
        if constexpr (!Epi::AFTER_DRAIN) { E(acc, cur, wr, wc, fr, fq);
#ifdef PROBE_EPI_DUP
            if constexpr (Epi::PROBE_DUP) { asm volatile("" ::: "memory"); E(acc, cur, wr, wc, fr, fq); }
#endif
            S.done(cur); }
        if (!has_next) break;
#pragma unroll
        for (int a = 0; a < 2; ++a)
#pragma unroll
            for (int b = 0; b < 2; ++b)
#pragma unroll
                for (int m = 0; m < 4; ++m)
#pragma unroll
                    for (int n = 0; n < 2; ++n) acc[a][b][m][n] = (f32x4){0.f, 0.f, 0.f, 0.f};
        cur = nxt; cA = nA; cB = nB; ++ui;
        if constexpr (ALIGN_EPI) { if (wr == 1) PG8_BAR; }
    }
    PG8_WAIT_V(0);
    if constexpr (!ALIGN_EPI) { if (wr == 0) PG8_BAR; }
    PG8_BAR;
    if constexpr (Epi::AFTER_DRAIN) { E.fused(acc, cur, wr, wc, fr, fq, lds, wid, lane); S.done(cur); }
#undef PG8_SA
#undef PG8_SB
#undef PG8_STAGE
#undef PG8_LDA
#undef PG8_LDB
#undef PG8_MMA
#undef PG8_WAIT_V
#undef PG8_WAIT_L
#undef PG8_BAR
#undef PG8_SCHED
}
}

#define XB_TMO      128
#define XB_XCNT(j)  (256  + 64 * (j))
#define XB_XSUB(j)  (1280 + 64 * (j))
#define XB_XGEN(j)  (2304 + 64 * (j))
#define XB_TOP      3328
#define XB_TOPGEN   3392
#define XCD_BAR_WORDS 3456
#define XB_SPIN_CAP (1u << 18)

__device__ __forceinline__ unsigned xb_ld(unsigned* p)              { return __hip_atomic_load(p, __ATOMIC_RELAXED, __HIP_MEMORY_SCOPE_AGENT); }
__device__ __forceinline__ unsigned xb_add(unsigned* p, unsigned v) { return __hip_atomic_fetch_add(p, v, __ATOMIC_RELAXED, __HIP_MEMORY_SCOPE_AGENT); }
__device__ __forceinline__ unsigned xb_xcc_id() { return (unsigned)__builtin_amdgcn_s_getreg((3 << 11) | 20) & 0xFu; }
#define XB_SPIN(cond, bar) do { unsigned _sp = 0; while (cond) { __builtin_amdgcn_s_sleep(1); \
    if ((++_sp & 255u) == 0u) { if (xb_ld(&(bar)[XB_TMO])) break; if (_sp > XB_SPIN_CAP) { atomicAdd(&(bar)[XB_TMO], 1u); break; } } } } while (0)

struct XcdBarrier {
    unsigned* bar; unsigned x;
    volatile LAS unsigned* st;
};

__device__ __forceinline__ XcdBarrier xcd_barrier_post(unsigned* bar, volatile LAS unsigned* st) {
    XcdBarrier b; b.bar = bar; b.x = xb_xcc_id(); b.st = st;
    if (threadIdx.x == 0) (void)xb_add(&bar[XB_XCNT(b.x)], 1u);
    return b;
}
__device__ __forceinline__ void xcd_barrier_complete(unsigned* bar, unsigned x, unsigned& nloc, unsigned& nx) {
    const unsigned G = gridDim.x * gridDim.y * gridDim.z;
    unsigned sum, cnt, mine, sp = 0u;
    for (;;) {
        sum = 0u; cnt = 0u; mine = 0u;
#pragma unroll
        for (unsigned j = 0; j < 16; ++j) { const unsigned c = xb_ld(&bar[XB_XCNT(j)]); sum += c; cnt += (c > 0u) ? 1u : 0u; mine = (j == x) ? c : mine; }
        if (sum == G) break;
        __builtin_amdgcn_s_sleep(1);
        if ((++sp & 255u) == 0u) { if (xb_ld(&bar[XB_TMO])) break; if (sp > XB_SPIN_CAP) { atomicAdd(&bar[XB_TMO], 1u); break; } }
    }
    nloc = mine > 0u ? mine : 1u; nx = cnt > 0u ? cnt : 1u;
}

__device__ __forceinline__ void xcd_barrier(const XcdBarrier& b) {
    asm volatile("s_waitcnt vmcnt(0)" ::: "memory");
    __syncthreads();
    if (threadIdx.x == 0) {
        unsigned* bar = b.bar; asm volatile("" : "+s"(bar));
        __builtin_amdgcn_s_waitcnt(0);
        unsigned nloc = b.st[0], nx = b.st[1];
        unsigned bx = b.x; asm volatile("" : "+s"(bx));
        if (nloc == 0u) { xcd_barrier_complete(bar, bx, nloc, nx); b.st[0] = nloc; b.st[1] = nx; }
        const unsigned old = xb_add(&bar[XB_XSUB(bx)], 1u);
        const unsigned gen = old / nloc;
        if (old + 1u == (gen + 1u) * nloc) {
            __builtin_amdgcn_fence(__ATOMIC_RELEASE, "agent");
            asm volatile("s_waitcnt vmcnt(0)" ::: "memory");
            const unsigned og = xb_add(&bar[XB_TOP], 1u);
            const unsigned tg = og / nx;
            if (og + 1u == (tg + 1u) * nx) xb_add(&bar[XB_TOPGEN], 1u);
            else XB_SPIN(xb_ld(&bar[XB_TOPGEN]) == tg, bar);
            __builtin_amdgcn_fence(__ATOMIC_ACQUIRE, "agent");
            xb_add(&bar[XB_XGEN(bx)], 1u);
            asm volatile("s_waitcnt vmcnt(0)" ::: "memory");
        } else {
            XB_SPIN(xb_ld(&bar[XB_XGEN(bx)]) == gen, bar);
            __builtin_amdgcn_fence(__ATOMIC_ACQUIRE, "agent");
            asm volatile("s_waitcnt vmcnt(0)" ::: "memory");
        }
    }
    __syncthreads();
}
struct Params {
    const float* in[23];
    float* out;
    unsigned char* ws;
};

struct Ctx {
    LAS unsigned char* lds;
    int tid, lane, wave, G, blk;
};

__device__ __forceinline__ void transpose_item(const float* W, int ld, bf16* WT, int Kd, int k0, int n0, int drow0, LAS float* scr, int lane) {
#pragma unroll 8
    for (int i = 0; i < 32; ++i) { const int kk = 2 * i + (lane >> 5); scr[kk * 33 + (lane & 31)] = W[(size_t)(k0 + kk) * ld + n0 + (lane & 31)]; }
    LDS_WAIT(); asm volatile("" ::: "memory");
    const int c = lane & 7;
#pragma unroll
    for (int j = 0; j < 4; ++j) { const int n = (lane >> 3) + 8 * j; const LAS float* s = scr + (8 * c) * 33 + n;
        u32x4 o; o.x = cvt_pk_bf16(s[0 * 33], s[1 * 33]); o.y = cvt_pk_bf16(s[2 * 33], s[3 * 33]); o.z = cvt_pk_bf16(s[4 * 33], s[5 * 33]); o.w = cvt_pk_bf16(s[6 * 33], s[7 * 33]);
        *(u32x4*)(WT + (size_t)(drow0 + n) * Kd + k0 + 8 * c) = o; }
    LDS_WAIT(); asm volatile("" ::: "memory");
}

__device__ __forceinline__ void cvt_copy(const float* src, bf16* dst, size_t n8, size_t i0, size_t stride) {
    for (size_t i = i0; i < n8; i += stride) { const f32x4 a = *(const f32x4*)(src + i * 8), b = *(const f32x4*)(src + i * 8 + 4);
        u32x4 o; o.x = cvt_pk_bf16(a[0], a[1]); o.y = cvt_pk_bf16(a[2], a[3]); o.z = cvt_pk_bf16(b[0], b[1]); o.w = cvt_pk_bf16(b[2], b[3]);
        *(u32x4*)(dst + i * 8) = o; }
}

__device__ __forceinline__ void p0_prologue(const Params& P, const Ctx& C) {
    unsigned char* ws = P.ws;
    {
        LAS float* scr = (LAS float*)(C.lds + RING_OFF + C.wave * 16384);
        const int gw = C.blk * 8 + C.wave, NGW = C.G * 8;
        constexpr int I_IN = (D / 64) * (NQKV / 32), I_O = (D / 64) * (D / 32), I_G = (D / 64) * (DFF / 32), I_D = (DFF / 64) * (D / 32);
        constexpr int I_L = I_IN + I_O + 2 * I_G + I_D;
        for (int it = gw; it < 2 * I_L; it += NGW) {
            const int l = it / I_L; int r = it % I_L;
            if (r < I_IN) { const int nb = NQKV / 32, kb = r / nb, n0 = (r % nb) * 32;
                transpose_item(P.in[15] + (size_t)l * D * NIN, NIN, (bf16*)(ws + WS_WIN + l * SZ_WIN), LDW, kb * 64, n0, n0, scr, C.lane); continue; }
            r -= I_IN;
            if (r < I_O) { const int nb = D / 32, kb = r / nb, n0 = (r % nb) * 32;
                transpose_item(P.in[18] + (size_t)l * D * D, D, (bf16*)(ws + WS_WO + l * SZ_WO), LDW, kb * 64, n0, n0, scr, C.lane); continue; }
            r -= I_O;
            if (r < 2 * I_G) { const int up = r >= I_G; if (up) r -= I_G; const int nb = DFF / 32, kb = r / nb, n0 = (r % nb) * 32;
                const int drow0 = (n0 >> 7) * 256 + (n0 & 127) + (up ? 128 : 0);
                transpose_item(P.in[up ? 20 : 19] + (size_t)l * D * DFF, DFF, (bf16*)(ws + WS_WGU + l * SZ_WGU), LDW, kb * 64, n0, drow0, scr, C.lane); continue; }
            r -= 2 * I_G;
            { const int nb = D / 32, kb = r / nb, n0 = (r % nb) * 32;
                transpose_item(P.in[21] + (size_t)l * DFF * D, D, (bf16*)(ws + WS_WDN + l * SZ_WDN), LDWD, kb * 64, n0, n0, scr, C.lane); }
        }
    }
    {
        const size_t i0 = (size_t)C.blk * 512 + C.tid, stride = (size_t)C.G * 512;
        cvt_copy(P.in[2], (bf16*)(ws + WS_CAK), SZ_CA / 16, i0, stride); cvt_copy(P.in[3], (bf16*)(ws + WS_CAV), SZ_CA / 16, i0, stride);
        cvt_copy(P.in[4], (bf16*)(ws + WS_CBK), SZ_CB / 16, i0, stride); cvt_copy(P.in[5], (bf16*)(ws + WS_CBV), SZ_CB / 16, i0, stride);
        cvt_copy(P.in[7], (bf16*)(ws + WS_CCK), SZ_CB / 16, i0, stride); cvt_copy(P.in[8], (bf16*)(ws + WS_CCV), SZ_CB / 16, i0, stride);
    }
    {
        __syncthreads();
        LAS float* st = (LAS float*)(C.lds + RING_OFF);
        for (int idx = C.tid; idx < NMIDX * D; idx += 512) { const int m = idx / D, k = idx % D;
            const float c = m < PB ? P.in[9][m * D + k] : P.in[10][(m - PB) * D + k];
            st[k * NMIDX + m] = c * fast_rcp(1.0f + fast_exp2(-c * LOG2E)); }
        __syncthreads();
        float* mod = (float*)(ws + WS_MOD);
        constexpr int KC = 256, NKC = D / KC, NNC = NMOD / 256;
        for (int it = C.wave * C.G + C.blk; it < 2 * NKC * NNC; it += 8 * C.G) {
            const int l = it / (NKC * NNC), r = it % (NKC * NNC), kc = r / NNC, nc = r % NNC, k0 = kc * KC, n0 = nc * 256 + C.lane * 4;
            const float* wp = P.in[11] + ((size_t)l * D + k0) * NMOD + n0;
            f32x4 acc[NMIDX];
#pragma unroll
            for (int m = 0; m < NMIDX; ++m) acc[m] = (f32x4){0.f, 0.f, 0.f, 0.f};
#pragma unroll 4
            for (int k = 0; k < KC; ++k) { const f32x4 w = *(const f32x4*)(wp + (size_t)k * NMOD);
                const LAS f32x4* sp = (const LAS f32x4*)(st + (k0 + k) * NMIDX); const f32x4 s0 = sp[0], s1 = sp[1], s2 = sp[2];
                acc[0] += w * s0[0]; acc[1] += w * s0[1]; acc[2] += w * s0[2]; acc[3] += w * s0[3];
                acc[4] += w * s1[0]; acc[5] += w * s1[1]; acc[6] += w * s1[2]; acc[7] += w * s1[3];
                acc[8] += w * s2[0]; acc[9] += w * s2[1]; acc[10] += w * s2[2]; acc[11] += w * s2[3]; }
            f32x4 bias = (f32x4){0.f, 0.f, 0.f, 0.f};
            if (kc == 0) bias = *(const f32x4*)(P.in[12] + (size_t)l * NMOD + n0);
#pragma unroll
            for (int m = 0; m < NMIDX; ++m) { float* mp = mod + ((size_t)l * NMIDX + m) * NMOD + n0;
#pragma unroll
                for (int j = 0; j < 4; ++j) __hip_atomic_fetch_add(mp + j, acc[m][j] + bias[j], __ATOMIC_RELAXED, __HIP_MEMORY_SCOPE_AGENT); }
        }
    }
}

template <bool WITH_LOGF>
__device__ __forceinline__ void norm_rows(const Ctx& C, const float* xrows, bf16* hrows, int nrows, const float* gvec, const float* shift, const float* scale,
                                          const LAS float* wf, const float* bf, float* lf_out) {
    f32x4 gm[8], sh[8];
#pragma unroll
    for (int j = 0; j < 8; ++j) { const int e = 4 * C.lane + 256 * j; const f32x4 g = *(const f32x4*)(gvec + e), sc = *(const f32x4*)(scale + e); sh[j] = *(const f32x4*)(shift + e); gm[j] = g * (sc + 1.0f); }
    f32x4 nx[8];
#pragma unroll
    for (int j = 0; j < 8; ++j) nx[j] = *(const f32x4*)(xrows + 4 * C.lane + 256 * j);
    for (int r = 0; r < nrows; ++r) {
        f32x4 v[8]; float ss = 0.f;
#pragma unroll
        for (int j = 0; j < 8; ++j) v[j] = nx[j];
        if (r + 1 < nrows) { const float* xr = xrows + (size_t)(r + 1) * D;
#pragma unroll
            for (int j = 0; j < 8; ++j) nx[j] = *(const f32x4*)(xr + 4 * C.lane + 256 * j); }
        asm volatile("" ::: "memory");
#pragma unroll
        for (int j = 0; j < 8; ++j) ss += (v[j][0] * v[j][0] + v[j][1] * v[j][1]) + (v[j][2] * v[j][2] + v[j][3] * v[j][3]);
        const float rstd = 1.0f / sqrtf(wave_sum(ss) * (1.0f / D) + EPS);
#pragma unroll
        for (int j = 0; j < 8; ++j) v[j] = v[j] * rstd * gm[j] + sh[j];
        bf16* hr = hrows + (size_t)r * LDH;
#pragma unroll
        for (int j = 0; j < 8; ++j) { u32x2 w; w.x = cvt_pk_bf16(v[j][0], v[j][1]); w.y = cvt_pk_bf16(v[j][2], v[j][3]); *(u32x2*)(hr + 4 * C.lane + 256 * j) = w; }
        if constexpr (WITH_LOGF) {
            float dots[6];
#pragma unroll
            for (int f = 0; f < 6; ++f) { float a = 0.f;
#pragma unroll
                for (int j = 0; j < 8; ++j) { const f32x4 w = *(const LAS f32x4*)(wf + f * D + 4 * C.lane + 256 * j); a += (v[j][0] * w[0] + v[j][1] * w[1]) + (v[j][2] * w[2] + v[j][3] * w[3]); }
                dots[f] = wave_sum(a); }
            if (C.lane < 6) { float z = C.lane == 0 ? dots[0] : C.lane == 1 ? dots[1] : C.lane == 2 ? dots[2] : C.lane == 3 ? dots[3] : C.lane == 4 ? dots[4] : dots[5];
                z += bf[C.lane];
                const float ls = fminf(z, 0.f) - LN2 * fast_log2(1.0f + fast_exp2(-fabsf(z) * LOG2E));
                lf_out[(size_t)r * HB + C.lane] = ls; }
        }
    }
}

__device__ __forceinline__ void sample_resid_row(const Ctx& C, const float* xin, float* xout, const float* part, int nkc, const float* gate) {
    f32x4 s[8];
#pragma unroll
    for (int j = 0; j < 8; ++j) s[j] = (f32x4){0.f, 0.f, 0.f, 0.f};
    for (int kc = 0; kc < nkc; ++kc) { const float* pp = part + (size_t)kc * MS * D;
#pragma unroll
        for (int j = 0; j < 8; ++j) s[j] += *(const f32x4*)(pp + 4 * C.lane + 256 * j); }
#pragma unroll
    for (int j = 0; j < 8; ++j) { const int e = 4 * C.lane + 256 * j; *(f32x4*)(xout + e) = *(const f32x4*)(xin + e) + *(const f32x4*)(gate + e) * s[j]; }
}
template <bool WITH_LOGF>
__device__ __forceinline__ void norm_phase(const Params& P, const Ctx& C, int layer, const float* xp, const float* xs, const float* gvec, int off_shift, int off_scale,
                                           int fix_nkc, const float* fix_mod, int fix_gate_off) {
    bf16* H = (bf16*)(P.ws + WS_H); const float* mod = (const float*)(P.ws + WS_MOD) + (size_t)layer * NMIDX * NMOD;
    LAS float* wf = (LAS float*)(C.lds + RING_OFF);
    if constexpr (WITH_LOGF) {
        const float* win = P.in[15] + (size_t)layer * D * NIN + NQKV;
        for (int idx = C.tid; idx < 6 * D; idx += 512) { const int k = idx / 6, f = idx % 6; wf[f * D + k] = win[(size_t)k * NIN + f]; }
        __syncthreads();
    }
    const float* bf = P.in[16] + layer * HB;
    float* lfp = P.out + O_BLF_P + (size_t)layer * PB * PT * HB; float* lfs = P.out + O_BLF_S + (size_t)layer * MS * HB;
    const int gw = C.blk * 8 + C.wave, NGW = C.G * 8;
    for (int it = gw; it < MP / 16; it += NGW) { const int r0 = it * 16, b = r0 >> 13; const float* mv = mod + (size_t)b * NMOD;
        norm_rows<WITH_LOGF>(C, xp + (size_t)r0 * D, H + (size_t)r0 * LDH, 16, gvec, mv + off_shift, mv + off_scale, wf, bf, lfp + (size_t)r0 * HB); }
    if (C.wave == 0 && xs != nullptr) for (int r = C.blk; r < MS; r += C.G) { const float* mv = mod + (size_t)(PB + (r >> 5)) * NMOD; const float* xr = xs + (size_t)r * D;
        if (fix_nkc > 0) { float* xo = P.out + O_Y_S + (size_t)r * D;
            sample_resid_row(C, xr, xo, (const float*)(P.ws + WS_PART) + (size_t)r * D, fix_nkc, fix_mod + (size_t)(PB + (r >> 5)) * NMOD + fix_gate_off); xr = xo; }
        norm_rows<WITH_LOGF>(C, xr, H + (size_t)(MP + r) * LDH, 1, gvec, mv + off_shift, mv + off_scale, wf, bf, lfs + (size_t)r * HB); }
    __syncthreads();
}

__device__ __forceinline__ void final_norm(const Params& P, const Ctx& C) {
    const float* g = P.in[22]; f32x4 gm[8];
#pragma unroll
    for (int j = 0; j < 8; ++j) gm[j] = *(const f32x4*)(g + 4 * C.lane + 256 * j);
    const int gw = C.blk * 8 + C.wave, NGW = C.G * 8;
    for (int it = gw; it < MP / 16; it += NGW) {
        float* x0 = P.out + (size_t)it * 16 * D; f32x4 nx[8];
#pragma unroll
        for (int j = 0; j < 8; ++j) nx[j] = *(const f32x4*)(x0 + 4 * C.lane + 256 * j);
        for (int r = 0; r < 16; ++r) { float* xr = x0 + (size_t)r * D; f32x4 v[8]; float ss = 0.f;
#pragma unroll
            for (int j = 0; j < 8; ++j) v[j] = nx[j];
            if (r + 1 < 16) {
#pragma unroll
                for (int j = 0; j < 8; ++j) nx[j] = *(const f32x4*)(xr + D + 4 * C.lane + 256 * j); }
            asm volatile("" ::: "memory");
#pragma unroll
            for (int j = 0; j < 8; ++j) ss += (v[j][0] * v[j][0] + v[j][1] * v[j][1]) + (v[j][2] * v[j][2] + v[j][3] * v[j][3]);
            const float rstd = 1.0f / sqrtf(wave_sum(ss) * (1.0f / D) + EPS);
#pragma unroll
            for (int j = 0; j < 8; ++j) *(f32x4*)(xr + 4 * C.lane + 256 * j) = v[j] * rstd * gm[j]; }
    }
    if (C.wave == 0) for (int rs = C.blk; rs < MS; rs += C.G) {
        float* xr = P.out + O_Y_S + (size_t)rs * D;
        sample_resid_row(C, xr, xr, (const float*)(P.ws + WS_PART) + (size_t)rs * D, DFF / 256, (const float*)(P.ws + WS_MOD) + ((size_t)NMIDX + PB + (rs >> 5)) * NMOD + 5 * D);
        f32x4 v[8]; float ss = 0.f;
#pragma unroll
        for (int j = 0; j < 8; ++j) { v[j] = *(const f32x4*)(xr + 4 * C.lane + 256 * j); ss += (v[j][0] * v[j][0] + v[j][1] * v[j][1]) + (v[j][2] * v[j][2] + v[j][3] * v[j][3]); }
        const float rstd = 1.0f / sqrtf(wave_sum(ss) * (1.0f / D) + EPS);
#pragma unroll
        for (int j = 0; j < 8; ++j) *(f32x4*)(xr + 4 * C.lane + 256 * j) = v[j] * rstd * gm[j]; }
}

__device__ __forceinline__ float block_excl_scan(const Ctx& C, LAS float* red, float s) {
    float incl = s;
#pragma unroll
    for (int o = 1; o < 64; o <<= 1) { const float t = __shfl_up(incl, o); if (C.lane >= o) incl += t; }
    if (C.lane == 63) red[C.wave] = incl;
    __syncthreads();
    float base = 0.f;
    for (int w = 0; w < C.wave; ++w) base += red[w];
    return base + incl - s;
}

__device__ __forceinline__ void fcum_phase(const Params& P, const Ctx& C, int layer) {
    LAS float* red = (LAS float*)(C.lds + RING_OFF);
    if (C.blk < PB * HB) {
        const int b = C.blk / HB, h = C.blk % HB; const float* lf = P.out + O_BLF_P + ((size_t)(layer * PB + b) * PT) * HB + h;
        float* F = (float*)(P.ws + WS_FP) + ((size_t)b * PT) * HB + h;
        float v[16]; float s = 0.f;
#pragma unroll
        for (int i = 0; i < 16; ++i) { v[i] = lf[(size_t)(C.tid * 16 + i) * HB]; s += v[i]; }
        float a = block_excl_scan(C, red, s);
#pragma unroll
        for (int i = 0; i < 16; ++i) { a += v[i]; F[(size_t)(C.tid * 16 + i) * HB] = a; }
        __syncthreads();
    } else if (C.blk < PB * HB + SB * HB) {
        const int q = C.blk - PB * HB, sb = q / HB, h = q % HB; constexpr int L = PAST + ST;
        const float* cl = P.in[6] + ((size_t)(layer * SB + sb) * PAST) * HB + h; const float* nl = P.out + O_BLF_S + ((size_t)(layer * SB + sb) * ST) * HB + h;
        float* F = (float*)(P.ws + WS_FS) + ((size_t)sb * L) * HB + h;
        float v[3]; float s = 0.f;
#pragma unroll
        for (int i = 0; i < 3; ++i) { const int p = C.tid * 3 + i; v[i] = p < PAST ? cl[(size_t)p * HB] : (p < L ? nl[(size_t)(p - PAST) * HB] : 0.f); s += v[i]; }
        float a = block_excl_scan(C, red, s);
#pragma unroll
        for (int i = 0; i < 3; ++i) { const int p = C.tid * 3 + i; a += v[i]; if (p < L) F[(size_t)p * HB] = a; }
        __syncthreads();
    }
}

__device__ __forceinline__ void finish_qkv(const Params& P, const Ctx& C, int layer) {
    const float* part = (const float*)(P.ws + WS_PART); bf16* qkv = (bf16*)(P.ws + WS_QKV);
    for (int r = C.blk; r < MS; r += C.G)
        for (int c4 = C.tid; c4 < NQKV / 4; c4 += 512) { const int c = c4 * 4; f32x4 s = (f32x4){0.f, 0.f, 0.f, 0.f};
#pragma unroll
            for (int kc = 0; kc < 8; ++kc) s += *(const f32x4*)(part + ((size_t)kc * MS + r) * NQKV + c);
            u32x2 w; w.x = cvt_pk_bf16(s[0], s[1]); w.y = cvt_pk_bf16(s[2], s[3]); *(u32x2*)(qkv + (size_t)(MP + r) * LDQ + c) = w;
            const int which = c / D;
            if (which != 0) { const int hh = (c % D) / HD, d = c % HD; const bool isv = which == 2; float* dst;
                if (hh < HA) dst = P.out + (isv ? O_AV_S : O_AK_S) + ((size_t)(layer * MS + r) * HA + hh) * HD + d;
                else if (hh < HA + HB) dst = P.out + (isv ? O_BV_S : O_BK_S) + ((size_t)(layer * MS + r) * HB + (hh - HA)) * HD + d;
                else dst = P.out + (isv ? O_CV_S : O_CK_S) + ((size_t)(layer * MS + r) * HC + (hh - HA - HB)) * HD + d;
                *(f32x4*)dst = s; } }
}
__device__ __forceinline__ void finish_act(const Params& P, const Ctx& C) {
    const float* part = (const float*)(P.ws + WS_PART); bf16* act = (bf16*)(P.ws + WS_QKV);
    for (int r = C.blk; r < MS; r += C.G)
        for (int j4 = C.tid; j4 < DFF / 4; j4 += 512) { const int j = j4 * 4, cg = (j >> 7) * 256 + (j & 127); f32x4 g = (f32x4){0.f, 0.f, 0.f, 0.f}, up = g;
#pragma unroll
            for (int kc = 0; kc < 4; ++kc) { const float* pr = part + ((size_t)kc * MS + r) * (2 * DFF) + cg; g += *(const f32x4*)pr; up += *(const f32x4*)(pr + 128); }
            float o[4];
#pragma unroll
            for (int i = 0; i < 4; ++i) o[i] = g[i] * fast_rcp(1.0f + fast_exp2(-g[i] * LOG2E)) * up[i];
            u32x2 w; w.x = cvt_pk_bf16(o[0], o[1]); w.y = cvt_pk_bf16(o[2], o[3]); *(u32x2*)(act + (size_t)(MP + r) * LDACT + j) = w; }
}

namespace att {
constexpr int KROW = 272, VROW = 144;
constexpr int KBUF = 64 * KROW, VBUF = 128 * VROW;
constexpr int OFF_K = 0, OFF_V = 2 * KBUF, OFF_FB = OFF_V + 2 * VBUF, OFF_REL = OFF_FB + 512, OFF_VOTE = OFF_REL + 1040, OFF_QW = OFF_VOTE + 64;
static_assert(OFF_QW + 16 <= RING_BYTES && (OFF_REL % 16) == 0 && (OFF_VOTE % 16) == 0, "attention LDS map");
constexpr float STICK_STOP = -105.0f;

struct Unit {
    const bf16* q; bf16* o; int ostride; int nq, qpos0, kv_len, new_pos0;
    const bf16 *kn, *vn, *kc, *vc; int cstride;
    int t_hi, t_lo;
    const float* F; float fref; float kmax;
    const float* rel;
};

__device__ __forceinline__ float partner32(float x, int hi) {
    auto rr = __builtin_amdgcn_permlane32_swap(__float_as_uint(x), __float_as_uint(x), false, false);
    return __uint_as_float(hi ? rr[0] : rr[1]);
}
__device__ __forceinline__ bf16x8 pack8(float a0, float a1, float a2, float a3, float a4, float a5, float a6, float a7) {
    u32x4 w = {cvt_pk_bf16(a0, a1), cvt_pk_bf16(a2, a3), cvt_pk_bf16(a4, a5), cvt_pk_bf16(a6, a7)};
    return __builtin_bit_cast(bf16x8, w);
}

template <int MODE>
__device__ __forceinline__ void run_unit(LAS unsigned char* lds, const Unit& u, int tid, int wave, int lane) {
    const int qr = lane & 31, hi = lane >> 5;
    const bool active = wave * 32 < u.nq;
    const int qpos_w0 = u.qpos0 + wave * 32, qpos = qpos_w0 + qr;
    int w_hi, w_lo;
    if (MODE == 0) { const int n = qpos_w0 >> 6; w_hi = n; w_lo = n - 8 > 0 ? n - 8 : 0; }
    else if (MODE == 1) { w_hi = (qpos_w0 + 31) >> 6; w_lo = 0; }
    else { w_hi = (qpos_w0 + 30) >> 6; w_lo = 0; }
    const int near_lo = (qpos_w0 >> 6) - 2;
    bf16x8 qf[8];
    { const bf16* qp = u.q + (size_t)((active ? wave * 32 : 0) + qr) * LDQ + 8 * hi;
#pragma unroll
      for (int ds = 0; ds < 8; ++ds) qf[ds] = *(const bf16x8*)(qp + 16 * ds); }
    float qk_bound = 0.f;
    if (MODE == 1) { float s = 0.f;
#pragma unroll
        for (int ds = 0; ds < 8; ++ds) { const u32x4 w = __builtin_bit_cast(u32x4, qf[ds]);
#pragma unroll
            for (int i = 0; i < 4; ++i) { const float lo = __uint_as_float(w[i] << 16), hi2 = __uint_as_float(w[i] & 0xffff0000u); s += lo * lo + hi2 * hi2; } }
        s += partner32(s, hi); qk_bound = sqrtf(s) * u.kmax; }
    LAS float* rel_l = (LAS float*)(lds + OFF_REL);
    if (MODE == 0) { for (int i = tid; i < 257; i += 512) rel_l[i] = u.rel[i * HA] * INV_SCALE; }
    f32x16 o[4];
#pragma unroll
    for (int b = 0; b < 4; ++b)
#pragma unroll
        for (int r = 0; r < 16; ++r) o[b][r] = 0.f;
    float m_run = -1e30f, l_run = 0.f, carry = 0.f;
    const int k_key = tid >> 4, k_dc = tid & 15;
    const int k_lds = k_key * KROW + k_dc * 16;
    const int v_dc = lane & 15, v_kq = lane >> 4;
    const int v_key0 = 16 * (wave >> 1) + 4 * (wave & 1) + 2 * (v_kq & 1) + 8 * (v_kq >> 1);
    const int v_pos0 = (v_key0 & ~0xC) | ((v_key0 & 4) << 1) | ((v_key0 & 8) >> 1);
    const int v_lds = (8 * v_dc) * VROW + ((((v_pos0 >> 3) ^ ((v_dc >> 1) & 7))) << 4) + (v_pos0 & 7) * 2;
    const int kr_lds = qr * KROW + hi * 16;
    const int vr_lds = qr * VROW + ((hi ^ (qr >> 4)) << 4);
    u32x4 kreg[2], vreg[2]; float freg = 0.f;
    auto stage_load = [&](int j) {
        const int last = u.kv_len - 1;
#pragma unroll
        for (int i = 0; i < 2; ++i) { int pos = 64 * j + k_key + 32 * i; pos = pos < last ? pos : last; const bool nw = pos >= u.new_pos0;
            const bf16* src = (nw ? u.kn : u.kc) + (size_t)(nw ? pos - u.new_pos0 : pos) * (nw ? LDQ : u.cstride);
            kreg[i] = *(const u32x4*)(src + 8 * k_dc); }
#pragma unroll
        for (int i = 0; i < 2; ++i) { int pos = 64 * j + v_key0 + i; pos = pos < last ? pos : last; const bool nw = pos >= u.new_pos0;
            const bf16* src = (nw ? u.vn : u.vc) + (size_t)(nw ? pos - u.new_pos0 : pos) * (nw ? LDQ : u.cstride);
            vreg[i] = *(const u32x4*)(src + 8 * v_dc); }
        if (MODE == 1 && tid < 64) { int pos = 64 * j + tid; pos = pos < last ? pos : last; freg = u.F[(size_t)pos * HB]; }
    };
    auto stage_store = [&](int buf) {
        LAS unsigned char* kb = lds + OFF_K + buf * KBUF + k_lds;
        *(LAS u32x4*)kb = kreg[0]; *(LAS u32x4*)(kb + 32 * KROW) = kreg[1];
        LAS unsigned char* vb = lds + OFF_V + buf * VBUF + v_lds;
        const unsigned a[4] = {vreg[0].x, vreg[0].y, vreg[0].z, vreg[0].w}, b[4] = {vreg[1].x, vreg[1].y, vreg[1].z, vreg[1].w};
#pragma unroll
        for (int i = 0; i < 4; ++i) {
            *(LAS unsigned*)(vb + (2 * i) * VROW) = (a[i] & 0xffffu) | (b[i] << 16);
            *(LAS unsigned*)(vb + (2 * i + 1) * VROW) = (a[i] >> 16) | (b[i] & 0xffff0000u); }
        if (MODE == 1 && tid < 64) ((LAS float*)(lds + OFF_FB + buf * 256))[tid] = (u.fref - freg) * INV_SCALE;
    };
    stage_load(u.t_hi);
    stage_store(0);
    LDS_WAIT(); __syncthreads();
    bool wave_done = !active;
    for (int j = u.t_hi, it = 0;; --j, ++it) {
        const int cur = it & 1;
        const bool more = j > u.t_lo;
        if (more) stage_load(j - 1);
        if (active && j <= w_hi && j >= w_lo && !(MODE != 0 && wave_done)) {
            f32x16 p0, p1;
            if (MODE == 1) { const LAS f32x4* fb = (const LAS f32x4*)(lds + OFF_FB + cur * 256);
#pragma unroll
                for (int g = 0; g < 4; ++g) { const f32x4 a = fb[2 * g + hi], b = fb[8 + 2 * g + hi];
#pragma unroll
                    for (int i = 0; i < 4; ++i) { p0[4 * g + i] = a[i]; p1[4 * g + i] = b[i]; } } }
            else if (MODE == 0) {
                if (j >= near_lo) { const int base = qpos - 64 * j - 4 * hi + 128;
#pragma unroll
                    for (int r = 0; r < 16; ++r) { const int c = (r & 3) + 8 * (r >> 2); int i0 = base - c, i1 = base - c - 32; i0 = i0 < 256 ? i0 : 256; i1 = i1 < 256 ? i1 : 256;
                        p0[r] = rel_l[i0]; p1[r] = rel_l[i1]; } }
                else { const float cb = rel_l[256];
#pragma unroll
                    for (int r = 0; r < 16; ++r) { p0[r] = cb; p1[r] = cb; } } }
            else {
#pragma unroll
                for (int r = 0; r < 16; ++r) { p0[r] = 0.f; p1[r] = 0.f; } }
            { const LAS unsigned char* kb = lds + OFF_K + cur * KBUF + kr_lds;
#define ATT_KFRAG(i) (*(const LAS bf16x8*)(kb + ((i) & 1) * 32 * KROW + 32 * ((i) >> 1)))
              bf16x8 kf[8];
#pragma unroll
              for (int i = 0; i < 8; ++i) kf[i] = ATT_KFRAG(i);
              __builtin_amdgcn_sched_barrier(0);
#pragma unroll
              for (int i = 0; i < 16; ++i) {
                  if (i & 1) p1 = __builtin_amdgcn_mfma_f32_32x32x16_bf16(kf[i & 7], qf[i >> 1], p1, 0, 0, 0); else p0 = __builtin_amdgcn_mfma_f32_32x32x16_bf16(kf[i & 7], qf[i >> 1], p0, 0, 0, 0);
                  if (i + 8 < 16) kf[i & 7] = ATT_KFRAG(i + 8);
                  __builtin_amdgcn_sched_barrier(0); }
#undef ATT_KFRAG
            }
            const int kp0 = 64 * j + 4 * hi;
            if (MODE != 2) {
                const bool need_mask = MODE == 1 ? (64 * j + 63 > qpos_w0) : (64 * j + 63 >= u.kv_len);
                if (need_mask) { const int lim = MODE == 1 ? qpos + 1 : u.kv_len;
#pragma unroll
                    for (int r = 0; r < 16; ++r) { const int kp = kp0 + (r & 3) + 8 * (r >> 2);
                        if (kp >= lim) p0[r] = -__builtin_inff(); if (kp + 32 >= lim) p1[r] = -__builtin_inff(); } }
                float mx = fmaxf(p0[0], p1[0]);
#pragma unroll
                for (int r = 1; r < 16; ++r) mx = fmaxf(mx, fmaxf(p0[r], p1[r]));
                mx = fmaxf(mx, partner32(mx, hi));
                const float mn = fmaxf(m_run, mx);
                constexpr float C2 = ATT_SCALE * LOG2E;
                if (__any(mn > m_run)) { const float alpha = fast_exp2((m_run - mn) * C2); l_run *= alpha; m_run = mn;
#pragma unroll
                    for (int b = 0; b < 4; ++b)
#pragma unroll
                        for (int r = 0; r < 16; ++r) o[b][r] *= alpha; }
                const float mc = m_run * C2; float ps = 0.f;
#pragma unroll
                for (int r = 0; r < 16; ++r) { p0[r] = fast_exp2(p0[r] * C2 - mc); p1[r] = fast_exp2(p1[r] * C2 - mc); ps += p0[r] + p1[r]; }
                l_run += ps;
                if (MODE == 1) {
                    const float bmax = ((const LAS float*)(lds + OFF_FB + cur * 256))[0];
                    wave_done = __all((qk_bound + bmax - m_run) * C2 < -150.0f); }
            } else {
                const bool need_mask = 64 * j + 63 >= qpos_w0;
                float ls0[16], ls1[16];
#pragma unroll
                for (int r = 0; r < 16; ++r) {
                    const float z0 = p0[r] * ATT_SCALE, z1 = p1[r] * ATT_SCALE;
                    const float sp0 = fmaxf(z0, 0.f) + LN2 * fast_log2(1.0f + fast_exp2(-fabsf(z0) * LOG2E)), sp1 = fmaxf(z1, 0.f) + LN2 * fast_log2(1.0f + fast_exp2(-fabsf(z1) * LOG2E));
                    p0[r] = z0 - sp0; p1[r] = z1 - sp1;
                    ls0[r] = -sp0; ls1[r] = -sp1; }
                if (need_mask) {
#pragma unroll
                    for (int r = 0; r < 16; ++r) { const int kp = kp0 + (r & 3) + 8 * (r >> 2);
                        if (kp >= qpos) { ls0[r] = 0.f; p0[r] = -__builtin_inff(); } if (kp + 32 >= qpos) { ls1[r] = 0.f; p1[r] = -__builtin_inff(); } } }
                float a[8], b[8], t[8];
#pragma unroll
                for (int g = 0; g < 4; ++g) { a[g] = (ls0[4 * g] + ls0[4 * g + 1]) + (ls0[4 * g + 2] + ls0[4 * g + 3]); a[4 + g] = (ls1[4 * g] + ls1[4 * g + 1]) + (ls1[4 * g + 2] + ls1[4 * g + 3]); }
#pragma unroll
                for (int g = 0; g < 8; ++g) { b[g] = partner32(a[g], hi); t[g] = a[g] + b[g]; }
                float ps = carry;
#pragma unroll
                for (int g = 7; g >= 0; --g) {
                    const float sg = ps + (hi ? 0.f : b[g]);
                    if (g < 4) { const float e3 = sg, e2 = e3 + ls0[4 * g + 3], e1 = e2 + ls0[4 * g + 2], e0 = e1 + ls0[4 * g + 1];
                        p0[4 * g + 3] = fast_exp2((p0[4 * g + 3] + e3) * LOG2E); p0[4 * g + 2] = fast_exp2((p0[4 * g + 2] + e2) * LOG2E);
                        p0[4 * g + 1] = fast_exp2((p0[4 * g + 1] + e1) * LOG2E); p0[4 * g] = fast_exp2((p0[4 * g] + e0) * LOG2E); }
                    else { const int gg = g - 4; const float e3 = sg, e2 = e3 + ls1[4 * gg + 3], e1 = e2 + ls1[4 * gg + 2], e0 = e1 + ls1[4 * gg + 1];
                        p1[4 * gg + 3] = fast_exp2((p1[4 * gg + 3] + e3) * LOG2E); p1[4 * gg + 2] = fast_exp2((p1[4 * gg + 2] + e2) * LOG2E);
                        p1[4 * gg + 1] = fast_exp2((p1[4 * gg + 1] + e1) * LOG2E); p1[4 * gg] = fast_exp2((p1[4 * gg] + e0) * LOG2E); }
                    ps += t[g];
                }
                carry = ps;
                wave_done = __all(carry < STICK_STOP) || j == 0;
            }
            { const LAS unsigned char* vb = lds + OFF_V + cur * VBUF + vr_lds;
#define ATT_VFRAG(i) (*(const LAS bf16x8*)(vb + 32 * ((i) & 3) * VROW + ((((i) >> 2) ^ ((i) & 3)) << 5)))
              bf16x8 pf[4], vf[8];
              pf[0] = pack8(p0[0], p0[1], p0[2], p0[3], p0[4], p0[5], p0[6], p0[7]); pf[1] = pack8(p0[8], p0[9], p0[10], p0[11], p0[12], p0[13], p0[14], p0[15]);
              pf[2] = pack8(p1[0], p1[1], p1[2], p1[3], p1[4], p1[5], p1[6], p1[7]); pf[3] = pack8(p1[8], p1[9], p1[10], p1[11], p1[12], p1[13], p1[14], p1[15]);
#pragma unroll
              for (int i = 0; i < 8; ++i) vf[i] = ATT_VFRAG(i);
              __builtin_amdgcn_sched_barrier(0);
#pragma unroll
              for (int i = 0; i < 16; ++i) {
                  o[i & 3] = __builtin_amdgcn_mfma_f32_32x32x16_bf16(vf[i & 7], pf[i >> 2], o[i & 3], 0, 0, 0);
                  if (i + 8 < 16) vf[i & 7] = ATT_VFRAG(i + 8);
                  __builtin_amdgcn_sched_barrier(0); }
#undef ATT_VFRAG
            }
        }
        if (more) stage_store(cur ^ 1);
        if (MODE != 0 && lane == 0) ((LAS unsigned*)(lds + OFF_VOTE))[cur * 8 + wave] = (wave_done || j - 1 < w_lo) ? 1u : 0u;
        LDS_WAIT(); __syncthreads();
        if (!more) break;
        if (MODE != 0) { const LAS u32x4* vv = (const LAS u32x4*)(lds + OFF_VOTE + cur * 32); const u32x4 x = vv[0], y = vv[1];
            if ((x.x & x.y & x.z & x.w & y.x & y.y & y.z & y.w) != 0u) break; }
    }
    if (active) {
        float inv = 1.0f;
        if (MODE != 2) { const float lt = l_run + partner32(l_run, hi); inv = 1.0f / lt; }
        bf16* op = u.o + (size_t)(wave * 32 + qr) * u.ostride + 4 * hi;
#pragma unroll
        for (int db = 0; db < 4; ++db)
#pragma unroll
            for (int g = 0; g < 4; ++g) { u32x2 w; w.x = cvt_pk_bf16(o[db][4 * g] * inv, o[db][4 * g + 1] * inv); w.y = cvt_pk_bf16(o[db][4 * g + 2] * inv, o[db][4 * g + 3] * inv);
                *(u32x2*)(op + 32 * db + 8 * g) = w; }
    }
    __syncthreads();
}

__device__ __forceinline__ int pull(LAS unsigned char* lds, unsigned* counter, int tid) {
    LAS int* qw = (LAS int*)(lds + OFF_QW);
    if (tid == 0) *qw = (int)__hip_atomic_fetch_add(counter, 1u, __ATOMIC_RELAXED, __HIP_MEMORY_SCOPE_AGENT);
    LDS_WAIT(); __syncthreads();
    const int v = *qw;
    __syncthreads();
    return v;
}

template <int MODE>
__device__ __forceinline__ void mode_loop(const Params& P, const Ctx& C, int layer, int probe_pass) {
    constexpr int NHG = MODE == 0 ? HA : HB;
    constexpr int H0 = MODE == 0 ? 0 : (MODE == 1 ? HA : HA + HB);
    constexpr int NPU = PB * NHG * (PT / 256), NSU = SB * NHG;
    unsigned* counter = (unsigned*)(P.ws + WS_CTL) + CW_QUEUE + 64 * (layer * 3 + MODE + 8 * probe_pass);
    const bf16* qkv = (const bf16*)(P.ws + WS_QKV);
    for (;;) {
        const int i = pull(C.lds, counter, C.tid);
        if (i >= NPU + NSU) break;
        Unit u;
        if (i < NPU) {
            const int qb = (PT / 256 - 1) - i / (PB * NHG), bh = i % (PB * NHG), b = bh / NHG, hg = bh % NHG, hh = H0 + hg;
            const size_t row0 = (size_t)b * PT;
            u.q = qkv + (row0 + (size_t)qb * 256) * LDQ + hh * HD; u.nq = 256; u.qpos0 = qb * 256; u.kv_len = PT; u.new_pos0 = 0;
            u.kn = qkv + row0 * LDQ + D + hh * HD; u.vn = qkv + row0 * LDQ + 2 * D + hh * HD; u.kc = u.kn; u.vc = u.vn; u.cstride = LDQ;
            u.t_hi = 4 * qb + 3; u.t_lo = MODE == 0 ? (4 * qb - 8 > 0 ? 4 * qb - 8 : 0) : 0;
            u.F = (const float*)(P.ws + WS_FP) + row0 * HB + hg; u.fref = MODE == 1 ? u.F[(size_t)u.qpos0 * HB] : 0.f;
            u.rel = P.in[17] + (size_t)layer * 257 * HA + hh;
            u.kmax = 0.f;
            if (MODE == 1) {
                const float* kn2 = (const float*)(P.ws + WS_KN2) + ((size_t)layer * MP + row0) * HB + hg; float mx = 0.f;
                for (int t = C.tid; t < u.qpos0 + 256; t += 512) mx = fmaxf(mx, kn2[(size_t)t * HB]);
#pragma unroll
                for (int o = 1; o < 64; o <<= 1) mx = fmaxf(mx, __shfl_xor(mx, o));
                LAS float* red = (LAS float*)(C.lds + OFF_VOTE);
                if (C.lane == 0) red[C.wave] = mx;
                LDS_WAIT(); __syncthreads();
                mx = fmaxf(fmaxf(fmaxf(red[0], red[1]), fmaxf(red[2], red[3])), fmaxf(fmaxf(red[4], red[5]), fmaxf(red[6], red[7])));
                __syncthreads();
                u.kmax = sqrtf(mx) * 1.01f; }
        } else {
            const int s = i - NPU, sb = s / NHG, hg = s % NHG, hh = H0 + hg;
            constexpr int CL = MODE == 0 ? AWIN : PAST;
            const size_t row0 = (size_t)MP + (size_t)sb * ST;
            u.q = qkv + row0 * LDQ + hh * HD; u.nq = ST; u.qpos0 = CL; u.kv_len = CL + ST; u.new_pos0 = CL;
            u.kn = qkv + row0 * LDQ + D + hh * HD; u.vn = qkv + row0 * LDQ + 2 * D + hh * HD;
            const size_t coff = ((size_t)(layer * SB + sb) * CL * NHG + hg) * HD;
            u.kc = (const bf16*)(P.ws + (MODE == 0 ? WS_CAK : (MODE == 1 ? WS_CBK : WS_CCK))) + coff; u.vc = (const bf16*)(P.ws + (MODE == 0 ? WS_CAV : (MODE == 1 ? WS_CBV : WS_CCV))) + coff;
            u.cstride = NHG * HD;
            u.t_hi = (CL + ST - 1) >> 6; u.t_lo = 0;
            u.F = (const float*)(P.ws + WS_FS) + (size_t)sb * (PAST + ST) * HB + hg; u.fref = MODE == 1 ? u.F[(size_t)u.qpos0 * HB] : 0.f;
            u.rel = P.in[17] + (size_t)layer * 257 * HA + hh; u.kmax = __builtin_inff();
        }
        u.o = (bf16*)u.q; u.ostride = LDQ;
        if (probe_pass) { u.o = (bf16*)(P.ws + WS_H) + (u.q - qkv) / LDQ * LDH + (u.q - qkv) % LDQ; u.ostride = LDH; }
        run_unit<MODE>(C.lds, u, C.tid, C.wave, C.lane);
    }
}
}


#ifndef PHASE_MASK
#define PHASE_MASK 0xFFF
#endif
#define PH(n) ((PHASE_MASK >> (n)) & 1)
#ifndef DUP_MASK
#define DUP_MASK 0
#endif
#define DUP(n) ((DUP_MASK >> (n)) & 1)
typedef const Params __attribute__((address_space(4)))* KParams;
__device__ __forceinline__ const Params& kparams() {
    KParams p = (KParams)__builtin_amdgcn_kernarg_segment_ptr(); asm volatile("" : "+s"(p)); return *(const Params*)p;
}
#define P (kparams())
__device__ __forceinline__ Ctx make_ctx(LAS unsigned char* lds) {
    Ctx C; int t = threadIdx.x; asm volatile("" : "+v"(t));
    C.lds = lds; C.tid = t; C.lane = t & 63; C.wave = __builtin_amdgcn_readfirstlane(t >> 6); C.G = gridDim.x; C.blk = blockIdx.x; return C;
}
__global__ void __launch_bounds__(512, 2) hse_fwd(Params P_unused) {
    extern __shared__ __attribute__((aligned(16))) unsigned char lds_raw[];
    LAS unsigned char* const lds = (LAS unsigned char*)lds_raw;
    volatile LAS unsigned* MISC = (volatile LAS unsigned*)(lds + MISC_OFF);
    if (threadIdx.x < 64) MISC[threadIdx.x] = 0u;
    __syncthreads();
    XcdBarrier bar = xcd_barrier_post((unsigned*)(P.ws + WS_CTL) + CW_BAR, MISC + 8);

    if (PH(0)) { const Params& Q = P; const Ctx C = make_ctx(lds); p0_prologue(Q, C); }
    xcd_barrier(bar);


#pragma unroll 1
    for (int layer = 0; layer < 2; ++layer) {
        if (DUP(1)) { const Params& Q = P; const Ctx C = make_ctx(lds); norm_phase<true>(Q, C, layer, layer == 0 ? Q.in[0] : Q.out + O_Y_P, nullptr, Q.in[13] + layer * D, 0, D, 0, nullptr, 0); }
        if (PH(1)) { const Params& Q = P; const Ctx C = make_ctx(lds); norm_phase<true>(Q, C, layer, layer == 0 ? Q.in[0] : Q.out + O_Y_P, layer == 0 ? Q.in[1] : Q.out + O_Y_S, Q.in[13] + layer * D, 0, D,
                                      layer == 0 ? 0 : DFF / 256, (const float*)(Q.ws + WS_MOD), 5 * D); }
        xcd_barrier(bar);
        if (PH(2)) { const Params& Q = P; const Ctx C = make_ctx(lds); fcum_phase(Q, C, layer); }
#ifdef PROBE_CLOCK
        if (layer == PROBE_CLOCK - 1 && blockIdx.x == 0 && threadIdx.x == 0) { const unsigned long long c = clock64(), t = wall_clock64(); MISC[16] = (unsigned)c; MISC[17] = (unsigned)(c >> 32); MISC[18] = (unsigned)t; MISC[19] = (unsigned)(t >> 32); }
#endif
        if (PH(3)) { const Params& Q = P; const Ctx C = make_ctx(lds); pg8::Gemm g{(const bf16*)(Q.ws + WS_H), (const bf16*)(Q.ws + WS_WIN + layer * SZ_WIN)}; pg8::StaticOrder<MP / 256, NQKV / 256> S; S.init(C.G, C.blk);
          pg8::EpiQKV E{(bf16*)(Q.ws + WS_QKV), Q.out, layer, (float*)(Q.ws + WS_KN2) + (size_t)layer * MP * HB};
          pg8::gemm_phase<pg8::EpiQKV, pg8::StaticOrder<MP / 256, NQKV / 256>, true, true, D, LDH, LDW>(C.lds + RING_OFF, g, S, E);
          if (DUP(3)) { __syncthreads(); pg8::gemm_phase<pg8::EpiQKV, pg8::StaticOrder<MP / 256, NQKV / 256>, true, true, D, LDH, LDW>(C.lds + RING_OFF, g, S, E); }
          pg8::SampleOrder<MP / 256, NQKV / 256, 8> SS; SS.init(C.G, C.blk); pg8::EpiPartial<NQKV> EP{(float*)(Q.ws + WS_PART)};
          pg8::gemm_phase<pg8::EpiPartial<NQKV>, pg8::SampleOrder<MP / 256, NQKV / 256, 8>, true, true, 256, LDH, LDW>(C.lds + RING_OFF, g, SS, EP); }
#ifdef PROBE_CLOCK
        if (layer == PROBE_CLOCK - 1 && blockIdx.x == 0 && threadIdx.x == 0) { const unsigned long long c = clock64(), t = wall_clock64();
            const unsigned long long c0 = ((unsigned long long)MISC[17] << 32) | MISC[16], t0 = ((unsigned long long)MISC[19] << 32) | MISC[18];
            MISC[20] = (unsigned)(((c - c0) * 100ull) / (t - t0)); }
#endif
        xcd_barrier(bar);
        if (PH(3)) { const Params& Q = P; const Ctx C = make_ctx(lds); finish_qkv(Q, C, layer); }
        xcd_barrier(bar);
#if DUP_MASK & 0x70
        if (DUP(4)) { const Params& Q = P; const Ctx C = make_ctx(lds); att::mode_loop<1>(Q, C, layer, 1); }
        if (DUP(5)) { const Params& Q = P; const Ctx C = make_ctx(lds); att::mode_loop<0>(Q, C, layer, 1); }
        if (DUP(6)) { const Params& Q = P; const Ctx C = make_ctx(lds); att::mode_loop<2>(Q, C, layer, 1); }
#endif
        if (PH(4)) { const Params& Q = P; const Ctx C = make_ctx(lds); att::mode_loop<1>(Q, C, layer, 0); }
        if (PH(5)) { const Params& Q = P; const Ctx C = make_ctx(lds); att::mode_loop<0>(Q, C, layer, 0); }
        if (PH(6)) { const Params& Q = P; const Ctx C = make_ctx(lds); att::mode_loop<2>(Q, C, layer, 0); }
        xcd_barrier(bar);
        if (PH(7)) { const Params& Q = P; const Ctx C = make_ctx(lds); pg8::Gemm g{(const bf16*)(Q.ws + WS_QKV), (const bf16*)(Q.ws + WS_WO + layer * SZ_WO)}; pg8::StaticOrder<MP / 256, D / 256> S; S.init(C.G, C.blk);
          pg8::EpiResid E{layer == 0 ? Q.in[0] : Q.out + O_Y_P, Q.out + O_Y_P, (const float*)(Q.ws + WS_MOD) + (size_t)layer * NMIDX * NMOD + 2 * D};
          pg8::gemm_phase<pg8::EpiResid, pg8::StaticOrder<MP / 256, D / 256>, true, true, D, LDQ, LDW>(C.lds + RING_OFF, g, S, E);
          pg8::SampleOrder<MP / 256, D / 256, 8> SS; SS.init(C.G, C.blk); pg8::EpiPartial<D> EP{(float*)(Q.ws + WS_PART)};
          pg8::gemm_phase<pg8::EpiPartial<D>, pg8::SampleOrder<MP / 256, D / 256, 8>, true, true, 256, LDQ, LDW>(C.lds + RING_OFF, g, SS, EP); }
        xcd_barrier(bar);
        if (PH(8)) { const Params& Q = P; const Ctx C = make_ctx(lds); norm_phase<false>(Q, C, layer, Q.out + O_Y_P, layer == 0 ? Q.in[1] : Q.out + O_Y_S, Q.in[14] + layer * D, 3 * D, 4 * D,
                                       D / 256, (const float*)(Q.ws + WS_MOD) + (size_t)layer * NMIDX * NMOD, 2 * D); }
        xcd_barrier(bar);
        if (PH(9)) { const Params& Q = P; const Ctx C = make_ctx(lds); pg8::Gemm g{(const bf16*)(Q.ws + WS_H), (const bf16*)(Q.ws + WS_WGU + layer * SZ_WGU)}; pg8::StaticOrder<MP / 256, 2 * DFF / 256> S; S.init(C.G, C.blk);
          pg8::EpiSwiGLU E{(bf16*)(Q.ws + WS_QKV)};
          pg8::gemm_phase<pg8::EpiSwiGLU, pg8::StaticOrder<MP / 256, 2 * DFF / 256>, true, true, D, LDH, LDW>(C.lds + RING_OFF, g, S, E);
          if (DUP(9)) { __syncthreads(); pg8::gemm_phase<pg8::EpiSwiGLU, pg8::StaticOrder<MP / 256, 2 * DFF / 256>, true, true, D, LDH, LDW>(C.lds + RING_OFF, g, S, E); }
          pg8::SampleOrder<MP / 256, 2 * DFF / 256, 4> SS; SS.init(C.G, C.blk); pg8::EpiPartial<2 * DFF> EP{(float*)(Q.ws + WS_PART)};
          pg8::gemm_phase<pg8::EpiPartial<2 * DFF>, pg8::SampleOrder<MP / 256, 2 * DFF / 256, 4>, true, true, 512, LDH, LDW>(C.lds + RING_OFF, g, SS, EP); }
        xcd_barrier(bar);
        if (PH(9)) { const Params& Q = P; const Ctx C = make_ctx(lds); finish_act(Q, C); }
        xcd_barrier(bar);
        if (PH(10)) { const Params& Q = P; const Ctx C = make_ctx(lds); pg8::Gemm g{(const bf16*)(Q.ws + WS_QKV), (const bf16*)(Q.ws + WS_WDN + layer * SZ_WDN)}; pg8::StaticOrder<MP / 256, D / 256> S; S.init(C.G, C.blk);
          pg8::EpiResid E{Q.out + O_Y_P, Q.out + O_Y_P, (const float*)(Q.ws + WS_MOD) + (size_t)layer * NMIDX * NMOD + 5 * D};
          pg8::gemm_phase<pg8::EpiResid, pg8::StaticOrder<MP / 256, D / 256>, true, true, DFF, LDACT, LDWD>(C.lds + RING_OFF, g, S, E);
          pg8::SampleOrder<MP / 256, D / 256, DFF / 256> SS; SS.init(C.G, C.blk); pg8::EpiPartial<D> EP{(float*)(Q.ws + WS_PART)};
          pg8::gemm_phase<pg8::EpiPartial<D>, pg8::SampleOrder<MP / 256, D / 256, DFF / 256>, true, true, 256, LDACT, LDWD>(C.lds + RING_OFF, g, SS, EP); }
        xcd_barrier(bar);
    }
    if (PH(11)) { const Params& Q = P; const Ctx C = make_ctx(lds); final_norm(Q, C); }
#ifdef PROBE_CLOCK
    if (blockIdx.x == 0 && threadIdx.x == 0) { const unsigned long long t0 = wall_clock64(), wait = (unsigned long long)MISC[20] * 100ull; while (wall_clock64() - t0 < wait) __builtin_amdgcn_s_sleep(8); }
#endif
}
#undef P

extern "C" void kernel_launch(void* const* d_in, const int* in_sizes, int n_in, void* d_out, int out_size, void* d_ws, size_t ws_size, hipStream_t stream) {
    static int grid = 0;
    if (grid == 0) {
        if (n_in != 23 || (size_t)out_size != O_END || ws_size < WS_END) {
            fprintf(stderr, "kernel_launch: unexpected shapes (n_in %d, out %d (want %zu), ws %zu (want >= %zu)); nothing launched\n", n_in, out_size, (size_t)O_END, ws_size, (size_t)WS_END); grid = -1; return; }
        int dev = 0, cus = 0, per_cu = 0;
        if (hipGetDevice(&dev) != hipSuccess || hipDeviceGetAttribute(&cus, hipDeviceAttributeMultiprocessorCount, dev) != hipSuccess) { grid = -1; return; }
        if (hipFuncSetAttribute((const void*)hse_fwd, hipFuncAttributeMaxDynamicSharedMemorySize, LDS_BYTES) != hipSuccess) { fprintf(stderr, "kernel_launch: hipFuncSetAttribute failed\n"); grid = -1; return; }
        if (hipOccupancyMaxActiveBlocksPerMultiprocessor(&per_cu, (const void*)hse_fwd, 512, LDS_BYTES) != hipSuccess || per_cu < 1) { fprintf(stderr, "kernel_launch: occupancy query says %d\n", per_cu); (void)hipGetLastError(); grid = -1; return; }
        grid = cus;
    }
    if (grid < 0) return;
    (void)in_sizes;
    if (hipMemsetAsync((char*)d_ws + WS_CTL, 0, CTL_ZERO_BYTES, stream) != hipSuccess) return;
    Params p{};
    for (int i = 0; i < 23; ++i) p.in[i] = (const float*)d_in[i];
    p.out = (float*)d_out; p.ws = (unsigned char*)d_ws;
    hipLaunchKernelGGL(hse_fwd, dim3(grid), dim3(512), LDS_BYTES, stream, p);
}
```

```cpp
#include <hip/hip_runtime.h>
#include <cstdio>
#include <cstdint>

#define LAS __attribute__((address_space(3)))
#define GAS __attribute__((address_space(1)))
typedef unsigned short bf16;
typedef short bf16x8 __attribute__((ext_vector_type(8)));
typedef float f32x4 __attribute__((ext_vector_type(4)));
typedef float f32x2 __attribute__((ext_vector_type(2)));
typedef float f32x16 __attribute__((ext_vector_type(16)));
typedef unsigned u32x4 __attribute__((ext_vector_type(4)));
typedef unsigned u32x2 __attribute__((ext_vector_type(2)));

constexpr int D = 2048, NH = 16, HD = 128, DFF = 5632, NQKV = 6144, NIN = 6150, NMOD = 6 * D;
constexpr int PB = 4, PT = 8192, SB = 8, ST = 32, PAST = 1024, AWIN = 512;
constexpr int HA = 4, HB = 6, HC = 6;
constexpr int MP = PB * PT, MS = SB * ST, MT = MP + MS;
#ifndef ROWPAD
#define ROWPAD 64
#endif
constexpr int LDQ = NQKV + ROWPAD, LDH = D + ROWPAD, LDACT = DFF + ROWPAD, LDW = D + ROWPAD, LDWD = DFF + ROWPAD;
constexpr float EPS = 1e-6f;
constexpr float ATT_SCALE = 0.08838834764831845f, INV_SCALE = 11.313708498984761f, LOG2E = 1.4426950408889634f, LN2 = 0.6931471805599453f;
constexpr int NMIDX = PB + SB;

constexpr size_t O_Y_P = 0;
constexpr size_t O_Y_S = O_Y_P + (size_t)MP * D;
constexpr size_t O_AK_P = O_Y_S + (size_t)MS * D;
constexpr size_t SZ_A_P = (size_t)2 * PB * AWIN * HA * HD, SZ_B_P = (size_t)2 * PB * PT * HB * HD, SZ_LF_P = (size_t)2 * PB * PT * HB;
constexpr size_t SZ_A_S = (size_t)2 * SB * ST * HA * HD, SZ_B_S = (size_t)2 * SB * ST * HB * HD, SZ_LF_S = (size_t)2 * SB * ST * HB;
constexpr size_t O_AV_P = O_AK_P + SZ_A_P, O_BK_P = O_AV_P + SZ_A_P, O_BV_P = O_BK_P + SZ_B_P, O_BLF_P = O_BV_P + SZ_B_P, O_CK_P = O_BLF_P + SZ_LF_P, O_CV_P = O_CK_P + SZ_B_P;
constexpr size_t O_AK_S = O_CV_P + SZ_B_P, O_AV_S = O_AK_S + SZ_A_S, O_BK_S = O_AV_S + SZ_A_S, O_BV_S = O_BK_S + SZ_B_S, O_BLF_S = O_BV_S + SZ_B_S, O_CK_S = O_BLF_S + SZ_LF_S, O_CV_S = O_CK_S + SZ_B_S;
constexpr size_t O_END = O_CV_S + SZ_B_S;

constexpr size_t MiB = 1u << 20;
constexpr size_t WS_CTL = 0, CTL_ZERO_BYTES = 6 * MiB;
constexpr size_t WS_MOD = 2 * MiB;
constexpr size_t SZ_WIN = (size_t)NQKV * LDW * 2, SZ_WO = (size_t)D * LDW * 2, SZ_WGU = (size_t)2 * DFF * LDW * 2, SZ_WDN = (size_t)D * LDWD * 2;
constexpr size_t WS_KN2 = 4 * MiB;
constexpr size_t WS_WIN = 6 * MiB, WS_WO = WS_WIN + 2 * SZ_WIN, WS_WGU = WS_WO + 2 * SZ_WO, WS_WDN = WS_WGU + 2 * SZ_WGU;
constexpr size_t WS_H = WS_WDN + 2 * SZ_WDN;
constexpr size_t WS_QKV = WS_H + (size_t)MT * LDH * 2;
constexpr size_t WS_CACHE = WS_QKV + (size_t)MT * LDQ * 2;
constexpr size_t SZ_CA = (size_t)2 * SB * AWIN * HA * HD * 2, SZ_CB = (size_t)2 * SB * PAST * HB * HD * 2;
constexpr size_t WS_CAK = WS_CACHE, WS_CAV = WS_CAK + SZ_CA, WS_CBK = WS_CAV + SZ_CA, WS_CBV = WS_CBK + SZ_CB, WS_CCK = WS_CBV + SZ_CB, WS_CCV = WS_CCK + SZ_CB;
constexpr size_t WS_FP = WS_CCV + SZ_CB;
constexpr size_t WS_FS = WS_FP + (size_t)PB * PT * HB * 4;
constexpr size_t WS_PART = (WS_FS + (size_t)SB * (PAST + ST) * HB * 4 + 4095) / 4096 * 4096;
constexpr size_t WS_END = WS_PART + (size_t)8 * MS * NQKV * 4 + 4096;
static_assert((size_t)4 * MS * 2 * DFF * 4 <= (size_t)8 * MS * NQKV * 4 && (size_t)22 * MS * D * 4 <= (size_t)8 * MS * NQKV * 4, "partials buffer");
static_assert((size_t)MT * LDACT * 2 <= (size_t)MT * LDQ * 2, "ACT overlays QKV");
constexpr int CW_TMO = 0, CW_BAR = 4096, CW_QUEUE = 16384;

constexpr int RING_OFF = 0, RING_BYTES = 131072;
constexpr int MISC_OFF = RING_BYTES;
constexpr int LDS_BYTES = 147456;

#define LDS_WAIT() asm volatile("s_waitcnt lgkmcnt(0)" ::: "memory")
#define VM_WAIT() asm volatile("s_waitcnt vmcnt(0)" ::: "memory")
__device__ __forceinline__ unsigned cvt_pk_bf16(float lo, float hi) { unsigned r; asm volatile("v_cvt_pk_bf16_f32 %0, %1, %2" : "=v"(r) : "v"(lo), "v"(hi)); return r; }
__device__ __forceinline__ float fast_exp2(float x) { return __builtin_amdgcn_exp2f(x); }
__device__ __forceinline__ float fast_log2(float x) { return __builtin_amdgcn_logf(x); }
__device__ __forceinline__ float fast_rcp(float x) { return __builtin_amdgcn_rcpf(x); }
template <int CTRL, int ROWMASK> __device__ __forceinline__ float dpp_take(float v) {
    return __builtin_bit_cast(float, __builtin_amdgcn_update_dpp(0, __builtin_bit_cast(int, v), CTRL, ROWMASK, 0xf, false));
}
__device__ __forceinline__ float wave_sum(float v) {
    v += dpp_take<0x111, 0xf>(v); v += dpp_take<0x112, 0xf>(v); v += dpp_take<0x114, 0xf>(v); v += dpp_take<0x118, 0xf>(v);
    v += dpp_take<0x142, 0xa>(v); v += dpp_take<0x143, 0xc>(v);
    return __builtin_bit_cast(float, __builtin_amdgcn_readlane(__builtin_bit_cast(int, v), 63));
}
namespace pg8 {
#define PG8_LAS __attribute__((address_space(3)))
typedef unsigned short bf16_t;
typedef short bf16x8 __attribute__((ext_vector_type(8)));
typedef float f32x4 __attribute__((ext_vector_type(4)));
typedef unsigned u32x4 __attribute__((ext_vector_type(4)));
constexpr int BM = 256, BK = 64, HALF = 128, HTB = HALF * BK * 2  , STAGE_BYTES = 8 * HTB, NXCD = 8, WGM = 8;

__host__ __device__ __forceinline__ int lds_byte(int r, int c) { const int st = (r >> 4) * 2 + (c >> 5), rr = r & 15, cc = c & 31, ob = rr * 64 + cc * 2; return st * 1024 + (ob ^ (((ob >> 9) & 1) << 5)); }
__host__ __device__ __forceinline__ void stage_rc(int b, int& R, int& C) { const int st = b / 1024, sb = b % 1024, swz = sb ^ (((sb >> 9) & 1) << 5); R = (st >> 1) * 16 + swz / 64; C = (st & 1) * 32 + (swz % 64) / 2; }
__host__ __device__ __forceinline__ int perm32(int rho) { const int n = rho >> 4, i = rho & 15; return 8 * (i >> 2) + 4 * n + (i & 3); }

struct Unit { int pm, pn, kc; };
struct Gemm { const bf16_t* A; const bf16_t* Bt; };

template <int NM, int NN> struct StaticOrder {
    int G, c;
    __host__ __device__ void init(int G_, int c_) { G = G_; c = c_; }
    __host__ __device__ bool next(int i, Unit& u) const {
        constexpr int nM = NM, nN = NN, nwg = NM * NN;
        const int L = i * G + c; if (L >= nwg) return false;
        int wgid = L; { constexpr int q = nwg / NXCD, r = nwg % NXCD; const int xcd = wgid % NXCD, off = wgid / NXCD; wgid = (xcd < r ? xcd * (q + 1) : r * (q + 1) + (xcd - r) * q) + off; }
        constexpr int nig = WGM * nN; const int gid = wgid / nig, fm = gid * WGM, gsz = (nM - fm) < WGM ? (nM - fm) : WGM;
        u.pm = fm + ((wgid % nig) % gsz); u.pn = (wgid % nig) / gsz; u.kc = 0; return true;
    }
    __device__ __forceinline__ void a_ready(const Unit&) const {}
    __device__ __forceinline__ void done(const Unit&) const {}
};

__device__ __forceinline__ unsigned cvt_pk_bf16(float lo, float hi) { unsigned r; asm volatile("v_cvt_pk_bf16_f32 %0, %1, %2" : "=v"(r) : "v"(lo), "v"(hi)); return r; }

struct EpiQKV {
    static constexpr bool PERM = true, AFTER_DRAIN = false, PROBE_DUP = true;
    bf16_t* QKV; float* out; int layer; float* kn2;
    __device__ __forceinline__ void operator()(const f32x4 (&acc)[2][2][4][2], const Unit& u, int wr, int wc, int fr, int fq) const {
        const int which = u.pn >> 3;
        const int rl0 = wr * 64 + fr;
        const int d0 = wc * 32 + 8 * fq;
        bf16_t* qbase = QKV + (size_t)(u.pm * BM + rl0) * ::LDQ + u.pn * BM + d0;
        float* fb[2]; int rstride[2]; bool en[2];
#pragma unroll
        for (int bj = 0; bj < 2; ++bj) {
            const int hh = (u.pn & 7) * 2 + bj;
            en[bj] = which != 0; fb[bj] = out; rstride[bj] = 0;
            if (which != 0) {
                const bool isv = which == 2;
                {
                    const int b = u.pm >> 5, t0 = (u.pm & 31) * 256;
                    if (hh < ::HA) { en[bj] = t0 >= ::PT - ::AWIN; rstride[bj] = ::HA * ::HD;
                        fb[bj] = out + (isv ? ::O_AV_P : ::O_AK_P) + ((size_t)((layer * ::PB + b) * ::AWIN + (t0 - (::PT - ::AWIN))) * ::HA + hh) * ::HD; }
                    else { const int hg = hh < ::HA + ::HB ? hh - ::HA : hh - ::HA - ::HB; rstride[bj] = ::HB * ::HD;
                        const size_t ob = hh < ::HA + ::HB ? (isv ? ::O_BV_P : ::O_BK_P) : (isv ? ::O_CV_P : ::O_CK_P);
                        fb[bj] = out + ob + ((size_t)((layer * ::PB + b) * ::PT + t0) * ::HB + hg) * ::HD; }
                }
            }
        }
#pragma unroll
        for (int ai = 0; ai < 2; ++ai)
#pragma unroll
            for (int m = 0; m < 4; ++m) { const int rl = rl0 + ai * HALF + m * 16; bf16_t* rowp = qbase + (size_t)(ai * HALF + m * 16) * ::LDQ;
#pragma unroll
                for (int bj = 0; bj < 2; ++bj) { const f32x4 v0 = acc[ai][bj][m][0], v1 = acc[ai][bj][m][1];
                    u32x4 w; w.x = cvt_pk_bf16(v0[0], v0[1]); w.y = cvt_pk_bf16(v0[2], v0[3]); w.z = cvt_pk_bf16(v1[0], v1[1]); w.w = cvt_pk_bf16(v1[2], v1[3]);
                    *(u32x4*)(rowp + bj * HALF) = w;
                    if (en[bj]) { float* fp = fb[bj] + (size_t)rl * rstride[bj] + d0; *(f32x4*)fp = v0; *(f32x4*)(fp + 4) = v1; }
                    if (which == 1) { const int hh = (u.pn & 7) * 2 + bj;
                        if (hh >= ::HA && hh < ::HA + ::HB) {
                            float s = (v0[0] * v0[0] + v0[1] * v0[1]) + (v0[2] * v0[2] + v0[3] * v0[3]) + (v1[0] * v1[0] + v1[1] * v1[1]) + (v1[2] * v1[2] + v1[3] * v1[3]);
                            s += __shfl_xor(s, 16); s += __shfl_xor(s, 32);
                            if (fq == 0) __hip_atomic_fetch_add(kn2 + (size_t)(u.pm * BM + rl) * ::HB + (hh - ::HA), s, __ATOMIC_RELAXED, __HIP_MEMORY_SCOPE_AGENT); } } } }
    }
};
struct EpiResid {
    static constexpr bool PERM = false, AFTER_DRAIN = false, PROBE_DUP = false;
    const float* xin_p; float* xout_p; const float* gate;
    __device__ __forceinline__ void operator()(const f32x4 (&acc)[2][2][4][2], const Unit& u, int wr, int wc, int fr, int fq) const {
        const float* xi = xin_p + (size_t)u.pm * BM * ::D; float* xo = xout_p + (size_t)u.pm * BM * ::D;
        const int col0 = u.pn * BM + wc * 32 + 4 * fq; const float* gp = gate + (size_t)(u.pm >> 5) * ::NMOD + col0;
#pragma unroll
        for (int ai = 0; ai < 2; ++ai)
#pragma unroll
            for (int m = 0; m < 4; ++m) { const int rl = ai * HALF + wr * 64 + m * 16 + fr; const size_t off = (size_t)rl * ::D + col0;
#pragma unroll
                for (int bj = 0; bj < 2; ++bj) {
#pragma unroll
                    for (int n = 0; n < 2; ++n) { const f32x4 gv = *(const f32x4*)(gp + bj * HALF + n * 16); const f32x4 xv = *(const f32x4*)(xi + off + bj * HALF + n * 16);
                        *(f32x4*)(xo + off + bj * HALF + n * 16) = xv + gv * acc[ai][bj][m][n]; }
                    asm volatile("" ::: "memory"); } }
    }
};
struct EpiSwiGLU {
    static constexpr bool PERM = true, AFTER_DRAIN = false, PROBE_DUP = false;
    bf16_t* ACT;
    __device__ __forceinline__ void operator()(const f32x4 (&acc)[2][2][4][2], const Unit& u, int wr, int wc, int fr, int fq) const {
        bf16_t* base = ACT + (size_t)(u.pm * BM + wr * 64 + fr) * ::LDACT + u.pn * HALF + wc * 32 + 8 * fq;
#pragma unroll
        for (int ai = 0; ai < 2; ++ai)
#pragma unroll
            for (int m = 0; m < 4; ++m) { float r[8];
#pragma unroll
                for (int n = 0; n < 2; ++n)
#pragma unroll
                    for (int j = 0; j < 4; ++j) { const float g = acc[ai][0][m][n][j], up = acc[ai][1][m][n][j];
                        r[4 * n + j] = g * __builtin_amdgcn_rcpf(1.0f + __builtin_amdgcn_exp2f(-g * ::LOG2E)) * up; }
                u32x4 w; w.x = cvt_pk_bf16(r[0], r[1]); w.y = cvt_pk_bf16(r[2], r[3]); w.z = cvt_pk_bf16(r[4], r[5]); w.w = cvt_pk_bf16(r[6], r[7]);
                *(u32x4*)(base + (size_t)(ai * HALF + m * 16) * ::LDACT) = w; }
    }
};


template <int PM, int NN, int NKC> struct SampleOrder {
    int G, c;
    __host__ __device__ void init(int G_, int c_) { G = G_; c = c_; }
    __host__ __device__ bool next(int i, Unit& u) const { const int L = i * G + c; if (L >= NN * NKC) return false; u.pm = PM; u.pn = L % NN; u.kc = L / NN; return true; }
    __device__ __forceinline__ void a_ready(const Unit&) const {}
    __device__ __forceinline__ void done(const Unit&) const {}
};
template <int N> struct EpiPartial {
    static constexpr bool PERM = false, AFTER_DRAIN = false, PROBE_DUP = false;
    float* part;
    __device__ __forceinline__ void operator()(const f32x4 (&acc)[2][2][4][2], const Unit& u, int wr, int wc, int fr, int fq) const {
        float* base = part + ((size_t)u.kc * BM + wr * 64 + fr) * N + u.pn * BM + wc * 32 + 4 * fq;
#pragma unroll
        for (int ai = 0; ai < 2; ++ai)
#pragma unroll
            for (int m = 0; m < 4; ++m) { float* rowp = base + (size_t)(ai * HALF + m * 16) * N;
#pragma unroll
                for (int bj = 0; bj < 2; ++bj)
#pragma unroll
                    for (int n = 0; n < 2; ++n) *(f32x4*)(rowp + bj * HALF + n * 16) = acc[ai][bj][m][n]; }
    }
};


template <class Epi, class Sched, bool ALIGN_EPI, bool SP2, int KK, int LDA, int LDB = KK>
__device__ __forceinline__ void gemm_phase(PG8_LAS unsigned char* lds, const Gemm g, const Sched& S, const Epi& E) {
    int tid = threadIdx.x; asm volatile("" : "+v"(tid));
    const int wid = __builtin_amdgcn_readfirstlane(tid >> 6), lane = tid & 63, wr = wid >> 2, wc = wid & 3, fr = lane & 15, fq = lane >> 4;
    constexpr int K = KK, nt = K / BK, lda = LDA, ldb = LDB;
    unsigned voffA[2], voffB[2];
#pragma unroll
    for (int i = 0; i < 2; ++i) { int R, C; stage_rc(tid * 16 + i * 8192, R, C); const int Rb = Epi::PERM ? ((R & ~31) + perm32(R & 31)) : R;
        voffA[i] = (unsigned)(R * lda + C) * 2u; voffB[i] = (unsigned)(Rb * ldb + C) * 2u; }
    constexpr size_t kstep = (size_t)(BK * 2);
    constexpr size_t hstepA = (size_t)HALF * lda * 2, hstepB = (size_t)HALF * ldb * 2;
    constexpr size_t tstepA = 2 * hstepA, tstepB = 2 * hstepB;
    const unsigned ldsw = (unsigned)wid * 1024u;
    const int aoff = lds_byte(wr * 64 + fr, fq * 8), boff = lds_byte(wc * 32 + fr, fq * 8);
#define PG8_SA(b, h) (((b) * 2 + (h)) * HTB)
#define PG8_SB(b, h) ((4 + (b) * 2 + (h)) * HTB)
#define PG8_STAGE(bufoff, gbase, voff) do { _Pragma("unroll") for (int _i = 0; _i < 2; ++_i) \
        __builtin_amdgcn_global_load_lds((const unsigned*)((const char*)(gbase) + (voff)[_i]), (PG8_LAS unsigned*)(lds + (bufoff) + ldsw + _i * 8192), 16, 0, 0); } while (0)
#define PG8_LDA(dst, b, h) do { _Pragma("unroll") for (int m = 0; m < 4; ++m) _Pragma("unroll") for (int k = 0; k < 2; ++k) dst[m][k] = *(const PG8_LAS bf16x8*)(lds + PG8_SA(b, h) + aoff + m * 2048 + k * 1024); } while (0)
#define PG8_LDB(dst, b, h) do { _Pragma("unroll") for (int n = 0; n < 2; ++n) _Pragma("unroll") for (int k = 0; k < 2; ++k) dst[n][k] = *(const PG8_LAS bf16x8*)(lds + PG8_SB(b, h) + boff + n * 2048 + k * 1024); } while (0)
#define PG8_MMA(ai, bj, At, Bt) do { __builtin_amdgcn_s_setprio(1); _Pragma("unroll") for (int m = 0; m < 4; ++m) _Pragma("unroll") for (int n = 0; n < 2; ++n) _Pragma("unroll") for (int k = 0; k < 2; ++k) \
        acc[ai][bj][m][n] = __builtin_amdgcn_mfma_f32_16x16x32_bf16(Bt[n][k], At[m][k], acc[ai][bj][m][n], 0, 0, 0); __builtin_amdgcn_s_setprio(0); } while (0)
#define PG8_WAIT_V(n) asm volatile("s_waitcnt vmcnt(" #n ")" ::: "memory")
#define PG8_WAIT_L(n) asm volatile("s_waitcnt lgkmcnt(" #n ")" ::: "memory")
#define PG8_BAR __builtin_amdgcn_s_barrier()
#define PG8_SCHED __builtin_amdgcn_sched_barrier(0)
    Unit cur, nxt; int ui = 0;
    if (!S.next(0, cur)) return;
    f32x4 acc[2][2][4][2];
#pragma unroll
    for (int a = 0; a < 2; ++a)
#pragma unroll
        for (int b = 0; b < 2; ++b)
#pragma unroll
            for (int m = 0; m < 4; ++m)
#pragma unroll
                for (int n = 0; n < 2; ++n) acc[a][b][m][n] = (f32x4){0.f, 0.f, 0.f, 0.f};
    bf16x8 At[4][2], B0[2][2], B1[2][2];
    const char* cA = (const char*)g.A + (size_t)cur.pm * tstepA + (size_t)cur.kc * (K * 2); const char* cB = (const char*)g.Bt + (size_t)cur.pn * tstepB + (size_t)cur.kc * (K * 2);
    S.a_ready(cur);
    if constexpr (SP2) {
        PG8_STAGE(PG8_SB(0, 0), cB, voffB); PG8_STAGE(PG8_SB(0, 1), cB + hstepB, voffB); PG8_STAGE(PG8_SA(0, 0), cA, voffA); PG8_STAGE(PG8_SA(0, 1), cA + hstepA, voffA);
        if (wr == 1) PG8_BAR;
        PG8_WAIT_V(2); PG8_BAR;
        PG8_STAGE(PG8_SB(1, 0), cB + kstep, voffB); PG8_STAGE(PG8_SA(1, 0), cA + kstep, voffA); PG8_STAGE(PG8_SB(1, 1), cB + hstepB + kstep, voffB);
        PG8_WAIT_V(6); PG8_BAR;
    } else {
        PG8_STAGE(PG8_SB(0, 0), cB, voffB); PG8_STAGE(PG8_SA(0, 0), cA, voffA); PG8_STAGE(PG8_SB(0, 1), cB + hstepB, voffB); PG8_STAGE(PG8_SA(0, 1), cA + hstepA, voffA);
        if (wr == 1) PG8_BAR;
        PG8_WAIT_V(4); PG8_BAR;
        PG8_STAGE(PG8_SB(1, 0), cB + kstep, voffB); PG8_STAGE(PG8_SA(1, 0), cA + kstep, voffA); PG8_STAGE(PG8_SB(1, 1), cB + hstepB + kstep, voffB);
        PG8_WAIT_V(6); PG8_BAR;
    }
    for (;;) {
        const bool has_next = S.next(ui + 1, nxt);
        const char* nA = has_next ? (const char*)g.A + (size_t)nxt.pm * tstepA + (size_t)nxt.kc * (K * 2) : cA; const char* nB = has_next ? (const char*)g.Bt + (size_t)nxt.pn * tstepB + (size_t)nxt.kc * (K * 2) : cB;
#pragma unroll 1
        for (int t = 0; t < nt; t += 2) {
            const bool last = (t == nt - 2);
            const char* a1 = cA + (size_t)(t + 1) * kstep;
            const char* a2 = last ? nA : cA + (size_t)(t + 2) * kstep; const char* b2 = last ? nB : cB + (size_t)(t + 2) * kstep;
            const char* a3 = a2 + kstep; const char* b3 = b2 + kstep;
            if (last && has_next) S.a_ready(nxt);
            if constexpr (SP2) {
            PG8_LDB(B0, 0, 0); PG8_LDB(B1, 0, 1); PG8_SCHED; PG8_LDA(At, 0, 0); PG8_STAGE(PG8_SA(1, 1), a1 + hstepA, voffA);
            PG8_WAIT_V(8); PG8_WAIT_L(0); PG8_BAR; PG8_MMA(0, 0, At, B0); PG8_MMA(0, 1, At, B1); PG8_BAR; PG8_SCHED;
            PG8_LDA(At, 0, 1); PG8_STAGE(PG8_SB(0, 0), b2, voffB); PG8_STAGE(PG8_SB(0, 1), b2 + hstepB, voffB); PG8_STAGE(PG8_SA(0, 0), a2, voffA);
            PG8_WAIT_V(8); PG8_WAIT_L(0); PG8_BAR; PG8_MMA(1, 0, At, B0); PG8_MMA(1, 1, At, B1); PG8_BAR; PG8_SCHED;
            PG8_LDB(B0, 1, 0); PG8_LDB(B1, 1, 1); PG8_SCHED; PG8_LDA(At, 1, 0); PG8_STAGE(PG8_SA(0, 1), a2 + hstepA, voffA);
            PG8_WAIT_V(8); PG8_WAIT_L(0); PG8_BAR; PG8_MMA(0, 0, At, B0); PG8_MMA(0, 1, At, B1); PG8_BAR; PG8_SCHED;
            PG8_LDA(At, 1, 1); PG8_STAGE(PG8_SB(1, 0), b3, voffB); PG8_STAGE(PG8_SB(1, 1), b3 + hstepB, voffB); PG8_STAGE(PG8_SA(1, 0), a3, voffA);
            PG8_WAIT_V(8); PG8_WAIT_L(0); PG8_BAR; PG8_MMA(1, 0, At, B0); PG8_MMA(1, 1, At, B1); PG8_BAR; PG8_SCHED;
            } else {
            PG8_LDB(B0, 0, 0); PG8_SCHED; PG8_LDA(At, 0, 0); PG8_STAGE(PG8_SA(1, 1), a1 + hstepA, voffA);
            PG8_WAIT_L(8); PG8_BAR; PG8_WAIT_L(0); PG8_MMA(0, 0, At, B0); PG8_BAR; PG8_SCHED;
            PG8_LDB(B1, 0, 1); PG8_STAGE(PG8_SB(0, 0), b2, voffB);
            PG8_BAR; PG8_WAIT_L(0); PG8_MMA(0, 1, At, B1); PG8_BAR;
            PG8_LDA(At, 0, 1); PG8_STAGE(PG8_SA(0, 0), a2, voffA);
            PG8_BAR; PG8_WAIT_L(0); PG8_MMA(1, 0, At, B0); PG8_BAR; PG8_SCHED;
            PG8_STAGE(PG8_SB(0, 1), b2 + hstepB, voffB);
            PG8_WAIT_V(6); PG8_BAR; PG8_MMA(1, 1, At, B1); PG8_BAR;
            PG8_LDB(B0, 1, 0); PG8_SCHED; PG8_LDA(At, 1, 0); PG8_STAGE(PG8_SA(0, 1), a2 + hstepA, voffA);
            PG8_WAIT_L(8); PG8_BAR; PG8_WAIT_L(0); PG8_MMA(0, 0, At, B0); PG8_BAR; PG8_SCHED;
            PG8_LDB(B1, 1, 1); PG8_STAGE(PG8_SB(1, 0), b3, voffB);
            PG8_BAR; PG8_WAIT_L(0); PG8_MMA(0, 1, At, B1); PG8_BAR;
            PG8_LDA(At, 1, 1); PG8_STAGE(PG8_SA(1, 0), a3, voffA);
            PG8_BAR; PG8_WAIT_L(0); PG8_MMA(1, 0, At, B0); PG8_BAR; PG8_SCHED;
            PG8_STAGE(PG8_SB(1, 1), b3 + hstepB, voffB);
            PG8_WAIT_V(6); PG8_BAR; PG8_MMA(1, 1, At, B1); PG8_BAR;
            }
        }
        if constexpr (ALIGN_EPI) { if (wr == 0) PG8_BAR; }
        if constexpr (!Epi::AFTER_DRAIN) { E(acc, cur, wr, wc, fr, fq);
#ifdef PROBE_EPI_DUP
            if constexpr (Epi::PROBE_DUP) { asm volatile("" ::: "memory"); E(acc, cur, wr, wc, fr, fq); }
#endif
            S.done(cur); }
        if (!has_next) break;
#pragma unroll
        for (int a = 0; a < 2; ++a)
#pragma unroll
            for (int b = 0; b < 2; ++b)
#pragma unroll
                for (int m = 0; m < 4; ++m)
#pragma unroll
                    for (int n = 0; n < 2; ++n) acc[a][b][m][n] = (f32x4){0.f, 0.f, 0.f, 0.f};
        cur = nxt; cA = nA; cB = nB; ++ui;
        if constexpr (ALIGN_EPI) { if (wr == 1) PG8_BAR; }
    }
    PG8_WAIT_V(0);
    if constexpr (!ALIGN_EPI) { if (wr == 0) PG8_BAR; }
    PG8_BAR;
    if constexpr (Epi::AFTER_DRAIN) { E.fused(acc, cur, wr, wc, fr, fq, lds, wid, lane); S.done(cur); }
#undef PG8_SA
#undef PG8_SB
#undef PG8_STAGE
#undef PG8_LDA
#undef PG8_LDB
#undef PG8_MMA
#undef PG8_WAIT_V
#undef PG8_WAIT_L
#undef PG8_BAR
#undef PG8_SCHED
}
}

#define XB_TMO      128
#define XB_XCNT(j)  (256  + 64 * (j))
#define XB_XSUB(j)  (1280 + 64 * (j))
#define XB_XGEN(j)  (2304 + 64 * (j))
#define XB_TOP      3328
#define XB_TOPGEN   3392
#define XCD_BAR_WORDS 3456
#define XB_SPIN_CAP (1u << 18)

__device__ __forceinline__ unsigned xb_ld(unsigned* p)              { return __hip_atomic_load(p, __ATOMIC_RELAXED, __HIP_MEMORY_SCOPE_AGENT); }
__device__ __forceinline__ unsigned xb_add(unsigned* p, unsigned v) { return __hip_atomic_fetch_add(p, v, __ATOMIC_RELAXED, __HIP_MEMORY_SCOPE_AGENT); }
__device__ __forceinline__ unsigned xb_xcc_id() { return (unsigned)__builtin_amdgcn_s_getreg((3 << 11) | 20) & 0xFu; }
#define XB_SPIN(cond, bar) do { unsigned _sp = 0; while (cond) { __builtin_amdgcn_s_sleep(1); \
    if ((++_sp & 255u) == 0u) { if (xb_ld(&(bar)[XB_TMO])) break; if (_sp > XB_SPIN_CAP) { atomicAdd(&(bar)[XB_TMO], 1u); break; } } } } while (0)

struct XcdBarrier {
    unsigned* bar; unsigned x;
    volatile LAS unsigned* st;
};

__device__ __forceinline__ XcdBarrier xcd_barrier_post(unsigned* bar, volatile LAS unsigned* st) {
    XcdBarrier b; b.bar = bar; b.x = xb_xcc_id(); b.st = st;
    if (threadIdx.x == 0) (void)xb_add(&bar[XB_XCNT(b.x)], 1u);
    return b;
}
__device__ __forceinline__ void xcd_barrier_complete(unsigned* bar, unsigned x, unsigned& nloc, unsigned& nx) {
    const unsigned G = gridDim.x * gridDim.y * gridDim.z;
    unsigned sum, cnt, mine, sp = 0u;
    for (;;) {
        sum = 0u; cnt = 0u; mine = 0u;
#pragma unroll
        for (unsigned j = 0; j < 16; ++j) { const unsigned c = xb_ld(&bar[XB_XCNT(j)]); sum += c; cnt += (c > 0u) ? 1u : 0u; mine = (j == x) ? c : mine; }
        if (sum == G) break;
        __builtin_amdgcn_s_sleep(1);
        if ((++sp & 255u) == 0u) { if (xb_ld(&bar[XB_TMO])) break; if (sp > XB_SPIN_CAP) { atomicAdd(&bar[XB_TMO], 1u); break; } }
    }
    nloc = mine > 0u ? mine : 1u; nx = cnt > 0u ? cnt : 1u;
}

__device__ __forceinline__ void xcd_barrier(const XcdBarrier& b) {
    asm volatile("s_waitcnt vmcnt(0)" ::: "memory");
    __syncthreads();
    if (threadIdx.x == 0) {
        unsigned* bar = b.bar; asm volatile("" : "+s"(bar));
        __builtin_amdgcn_s_waitcnt(0);
        unsigned nloc = b.st[0], nx = b.st[1];
        unsigned bx = b.x; asm volatile("" : "+s"(bx));
        if (nloc == 0u) { xcd_barrier_complete(bar, bx, nloc, nx); b.st[0] = nloc; b.st[1] = nx; }
        const unsigned old = xb_add(&bar[XB_XSUB(bx)], 1u);
        const unsigned gen = old / nloc;
        if (old + 1u == (gen + 1u) * nloc) {
            __builtin_amdgcn_fence(__ATOMIC_RELEASE, "agent");
            asm volatile("s_waitcnt vmcnt(0)" ::: "memory");
            const unsigned og = xb_add(&bar[XB_TOP], 1u);
            const unsigned tg = og / nx;
            if (og + 1u == (tg + 1u) * nx) xb_add(&bar[XB_TOPGEN], 1u);
            else XB_SPIN(xb_ld(&bar[XB_TOPGEN]) == tg, bar);
            __builtin_amdgcn_fence(__ATOMIC_ACQUIRE, "agent");
            xb_add(&bar[XB_XGEN(bx)], 1u);
            asm volatile("s_waitcnt vmcnt(0)" ::: "memory");
        } else {
            XB_SPIN(xb_ld(&bar[XB_XGEN(bx)]) == gen, bar);
            __builtin_amdgcn_fence(__ATOMIC_ACQUIRE, "agent");
            asm volatile("s_waitcnt vmcnt(0)" ::: "memory");
        }
    }
    __syncthreads();
}
struct Params {
    const float* in[23];
    float* out;
    unsigned char* ws;
};

struct Ctx {
    LAS unsigned char* lds;
    int tid, lane, wave, G, blk;
};

__device__ __forceinline__ void transpose_item(const float* W, int ld, bf16* WT, int Kd, int k0, int n0, int drow0, LAS float* scr, int lane) {
#pragma unroll 8
    for (int i = 0; i < 32; ++i) { const int kk = 2 * i + (lane >> 5); scr[kk * 33 + (lane & 31)] = W[(size_t)(k0 + kk) * ld + n0 + (lane & 31)]; }
    LDS_WAIT(); asm volatile("" ::: "memory");
    const int c = lane & 7;
#pragma unroll
    for (int j = 0; j < 4; ++j) { const int n = (lane >> 3) + 8 * j; const LAS float* s = scr + (8 * c) * 33 + n;
        u32x4 o; o.x = cvt_pk_bf16(s[0 * 33], s[1 * 33]); o.y = cvt_pk_bf16(s[2 * 33], s[3 * 33]); o.z = cvt_pk_bf16(s[4 * 33], s[5 * 33]); o.w = cvt_pk_bf16(s[6 * 33], s[7 * 33]);
        *(u32x4*)(WT + (size_t)(drow0 + n) * Kd + k0 + 8 * c) = o; }
    LDS_WAIT(); asm volatile("" ::: "memory");
}

__device__ __forceinline__ void cvt_copy(const float* src, bf16* dst, size_t n8, size_t i0, size_t stride) {
    for (size_t i = i0; i < n8; i += stride) { const f32x4 a = *(const f32x4*)(src + i * 8), b = *(const f32x4*)(src + i * 8 + 4);
        u32x4 o; o.x = cvt_pk_bf16(a[0], a[1]); o.y = cvt_pk_bf16(a[2], a[3]); o.z = cvt_pk_bf16(b[0], b[1]); o.w = cvt_pk_bf16(b[2], b[3]);
        *(u32x4*)(dst + i * 8) = o; }
}

__device__ __forceinline__ void p0_prologue(const Params& P, const Ctx& C) {
    unsigned char* ws = P.ws;
    {
        LAS float* scr = (LAS float*)(C.lds + RING_OFF + C.wave * 16384);
        const int gw = C.blk * 8 + C.wave, NGW = C.G * 8;
        constexpr int I_IN = (D / 64) * (NQKV / 32), I_O = (D / 64) * (D / 32), I_G = (D / 64) * (DFF / 32), I_D = (DFF / 64) * (D / 32);
        constexpr int I_L = I_IN + I_O + 2 * I_G + I_D;
        for (int it = gw; it < 2 * I_L; it += NGW) {
            const int l = it / I_L; int r = it % I_L;
            if (r < I_IN) { const int nb = NQKV / 32, kb = r / nb, n0 = (r % nb) * 32;
                transpose_item(P.in[15] + (size_t)l * D * NIN, NIN, (bf16*)(ws + WS_WIN + l * SZ_WIN), LDW, kb * 64, n0, n0, scr, C.lane); continue; }
            r -= I_IN;
            if (r < I_O) { const int nb = D / 32, kb = r / nb, n0 = (r % nb) * 32;
                transpose_item(P.in[18] + (size_t)l * D * D, D, (bf16*)(ws + WS_WO + l * SZ_WO), LDW, kb * 64, n0, n0, scr, C.lane); continue; }
            r -= I_O;
            if (r < 2 * I_G) { const int up = r >= I_G; if (up) r -= I_G; const int nb = DFF / 32, kb = r / nb, n0 = (r % nb) * 32;
                const int drow0 = (n0 >> 7) * 256 + (n0 & 127) + (up ? 128 : 0);
                transpose_item(P.in[up ? 20 : 19] + (size_t)l * D * DFF, DFF, (bf16*)(ws + WS_WGU + l * SZ_WGU), LDW, kb * 64, n0, drow0, scr, C.lane); continue; }
            r -= 2 * I_G;
            { const int nb = D / 32, kb = r / nb, n0 = (r % nb) * 32;
                transpose_item(P.in[21] + (size_t)l * DFF * D, D, (bf16*)(ws + WS_WDN + l * SZ_WDN), LDWD, kb * 64, n0, n0, scr, C.lane); }
        }
    }
    {
        const size_t i0 = (size_t)C.blk * 512 + C.tid, stride = (size_t)C.G * 512;
        cvt_copy(P.in[2], (bf16*)(ws + WS_CAK), SZ_CA / 16, i0, stride); cvt_copy(P.in[3], (bf16*)(ws + WS_CAV), SZ_CA / 16, i0, stride);
        cvt_copy(P.in[4], (bf16*)(ws + WS_CBK), SZ_CB / 16, i0, stride); cvt_copy(P.in[5], (bf16*)(ws + WS_CBV), SZ_CB / 16, i0, stride);
        cvt_copy(P.in[7], (bf16*)(ws + WS_CCK), SZ_CB / 16, i0, stride); cvt_copy(P.in[8], (bf16*)(ws + WS_CCV), SZ_CB / 16, i0, stride);
    }
    {
        __syncthreads();
        LAS float* st = (LAS float*)(C.lds + RING_OFF);
        for (int idx = C.tid; idx < NMIDX * D; idx += 512) { const int m = idx / D, k = idx % D;
            const float c = m < PB ? P.in[9][m * D + k] : P.in[10][(m - PB) * D + k];
            st[k * NMIDX + m] = c * fast_rcp(1.0f + fast_exp2(-c * LOG2E)); }
        __syncthreads();
        float* mod = (float*)(ws + WS_MOD);
        constexpr int KC = 256, NKC = D / KC, NNC = NMOD / 256;
        for (int it = C.wave * C.G + C.blk; it < 2 * NKC * NNC; it += 8 * C.G) {
            const int l = it / (NKC * NNC), r = it % (NKC * NNC), kc = r / NNC, nc = r % NNC, k0 = kc * KC, n0 = nc * 256 + C.lane * 4;
            const float* wp = P.in[11] + ((size_t)l * D + k0) * NMOD + n0;
            f32x4 acc[NMIDX];
#pragma unroll
            for (int m = 0; m < NMIDX; ++m) acc[m] = (f32x4){0.f, 0.f, 0.f, 0.f};
#pragma unroll 4
            for (int k = 0; k < KC; ++k) { const f32x4 w = *(const f32x4*)(wp + (size_t)k * NMOD);
                const LAS f32x4* sp = (const LAS f32x4*)(st + (k0 + k) * NMIDX); const f32x4 s0 = sp[0], s1 = sp[1], s2 = sp[2];
                acc[0] += w * s0[0]; acc[1] += w * s0[1]; acc[2] += w * s0[2]; acc[3] += w * s0[3];
                acc[4] += w * s1[0]; acc[5] += w * s1[1]; acc[6] += w * s1[2]; acc[7] += w * s1[3];
                acc[8] += w * s2[0]; acc[9] += w * s2[1]; acc[10] += w * s2[2]; acc[11] += w * s2[3]; }
            f32x4 bias = (f32x4){0.f, 0.f, 0.f, 0.f};
            if (kc == 0) bias = *(const f32x4*)(P.in[12] + (size_t)l * NMOD + n0);
#pragma unroll
            for (int m = 0; m < NMIDX; ++m) { float* mp = mod + ((size_t)l * NMIDX + m) * NMOD + n0;
#pragma unroll
                for (int j = 0; j < 4; ++j) __hip_atomic_fetch_add(mp + j, acc[m][j] + bias[j], __ATOMIC_RELAXED, __HIP_MEMORY_SCOPE_AGENT); }
        }
    }
}

template <bool WITH_LOGF>
__device__ __forceinline__ void norm_rows(const Ctx& C, const float* xrows, bf16* hrows, int nrows, const float* gvec, const float* shift, const float* scale,
                                          const LAS float* wf, const float* bf, float* lf_out) {
    f32x4 gm[8], sh[8];
#pragma unroll
    for (int j = 0; j < 8; ++j) { const int e = 4 * C.lane + 256 * j; const f32x4 g = *(const f32x4*)(gvec + e), sc = *(const f32x4*)(scale + e); sh[j] = *(const f32x4*)(shift + e); gm[j] = g * (sc + 1.0f); }
    f32x4 nx[8];
#pragma unroll
    for (int j = 0; j < 8; ++j) nx[j] = *(const f32x4*)(xrows + 4 * C.lane + 256 * j);
    for (int r = 0; r < nrows; ++r) {
        f32x4 v[8]; float ss = 0.f;
#pragma unroll
        for (int j = 0; j < 8; ++j) v[j] = nx[j];
        if (r + 1 < nrows) { const float* xr = xrows + (size_t)(r + 1) * D;
#pragma unroll
            for (int j = 0; j < 8; ++j) nx[j] = *(const f32x4*)(xr + 4 * C.lane + 256 * j); }
        asm volatile("" ::: "memory");
#pragma unroll
        for (int j = 0; j < 8; ++j) ss += (v[j][0] * v[j][0] + v[j][1] * v[j][1]) + (v[j][2] * v[j][2] + v[j][3] * v[j][3]);
        const float rstd = 1.0f / sqrtf(wave_sum(ss) * (1.0f / D) + EPS);
#pragma unroll
        for (int j = 0; j < 8; ++j) v[j] = v[j] * rstd * gm[j] + sh[j];
        bf16* hr = hrows + (size_t)r * LDH;
#pragma unroll
        for (int j = 0; j < 8; ++j) { u32x2 w; w.x = cvt_pk_bf16(v[j][0], v[j][1]); w.y = cvt_pk_bf16(v[j][2], v[j][3]); *(u32x2*)(hr + 4 * C.lane + 256 * j) = w; }
        if constexpr (WITH_LOGF) {
            float dots[6];
#pragma unroll
            for (int f = 0; f < 6; ++f) { float a = 0.f;
#pragma unroll
                for (int j = 0; j < 8; ++j) { const f32x4 w = *(const LAS f32x4*)(wf + f * D + 4 * C.lane + 256 * j); a += (v[j][0] * w[0] + v[j][1] * w[1]) + (v[j][2] * w[2] + v[j][3] * w[3]); }
                dots[f] = wave_sum(a); }
            if (C.lane < 6) { float z = C.lane == 0 ? dots[0] : C.lane == 1 ? dots[1] : C.lane == 2 ? dots[2] : C.lane == 3 ? dots[3] : C.lane == 4 ? dots[4] : dots[5];
                z += bf[C.lane];
                const float ls = fminf(z, 0.f) - LN2 * fast_log2(1.0f + fast_exp2(-fabsf(z) * LOG2E));
                lf_out[(size_t)r * HB + C.lane] = ls; }
        }
    }
}

__device__ __forceinline__ void sample_resid_row(const Ctx& C, const float* xin, float* xout, const float* part, int nkc, const float* gate) {
    f32x4 s[8];
#pragma unroll
    for (int j = 0; j < 8; ++j) s[j] = (f32x4){0.f, 0.f, 0.f, 0.f};
    for (int kc = 0; kc < nkc; ++kc) { const float* pp = part + (size_t)kc * MS * D;
#pragma unroll
        for (int j = 0; j < 8; ++j) s[j] += *(const f32x4*)(pp + 4 * C.lane + 256 * j); }
#pragma unroll
    for (int j = 0; j < 8; ++j) { const int e = 4 * C.lane + 256 * j; *(f32x4*)(xout + e) = *(const f32x4*)(xin + e) + *(const f32x4*)(gate + e) * s[j]; }
}
template <bool WITH_LOGF>
__device__ __forceinline__ void norm_phase(const Params& P, const Ctx& C, int layer, const float* xp, const float* xs, const float* gvec, int off_shift, int off_scale,
                                           int fix_nkc, const float* fix_mod, int fix_gate_off) {
    bf16* H = (bf16*)(P.ws + WS_H); const float* mod = (const float*)(P.ws + WS_MOD) + (size_t)layer * NMIDX * NMOD;
    LAS float* wf = (LAS float*)(C.lds + RING_OFF);
    if constexpr (WITH_LOGF) {
        const float* win = P.in[15] + (size_t)layer * D * NIN + NQKV;
        for (int idx = C.tid; idx < 6 * D; idx += 512) { const int k = idx / 6, f = idx % 6; wf[f * D + k] = win[(size_t)k * NIN + f]; }
        __syncthreads();
    }
    const float* bf = P.in[16] + layer * HB;
    float* lfp = P.out + O_BLF_P + (size_t)layer * PB * PT * HB; float* lfs = P.out + O_BLF_S + (size_t)layer * MS * HB;
    const int gw = C.blk * 8 + C.wave, NGW = C.G * 8;
    for (int it = gw; it < MP / 16; it += NGW) { const int r0 = it * 16, b = r0 >> 13; const float* mv = mod + (size_t)b * NMOD;
        norm_rows<WITH_LOGF>(C, xp + (size_t)r0 * D, H + (size_t)r0 * LDH, 16, gvec, mv + off_shift, mv + off_scale, wf, bf, lfp + (size_t)r0 * HB); }
    if (C.wave == 0 && xs != nullptr) for (int r = C.blk; r < MS; r += C.G) { const float* mv = mod + (size_t)(PB + (r >> 5)) * NMOD; const float* xr = xs + (size_t)r * D;
        if (fix_nkc > 0) { float* xo = P.out + O_Y_S + (size_t)r * D;
            sample_resid_row(C, xr, xo, (const float*)(P.ws + WS_PART) + (size_t)r * D, fix_nkc, fix_mod + (size_t)(PB + (r >> 5)) * NMOD + fix_gate_off); xr = xo; }
        norm_rows<WITH_LOGF>(C, xr, H + (size_t)(MP + r) * LDH, 1, gvec, mv + off_shift, mv + off_scale, wf, bf, lfs + (size_t)r * HB); }
    __syncthreads();
}

__device__ __forceinline__ void final_norm(const Params& P, const Ctx& C) {
    const float* g = P.in[22]; f32x4 gm[8];
#pragma unroll
    for (int j = 0; j < 8; ++j) gm[j] = *(const f32x4*)(g + 4 * C.lane + 256 * j);
    const int gw = C.blk * 8 + C.wave, NGW = C.G * 8;
    for (int it = gw; it < MP / 16; it += NGW) {
        float* x0 = P.out + (size_t)it * 16 * D; f32x4 nx[8];
#pragma unroll
        for (int j = 0; j < 8; ++j) nx[j] = *(const f32x4*)(x0 + 4 * C.lane + 256 * j);
        for (int r = 0; r < 16; ++r) { float* xr = x0 + (size_t)r * D; f32x4 v[8]; float ss = 0.f;
#pragma unroll
            for (int j = 0; j < 8; ++j) v[j] = nx[j];
            if (r + 1 < 16) {
#pragma unroll
                for (int j = 0; j < 8; ++j) nx[j] = *(const f32x4*)(xr + D + 4 * C.lane + 256 * j); }
            asm volatile("" ::: "memory");
#pragma unroll
            for (int j = 0; j < 8; ++j) ss += (v[j][0] * v[j][0] + v[j][1] * v[j][1]) + (v[j][2] * v[j][2] + v[j][3] * v[j][3]);
            const float rstd = 1.0f / sqrtf(wave_sum(ss) * (1.0f / D) + EPS);
#pragma unroll
            for (int j = 0; j < 8; ++j) *(f32x4*)(xr + 4 * C.lane + 256 * j) = v[j] * rstd * gm[j]; }
    }
    if (C.wave == 0) for (int rs = C.blk; rs < MS; rs += C.G) {
        float* xr = P.out + O_Y_S + (size_t)rs * D;
        sample_resid_row(C, xr, xr, (const float*)(P.ws + WS_PART) + (size_t)rs * D, DFF / 256, (const float*)(P.ws + WS_MOD) + ((size_t)NMIDX + PB + (rs >> 5)) * NMOD + 5 * D);
        f32x4 v[8]; float ss = 0.f;
#pragma unroll
        for (int j = 0; j < 8; ++j) { v[j] = *(const f32x4*)(xr + 4 * C.lane + 256 * j); ss += (v[j][0] * v[j][0] + v[j][1] * v[j][1]) + (v[j][2] * v[j][2] + v[j][3] * v[j][3]); }
        const float rstd = 1.0f / sqrtf(wave_sum(ss) * (1.0f / D) + EPS);
#pragma unroll
        for (int j = 0; j < 8; ++j) *(f32x4*)(xr + 4 * C.lane + 256 * j) = v[j] * rstd * gm[j]; }
}

__device__ __forceinline__ float block_excl_scan(const Ctx& C, LAS float* red, float s) {
    float incl = s;
#pragma unroll
    for (int o = 1; o < 64; o <<= 1) { const float t = __shfl_up(incl, o); if (C.lane >= o) incl += t; }
    if (C.lane == 63) red[C.wave] = incl;
    __syncthreads();
    float base = 0.f;
    for (int w = 0; w < C.wave; ++w) base += red[w];
    return base + incl - s;
}

__device__ __forceinline__ void fcum_phase(const Params& P, const Ctx& C, int layer) {
    LAS float* red = (LAS float*)(C.lds + RING_OFF);
    if (C.blk < PB * HB) {
        const int b = C.blk / HB, h = C.blk % HB; const float* lf = P.out + O_BLF_P + ((size_t)(layer * PB + b) * PT) * HB + h;
        float* F = (float*)(P.ws + WS_FP) + ((size_t)b * PT) * HB + h;
        float v[16]; float s = 0.f;
#pragma unroll
        for (int i = 0; i < 16; ++i) { v[i] = lf[(size_t)(C.tid * 16 + i) * HB]; s += v[i]; }
        float a = block_excl_scan(C, red, s);
#pragma unroll
        for (int i = 0; i < 16; ++i) { a += v[i]; F[(size_t)(C.tid * 16 + i) * HB] = a; }
        __syncthreads();
    } else if (C.blk < PB * HB + SB * HB) {
        const int q = C.blk - PB * HB, sb = q / HB, h = q % HB; constexpr int L = PAST + ST;
        const float* cl = P.in[6] + ((size_t)(layer * SB + sb) * PAST) * HB + h; const float* nl = P.out + O_BLF_S + ((size_t)(layer * SB + sb) * ST) * HB + h;
        float* F = (float*)(P.ws + WS_FS) + ((size_t)sb * L) * HB + h;
        float v[3]; float s = 0.f;
#pragma unroll
        for (int i = 0; i < 3; ++i) { const int p = C.tid * 3 + i; v[i] = p < PAST ? cl[(size_t)p * HB] : (p < L ? nl[(size_t)(p - PAST) * HB] : 0.f); s += v[i]; }
        float a = block_excl_scan(C, red, s);
#pragma unroll
        for (int i = 0; i < 3; ++i) { const int p = C.tid * 3 + i; a += v[i]; if (p < L) F[(size_t)p * HB] = a; }
        __syncthreads();
    }
}

__device__ __forceinline__ void finish_qkv(const Params& P, const Ctx& C, int layer) {
    const float* part = (const float*)(P.ws + WS_PART); bf16* qkv = (bf16*)(P.ws + WS_QKV);
    for (int r = C.blk; r < MS; r += C.G)
        for (int c4 = C.tid; c4 < NQKV / 4; c4 += 512) { const int c = c4 * 4; f32x4 s = (f32x4){0.f, 0.f, 0.f, 0.f};
#pragma unroll
            for (int kc = 0; kc < 8; ++kc) s += *(const f32x4*)(part + ((size_t)kc * MS + r) * NQKV + c);
            u32x2 w; w.x = cvt_pk_bf16(s[0], s[1]); w.y = cvt_pk_bf16(s[2], s[3]); *(u32x2*)(qkv + (size_t)(MP + r) * LDQ + c) = w;
            const int which = c / D;
            if (which != 0) { const int hh = (c % D) / HD, d = c % HD; const bool isv = which == 2; float* dst;
                if (hh < HA) dst = P.out + (isv ? O_AV_S : O_AK_S) + ((size_t)(layer * MS + r) * HA + hh) * HD + d;
                else if (hh < HA + HB) dst = P.out + (isv ? O_BV_S : O_BK_S) + ((size_t)(layer * MS + r) * HB + (hh - HA)) * HD + d;
                else dst = P.out + (isv ? O_CV_S : O_CK_S) + ((size_t)(layer * MS + r) * HC + (hh - HA - HB)) * HD + d;
                *(f32x4*)dst = s; } }
}
__device__ __forceinline__ void finish_act(const Params& P, const Ctx& C) {
    const float* part = (const float*)(P.ws + WS_PART); bf16* act = (bf16*)(P.ws + WS_QKV);
    for (int r = C.blk; r < MS; r += C.G)
        for (int j4 = C.tid; j4 < DFF / 4; j4 += 512) { const int j = j4 * 4, cg = (j >> 7) * 256 + (j & 127); f32x4 g = (f32x4){0.f, 0.f, 0.f, 0.f}, up = g;
#pragma unroll
            for (int kc = 0; kc < 4; ++kc) { const float* pr = part + ((size_t)kc * MS + r) * (2 * DFF) + cg; g += *(const f32x4*)pr; up += *(const f32x4*)(pr + 128); }
            float o[4];
#pragma unroll
            for (int i = 0; i < 4; ++i) o[i] = g[i] * fast_rcp(1.0f + fast_exp2(-g[i] * LOG2E)) * up[i];
            u32x2 w; w.x = cvt_pk_bf16(o[0], o[1]); w.y = cvt_pk_bf16(o[2], o[3]); *(u32x2*)(act + (size_t)(MP + r) * LDACT + j) = w; }
}


namespace att {
constexpr int KROW = 272, VROW = 144;
constexpr int KBUF = 64 * KROW, VBUF = 128 * VROW;
constexpr int OFF_K = 0, OFF_V = 2 * KBUF, OFF_FB = OFF_V + 2 * VBUF, OFF_REL = OFF_FB + 512, OFF_VOTE = OFF_REL + 1040, OFF_QW = OFF_VOTE + 64;
static_assert(OFF_QW + 16 <= RING_BYTES && (OFF_REL % 16) == 0 && (OFF_VOTE % 16) == 0, "attention LDS map");
constexpr float STICK_STOP = -105.0f;

struct Unit {
    const bf16* q; bf16* o; int ostride; int nq, qpos0, kv_len, new_pos0;
    const bf16 *kn, *vn, *kc, *vc; int cstride;
    int t_hi, t_lo;
    const float* F; float fref; float kmax;
    const float* rel;
};

__device__ __forceinline__ float partner32(float x, int hi) {
    auto rr = __builtin_amdgcn_permlane32_swap(__float_as_uint(x), __float_as_uint(x), false, false);
    return __uint_as_float(hi ? rr[0] : rr[1]);
}
__device__ __forceinline__ bf16x8 pack8(float a0, float a1, float a2, float a3, float a4, float a5, float a6, float a7) {
    u32x4 w = {cvt_pk_bf16(a0, a1), cvt_pk_bf16(a2, a3), cvt_pk_bf16(a4, a5), cvt_pk_bf16(a6, a7)};
    return __builtin_bit_cast(bf16x8, w);
}

template <int MODE>
__device__ __forceinline__ void run_unit(LAS unsigned char* lds, const Unit& u, int tid, int wave, int lane) {
    const int qr = lane & 31, hi = lane >> 5;
    const bool active = wave * 32 < u.nq;
    const int qpos_w0 = u.qpos0 + wave * 32, qpos = qpos_w0 + qr;
    int w_hi, w_lo;
    if (MODE == 0) { const int n = qpos_w0 >> 6; w_hi = n; w_lo = n - 8 > 0 ? n - 8 : 0; }
    else if (MODE == 1) { w_hi = (qpos_w0 + 31) >> 6; w_lo = 0; }
    else { w_hi = (qpos_w0 + 30) >> 6; w_lo = 0; }
    const int near_lo = (qpos_w0 >> 6) - 2;
    bf16x8 qf[8];
    { const bf16* qp = u.q + (size_t)((active ? wave * 32 : 0) + qr) * LDQ + 8 * hi;
#pragma unroll
      for (int ds = 0; ds < 8; ++ds) qf[ds] = *(const bf16x8*)(qp + 16 * ds); }
    float qk_bound = 0.f;
    if (MODE == 1) { float s = 0.f;
#pragma unroll
        for (int ds = 0; ds < 8; ++ds) { const u32x4 w = __builtin_bit_cast(u32x4, qf[ds]);
#pragma unroll
            for (int i = 0; i < 4; ++i) { const float lo = __uint_as_float(w[i] << 16), hi2 = __uint_as_float(w[i] & 0xffff0000u); s += lo * lo + hi2 * hi2; } }
        s += partner32(s, hi); qk_bound = sqrtf(s) * u.kmax; }
    LAS float* rel_l = (LAS float*)(lds + OFF_REL);
    if (MODE == 0) { for (int i = tid; i < 257; i += 512) rel_l[i] = u.rel[i * HA] * INV_SCALE; }
    f32x16 o[4];
#pragma unroll
    for (int b = 0; b < 4; ++b)
#pragma unroll
        for (int r = 0; r < 16; ++r) o[b][r] = 0.f;
    float m_run = -1e30f, l_run = 0.f, carry = 0.f;
    const int k_key = tid >> 4, k_dc = tid & 15;
    const int k_lds = k_key * KROW + k_dc * 16;
    const int v_dc = lane & 15, v_kq = lane >> 4;
    const int v_key0 = 16 * (wave >> 1) + 4 * (wave & 1) + 2 * (v_kq & 1) + 8 * (v_kq >> 1);
    const int v_pos0 = (v_key0 & ~0xC) | ((v_key0 & 4) << 1) | ((v_key0 & 8) >> 1);
    const int v_lds = (8 * v_dc) * VROW + ((((v_pos0 >> 3) ^ ((v_dc >> 1) & 7))) << 4) + (v_pos0 & 7) * 2;
    const int kr_lds = qr * KROW + hi * 16;
    const int vr_lds = qr * VROW + ((hi ^ (qr >> 4)) << 4);
    u32x4 kreg[2], vreg[2]; float freg = 0.f;
    auto stage_load = [&](int j) {
        const int last = u.kv_len - 1;
#pragma unroll
        for (int i = 0; i < 2; ++i) { int pos = 64 * j + k_key + 32 * i; pos = pos < last ? pos : last; const bool nw = pos >= u.new_pos0;
            const bf16* src = (nw ? u.kn : u.kc) + (size_t)(nw ? pos - u.new_pos0 : pos) * (nw ? LDQ : u.cstride);
            kreg[i] = *(const u32x4*)(src + 8 * k_dc); }
#pragma unroll
        for (int i = 0; i < 2; ++i) { int pos = 64 * j + v_key0 + i; pos = pos < last ? pos : last; const bool nw = pos >= u.new_pos0;
            const bf16* src = (nw ? u.vn : u.vc) + (size_t)(nw ? pos - u.new_pos0 : pos) * (nw ? LDQ : u.cstride);
            vreg[i] = *(const u32x4*)(src + 8 * v_dc); }
        if (MODE == 1 && tid < 64) { int pos = 64 * j + tid; pos = pos < last ? pos : last; freg = u.F[(size_t)pos * HB]; }
    };
    auto stage_store = [&](int buf) {
        LAS unsigned char* kb = lds + OFF_K + buf * KBUF + k_lds;
        *(LAS u32x4*)kb = kreg[0]; *(LAS u32x4*)(kb + 32 * KROW) = kreg[1];
        LAS unsigned char* vb = lds + OFF_V + buf * VBUF + v_lds;
        const unsigned a[4] = {vreg[0].x, vreg[0].y, vreg[0].z, vreg[0].w}, b[4] = {vreg[1].x, vreg[1].y, vreg[1].z, vreg[1].w};
#pragma unroll
        for (int i = 0; i < 4; ++i) {
            *(LAS unsigned*)(vb + (2 * i) * VROW) = (a[i] & 0xffffu) | (b[i] << 16);
            *(LAS unsigned*)(vb + (2 * i + 1) * VROW) = (a[i] >> 16) | (b[i] & 0xffff0000u); }
        if (MODE == 1 && tid < 64) ((LAS float*)(lds + OFF_FB + buf * 256))[tid] = (u.fref - freg) * INV_SCALE;
    };
    stage_load(u.t_hi);
    stage_store(0);
    LDS_WAIT(); __syncthreads();
    bool wave_done = !active;
    for (int j = u.t_hi, it = 0;; --j, ++it) {
        const int cur = it & 1;
        const bool more = j > u.t_lo;
        if (more) stage_load(j - 1);
        if (active && j <= w_hi && j >= w_lo && !(MODE != 0 && wave_done)) {
            f32x16 p0, p1;
            if (MODE == 1) { const LAS f32x4* fb = (const LAS f32x4*)(lds + OFF_FB + cur * 256);
#pragma unroll
                for (int g = 0; g < 4; ++g) { const f32x4 a = fb[2 * g + hi], b = fb[8 + 2 * g + hi];
#pragma unroll
                    for (int i = 0; i < 4; ++i) { p0[4 * g + i] = a[i]; p1[4 * g + i] = b[i]; } } }
            else if (MODE == 0) {
                if (j >= near_lo) { const int base = qpos - 64 * j - 4 * hi + 128;
#pragma unroll
                    for (int r = 0; r < 16; ++r) { const int c = (r & 3) + 8 * (r >> 2); int i0 = base - c, i1 = base - c - 32; i0 = i0 < 256 ? i0 : 256; i1 = i1 < 256 ? i1 : 256;
                        p0[r] = rel_l[i0]; p1[r] = rel_l[i1]; } }
                else { const float cb = rel_l[256];
#pragma unroll
                    for (int r = 0; r < 16; ++r) { p0[r] = cb; p1[r] = cb; } } }
            else {
#pragma unroll
                for (int r = 0; r < 16; ++r) { p0[r] = 0.f; p1[r] = 0.f; } }
            { const LAS unsigned char* kb = lds + OFF_K + cur * KBUF + kr_lds;
#define ATT_KFRAG(i) (*(const LAS bf16x8*)(kb + ((i) & 1) * 32 * KROW + 32 * ((i) >> 1)))
              bf16x8 kf[8];
#pragma unroll
              for (int i = 0; i < 8; ++i) kf[i] = ATT_KFRAG(i);
              __builtin_amdgcn_sched_barrier(0);
#pragma unroll
              for (int i = 0; i < 16; ++i) {
                  if (i & 1) p1 = __builtin_amdgcn_mfma_f32_32x32x16_bf16(kf[i & 7], qf[i >> 1], p1, 0, 0, 0); else p0 = __builtin_amdgcn_mfma_f32_32x32x16_bf16(kf[i & 7], qf[i >> 1], p0, 0, 0, 0);
                  if (i + 8 < 16) kf[i & 7] = ATT_KFRAG(i + 8);
                  __builtin_amdgcn_sched_barrier(0); }
#undef ATT_KFRAG
            }
            const int kp0 = 64 * j + 4 * hi;
            if (MODE != 2) {
                const bool need_mask = MODE == 1 ? (64 * j + 63 > qpos_w0) : (64 * j + 63 >= u.kv_len);
                if (need_mask) { const int lim = MODE == 1 ? qpos + 1 : u.kv_len;
#pragma unroll
                    for (int r = 0; r < 16; ++r) { const int kp = kp0 + (r & 3) + 8 * (r >> 2);
                        if (kp >= lim) p0[r] = -__builtin_inff(); if (kp + 32 >= lim) p1[r] = -__builtin_inff(); } }
                float mx = fmaxf(p0[0], p1[0]);
#pragma unroll
                for (int r = 1; r < 16; ++r) mx = fmaxf(mx, fmaxf(p0[r], p1[r]));
                mx = fmaxf(mx, partner32(mx, hi));
                const float mn = fmaxf(m_run, mx);
                constexpr float C2 = ATT_SCALE * LOG2E;
                if (__any(mn > m_run)) { const float alpha = fast_exp2((m_run - mn) * C2); l_run *= alpha; m_run = mn;
#pragma unroll
                    for (int b = 0; b < 4; ++b)
#pragma unroll
                        for (int r = 0; r < 16; ++r) o[b][r] *= alpha; }
                const float mc = m_run * C2; float ps = 0.f;
#pragma unroll
                for (int r = 0; r < 16; ++r) { p0[r] = fast_exp2(p0[r] * C2 - mc); p1[r] = fast_exp2(p1[r] * C2 - mc); ps += p0[r] + p1[r]; }
                l_run += ps;
                if (MODE == 1) {
                    const float bmax = ((const LAS float*)(lds + OFF_FB + cur * 256))[0];
                    wave_done = __all((qk_bound + bmax - m_run) * C2 < -150.0f); }
            } else {
                const bool need_mask = 64 * j + 63 >= qpos_w0;
                float ls0[16], ls1[16];
#pragma unroll
                for (int r = 0; r < 16; ++r) {
                    const float z0 = p0[r] * ATT_SCALE, z1 = p1[r] * ATT_SCALE;
                    const float sp0 = fmaxf(z0, 0.f) + LN2 * fast_log2(1.0f + fast_exp2(-fabsf(z0) * LOG2E)), sp1 = fmaxf(z1, 0.f) + LN2 * fast_log2(1.0f + fast_exp2(-fabsf(z1) * LOG2E));
                    p0[r] = z0 - sp0; p1[r] = z1 - sp1;
                    ls0[r] = -sp0; ls1[r] = -sp1; }
                if (need_mask) {
#pragma unroll
                    for (int r = 0; r < 16; ++r) { const int kp = kp0 + (r & 3) + 8 * (r >> 2);
                        if (kp >= qpos) { ls0[r] = 0.f; p0[r] = -__builtin_inff(); } if (kp + 32 >= qpos) { ls1[r] = 0.f; p1[r] = -__builtin_inff(); } } }
                float a[8], b[8], t[8];
#pragma unroll
                for (int g = 0; g < 4; ++g) { a[g] = (ls0[4 * g] + ls0[4 * g + 1]) + (ls0[4 * g + 2] + ls0[4 * g + 3]); a[4 + g] = (ls1[4 * g] + ls1[4 * g + 1]) + (ls1[4 * g + 2] + ls1[4 * g + 3]); }
#pragma unroll
                for (int g = 0; g < 8; ++g) { b[g] = partner32(a[g], hi); t[g] = a[g] + b[g]; }
                float ps = carry;
#pragma unroll
                for (int g = 7; g >= 0; --g) {
                    const float sg = ps + (hi ? 0.f : b[g]);
                    if (g < 4) { const float e3 = sg, e2 = e3 + ls0[4 * g + 3], e1 = e2 + ls0[4 * g + 2], e0 = e1 + ls0[4 * g + 1];
                        p0[4 * g + 3] = fast_exp2((p0[4 * g + 3] + e3) * LOG2E); p0[4 * g + 2] = fast_exp2((p0[4 * g + 2] + e2) * LOG2E);
                        p0[4 * g + 1] = fast_exp2((p0[4 * g + 1] + e1) * LOG2E); p0[4 * g] = fast_exp2((p0[4 * g] + e0) * LOG2E); }
                    else { const int gg = g - 4; const float e3 = sg, e2 = e3 + ls1[4 * gg + 3], e1 = e2 + ls1[4 * gg + 2], e0 = e1 + ls1[4 * gg + 1];
                        p1[4 * gg + 3] = fast_exp2((p1[4 * gg + 3] + e3) * LOG2E); p1[4 * gg + 2] = fast_exp2((p1[4 * gg + 2] + e2) * LOG2E);
                        p1[4 * gg + 1] = fast_exp2((p1[4 * gg + 1] + e1) * LOG2E); p1[4 * gg] = fast_exp2((p1[4 * gg] + e0) * LOG2E); }
                    ps += t[g];
                }
                carry = ps;
                wave_done = __all(carry < STICK_STOP) || j == 0;
            }
            { const LAS unsigned char* vb = lds + OFF_V + cur * VBUF + vr_lds;
#define ATT_VFRAG(i) (*(const LAS bf16x8*)(vb + 32 * ((i) & 3) * VROW + ((((i) >> 2) ^ ((i) & 3)) << 5)))
              bf16x8 pf[4], vf[8];
              pf[0] = pack8(p0[0], p0[1], p0[2], p0[3], p0[4], p0[5], p0[6], p0[7]); pf[1] = pack8(p0[8], p0[9], p0[10], p0[11], p0[12], p0[13], p0[14], p0[15]);
              pf[2] = pack8(p1[0], p1[1], p1[2], p1[3], p1[4], p1[5], p1[6], p1[7]); pf[3] = pack8(p1[8], p1[9], p1[10], p1[11], p1[12], p1[13], p1[14], p1[15]);
#pragma unroll
              for (int i = 0; i < 8; ++i) vf[i] = ATT_VFRAG(i);
              __builtin_amdgcn_sched_barrier(0);
#pragma unroll
              for (int i = 0; i < 16; ++i) {
                  o[i & 3] = __builtin_amdgcn_mfma_f32_32x32x16_bf16(vf[i & 7], pf[i >> 2], o[i & 3], 0, 0, 0);
                  if (i + 8 < 16) vf[i & 7] = ATT_VFRAG(i + 8);
                  __builtin_amdgcn_sched_barrier(0); }
#undef ATT_VFRAG
            }
        }
        if (more) stage_store(cur ^ 1);
        if (MODE != 0 && lane == 0) ((LAS unsigned*)(lds + OFF_VOTE))[cur * 8 + wave] = (wave_done || j - 1 < w_lo) ? 1u : 0u;
        LDS_WAIT(); __syncthreads();
        if (!more) break;
        if (MODE != 0) { const LAS u32x4* vv = (const LAS u32x4*)(lds + OFF_VOTE + cur * 32); const u32x4 x = vv[0], y = vv[1];
            if ((x.x & x.y & x.z & x.w & y.x & y.y & y.z & y.w) != 0u) break; }
    }
    if (active) {
        float inv = 1.0f;
        if (MODE != 2) { const float lt = l_run + partner32(l_run, hi); inv = 1.0f / lt; }
        bf16* op = u.o + (size_t)(wave * 32 + qr) * u.ostride + 4 * hi;
#pragma unroll
        for (int db = 0; db < 4; ++db)
#pragma unroll
            for (int g = 0; g < 4; ++g) { u32x2 w; w.x = cvt_pk_bf16(o[db][4 * g] * inv, o[db][4 * g + 1] * inv); w.y = cvt_pk_bf16(o[db][4 * g + 2] * inv, o[db][4 * g + 3] * inv);
                *(u32x2*)(op + 32 * db + 8 * g) = w; }
    }
    __syncthreads();
}


__device__ __forceinline__ float vmax3(float a, float b, float c) { float r; asm("v_max3_f32 %0, %1, %2, %3" : "=v"(r) : "v"(a), "v"(b), "v"(c)); return r; }

__device__ __forceinline__ void run_unit_b(LAS unsigned char* lds, const Unit& u, int tid, int wave, int lane) {
    const int qr = lane & 31, hi = lane >> 5;
    const bool active = wave * 32 < u.nq;
    const int qpos_w0 = u.qpos0 + wave * 32, qpos = qpos_w0 + qr;
    const int w_hi = (qpos_w0 + 31) >> 6;
    bf16x8 qf[8];
    { const bf16* qp = u.q + (size_t)((active ? wave * 32 : 0) + qr) * LDQ + 8 * hi;
#pragma unroll
      for (int ds = 0; ds < 8; ++ds) qf[ds] = *(const bf16x8*)(qp + 16 * ds); }
    float qk_bound;
    { float s = 0.f;
#pragma unroll
      for (int ds = 0; ds < 8; ++ds) { const u32x4 w = __builtin_bit_cast(u32x4, qf[ds]);
#pragma unroll
          for (int i = 0; i < 4; ++i) { const float lo = __uint_as_float(w[i] << 16), hi2 = __uint_as_float(w[i] & 0xffff0000u); s += lo * lo + hi2 * hi2; } }
      s += partner32(s, hi); qk_bound = sqrtf(s) * u.kmax; }
    f32x16 o[4];
#pragma unroll
    for (int b = 0; b < 4; ++b)
#pragma unroll
        for (int r = 0; r < 16; ++r) o[b][r] = 0.f;
    float m_run = -1e30f, l_run = 0.f;
    const int k_key = tid >> 4, k_dc = tid & 15, k_lds = k_key * KROW + k_dc * 16;
    const int v_dc = lane & 15, v_kq = lane >> 4;
    const int v_key0 = 16 * (wave >> 1) + 4 * (wave & 1) + 2 * (v_kq & 1) + 8 * (v_kq >> 1);
    const int v_pos0 = (v_key0 & ~0xC) | ((v_key0 & 4) << 1) | ((v_key0 & 8) >> 1);
    const int v_lds = (8 * v_dc) * VROW + ((((v_pos0 >> 3) ^ ((v_dc >> 1) & 7))) << 4) + (v_pos0 & 7) * 2;
    const int kr_lds = qr * KROW + hi * 16, vr_lds = qr * VROW + ((hi ^ (qr >> 4)) << 4);
    u32x4 kreg[2], vreg[2], kreg2[2], vreg2[2]; float freg = 0.f, freg2 = 0.f;
#define B_STAGE_LOAD(J, kreg, vreg, freg) do { const int last_ = u.kv_len - 1; \
        _Pragma("unroll") for (int i = 0; i < 2; ++i) { int pos = 64 * (J) + k_key + 32 * i; pos = pos < last_ ? pos : last_; const bool nw = pos >= u.new_pos0; \
            const bf16* src = (nw ? u.kn : u.kc) + (size_t)(nw ? pos - u.new_pos0 : pos) * (nw ? LDQ : u.cstride); kreg[i] = *(const u32x4*)(src + 8 * k_dc); } \
        _Pragma("unroll") for (int i = 0; i < 2; ++i) { int pos = 64 * (J) + v_key0 + i; pos = pos < last_ ? pos : last_; const bool nw = pos >= u.new_pos0; \
            const bf16* src = (nw ? u.vn : u.vc) + (size_t)(nw ? pos - u.new_pos0 : pos) * (nw ? LDQ : u.cstride); vreg[i] = *(const u32x4*)(src + 8 * v_dc); } \
        if (tid < 64) { int pos = 64 * (J) + tid; pos = pos < last_ ? pos : last_; freg = u.F[(size_t)pos * HB]; } } while (0)
#define B_STAGE_STORE(B_, kreg, vreg, freg) do { LAS unsigned char* kb_ = lds + OFF_K + (B_) * KBUF + k_lds; *(LAS u32x4*)kb_ = kreg[0]; *(LAS u32x4*)(kb_ + 32 * KROW) = kreg[1]; \
        LAS unsigned char* vb_ = lds + OFF_V + (B_) * VBUF + v_lds; const unsigned a_[4] = {vreg[0].x, vreg[0].y, vreg[0].z, vreg[0].w}, b_[4] = {vreg[1].x, vreg[1].y, vreg[1].z, vreg[1].w}; \
        _Pragma("unroll") for (int i = 0; i < 4; ++i) { *(LAS unsigned*)(vb_ + (2 * i) * VROW) = (a_[i] & 0xffffu) | (b_[i] << 16); *(LAS unsigned*)(vb_ + (2 * i + 1) * VROW) = (a_[i] >> 16) | (b_[i] & 0xffff0000u); } \
        if (tid < 64) ((LAS float*)(lds + OFF_FB + (B_) * 256))[tid] = (u.fref - freg) * INV_SCALE; } while (0)
    B_STAGE_LOAD(u.t_hi, kreg, vreg, freg);
    B_STAGE_STORE(0, kreg, vreg, freg);
    if (u.t_hi > u.t_lo) B_STAGE_LOAD(u.t_hi - 1, kreg, vreg, freg);
    LDS_WAIT(); __syncthreads();
    constexpr float C2 = ATT_SCALE * LOG2E;
    bool wave_done = !active;
#define B_QK(PX, KH_) do { const LAS unsigned char* kb_ = lds + OFF_K + cur * KBUF + kr_lds + (KH_) * 32 * KROW; bf16x8 kf[4]; \
        _Pragma("unroll") for (int i = 0; i < 4; ++i) kf[i] = *(const LAS bf16x8*)(kb_ + 32 * i); \
        _Pragma("unroll") for (int i = 0; i < 8; ++i) { PX = __builtin_amdgcn_mfma_f32_32x32x16_bf16(kf[i & 3], qf[i], PX, 0, 0, 0); \
            if (i + 4 < 8) kf[i & 3] = *(const LAS bf16x8*)(kb_ + 32 * (i + 4)); } } while (0)
#define B_SM(PX, PFA, PFB, ALPHA) do { float mx = vmax3(PX[0], PX[1], PX[2]); \
        _Pragma("unroll") for (int r = 3; r < 15; r += 2) mx = vmax3(mx, PX[r], PX[r + 1]); \
        mx = fmaxf(mx, PX[15]); mx = fmaxf(mx, partner32(mx, hi)); const float mn = fmaxf(m_run, mx); ALPHA = fast_exp2((m_run - mn) * C2); l_run *= ALPHA; m_run = mn; \
        const float mc = mn * C2; float ps = 0.f; \
        _Pragma("unroll") for (int r = 0; r < 16; ++r) { PX[r] = fast_exp2(PX[r] * C2 - mc); ps += PX[r]; } \
        l_run += ps; PFA = pack8(PX[0], PX[1], PX[2], PX[3], PX[4], PX[5], PX[6], PX[7]); PFB = pack8(PX[8], PX[9], PX[10], PX[11], PX[12], PX[13], PX[14], PX[15]); } while (0)
#define B_PV(S0_, PFA, PFB) do { const LAS unsigned char* vb_ = lds + OFF_V + cur * VBUF + vr_lds; bf16x8 vf[4]; \
        _Pragma("unroll") for (int i = 0; i < 4; ++i) vf[i] = *(const LAS bf16x8*)(vb_ + 32 * (i & 3) * VROW + ((((S0_) + (i >> 2)) ^ (i & 3)) << 5)); \
        _Pragma("unroll") for (int i = 0; i < 8; ++i) { o[i & 3] = __builtin_amdgcn_mfma_f32_32x32x16_bf16(vf[i & 3], (i < 4 ? PFA : PFB), o[i & 3], 0, 0, 0); \
            if (i + 4 < 8) vf[i & 3] = *(const LAS bf16x8*)(vb_ + 32 * ((i + 4) & 3) * VROW + ((((S0_) + ((i + 4) >> 2)) ^ ((i + 4) & 3)) << 5)); } } while (0)
#define B_RESCALE(ALPHA) do { if (__any(ALPHA != 1.0f)) { _Pragma("unroll") for (int b = 0; b < 4; ++b) _Pragma("unroll") for (int r = 0; r < 16; ++r) o[b][r] *= ALPHA; } } while (0)
#define B_KFRAG1(i) (*(const LAS bf16x8*)(lds + OFF_K + cur * KBUF + kr_lds + 32 * KROW + 32 * (i)))
#define B_VFRAG0(i) (*(const LAS bf16x8*)(lds + OFF_V + cur * VBUF + vr_lds + 32 * ((i) & 3) * VROW + ((((i) >> 2) ^ ((i) & 3)) << 5)))
#define B_MFMA_SM(PX, PFA, PFB, ALPHA, FRAG_, MMA_) do { bf16x8 fr[4]; float mx_, mc_ = 0.f, ps_ = 0.f; \
        _Pragma("unroll") for (int i = 0; i < 4; ++i) fr[i] = FRAG_(i); \
        __builtin_amdgcn_sched_barrier(0); \
        _Pragma("unroll") for (int i = 0; i < 8; ++i) { MMA_; if (i + 4 < 8) fr[i & 3] = FRAG_(i + 4); \
            if (i == 0) { mx_ = vmax3(PX[0], PX[1], PX[2]); mx_ = vmax3(mx_, PX[3], PX[4]); mx_ = vmax3(mx_, PX[5], PX[6]); mx_ = vmax3(mx_, PX[7], PX[8]); } \
            if (i == 1) { mx_ = vmax3(mx_, PX[9], PX[10]); mx_ = vmax3(mx_, PX[11], PX[12]); mx_ = vmax3(mx_, PX[13], PX[14]); mx_ = fmaxf(mx_, PX[15]); mx_ = fmaxf(mx_, partner32(mx_, hi)); asm volatile("" : "+v"(mx_)); } \
            if (i == 2) { const float mn_ = fmaxf(m_run, mx_); ALPHA = fast_exp2((m_run - mn_) * C2); l_run *= ALPHA; m_run = mn_; mc_ = mn_ * C2; asm volatile("" : "+v"(mc_), "+v"(ALPHA)); } \
            if (i >= 3 && i <= 6) { _Pragma("unroll") for (int r = 4 * (i - 3); r < 4 * (i - 3) + 4; ++r) { PX[r] = fast_exp2(PX[r] * C2 - mc_); ps_ += PX[r]; } \
                asm volatile("" : "+v"(PX[4 * (i - 3)]), "+v"(PX[4 * (i - 3) + 1]), "+v"(PX[4 * (i - 3) + 2]), "+v"(PX[4 * (i - 3) + 3]), "+v"(ps_)); } \
            if (i == 7) { l_run += ps_; PFA = pack8(PX[0], PX[1], PX[2], PX[3], PX[4], PX[5], PX[6], PX[7]); PFB = pack8(PX[8], PX[9], PX[10], PX[11], PX[12], PX[13], PX[14], PX[15]); } \
            __builtin_amdgcn_sched_barrier(0); } } while (0)
#define B_HINT() do { _Pragma("unroll") for (int i = 0; i < 8; ++i) { __builtin_amdgcn_sched_group_barrier(0x008, 1, 0); __builtin_amdgcn_sched_group_barrier(0x100, 1, 0); __builtin_amdgcn_sched_group_barrier(0x002, 10, 0); } } while (0)
#define B_ITER(KS, VS, FS, KL, VL, FL) { \
        const int cur = it & 1; \
        const bool more = j > u.t_lo; \
        if (j - 1 > u.t_lo) B_STAGE_LOAD(j - 2, KL, VL, FL); \
        if (active && j <= w_hi && !wave_done) { \
            f32x16 p0, p1; bf16x8 pf0, pf1, pf2, pf3; float alpha_a, alpha_b; \
            const LAS f32x4* fb = (const LAS f32x4*)(lds + OFF_FB + cur * 256); const float bmax = ((const LAS float*)fb)[0]; \
        _Pragma("unroll") \
            for (int g = 0; g < 4; ++g) { const f32x4 a = fb[2 * g + hi], b = fb[8 + 2 * g + hi]; \
        _Pragma("unroll") \
                for (int i = 0; i < 4; ++i) { p0[4 * g + i] = a[i]; p1[4 * g + i] = b[i]; } } \
            const bool need_mask = 64 * j + 63 > qpos_w0; const int kp0 = 64 * j + 4 * hi; \
            B_QK(p0, 0); \
            if (need_mask) { \
        _Pragma("unroll") \
                for (int r = 0; r < 16; ++r) { if (kp0 + (r & 3) + 8 * (r >> 2) > qpos) p0[r] = -__builtin_inff(); } } \
            B_MFMA_SM(p0, pf0, pf1, alpha_a, B_KFRAG1, p1 = __builtin_amdgcn_mfma_f32_32x32x16_bf16(fr[i & 3], qf[i], p1, 0, 0, 0)); \
            if (need_mask) { \
        _Pragma("unroll") \
                for (int r = 0; r < 16; ++r) { if (kp0 + 32 + (r & 3) + 8 * (r >> 2) > qpos) p1[r] = -__builtin_inff(); } } \
            B_RESCALE(alpha_a); \
            B_MFMA_SM(p1, pf2, pf3, alpha_b, B_VFRAG0, o[i & 3] = __builtin_amdgcn_mfma_f32_32x32x16_bf16(fr[i & 3], (i < 4 ? pf0 : pf1), o[i & 3], 0, 0, 0)); \
            B_RESCALE(alpha_b); \
            B_PV(2, pf2, pf3); \
            wave_done = __all((qk_bound + bmax - m_run) * C2 < -150.0f); \
        } \
        if (more) B_STAGE_STORE(cur ^ 1, KS, VS, FS); \
        if (lane == 0) ((LAS unsigned*)(lds + OFF_VOTE))[cur * 8 + wave] = (wave_done || j == 0) ? 1u : 0u; \
        LDS_WAIT(); __syncthreads(); \
        if (!more) break; \
        { const LAS u32x4* vv = (const LAS u32x4*)(lds + OFF_VOTE + cur * 32); const u32x4 x = vv[0], y = vv[1]; \
          if ((x.x & x.y & x.z & x.w & y.x & y.y & y.z & y.w) != 0u) break; } \
    }
    for (int j = u.t_hi, it = 0;;) {
        B_ITER(kreg, vreg, freg, kreg2, vreg2, freg2) --j; ++it;
        B_ITER(kreg2, vreg2, freg2, kreg, vreg, freg) --j; ++it;
    }
#undef B_ITER
#undef B_STAGE_LOAD
#undef B_STAGE_STORE
#undef B_QK
#undef B_SM
#undef B_PV
#undef B_RESCALE
#undef B_HINT
#undef B_MFMA_SM
#undef B_KFRAG1
#undef B_VFRAG0
    if (active) {
        const float lt = l_run + partner32(l_run, hi), inv = 1.0f / lt;
        bf16* op = u.o + (size_t)(wave * 32 + qr) * u.ostride + 4 * hi;
#pragma unroll
        for (int db = 0; db < 4; ++db)
#pragma unroll
            for (int g = 0; g < 4; ++g) { u32x2 w; w.x = cvt_pk_bf16(o[db][4 * g] * inv, o[db][4 * g + 1] * inv); w.y = cvt_pk_bf16(o[db][4 * g + 2] * inv, o[db][4 * g + 3] * inv);
                *(u32x2*)(op + 32 * db + 8 * g) = w; }
    }
    __syncthreads();
}

__device__ __forceinline__ int pull(LAS unsigned char* lds, unsigned* counter, int tid) {
    LAS int* qw = (LAS int*)(lds + OFF_QW);
    if (tid == 0) *qw = (int)__hip_atomic_fetch_add(counter, 1u, __ATOMIC_RELAXED, __HIP_MEMORY_SCOPE_AGENT);
    LDS_WAIT(); __syncthreads();
    const int v = *qw;
    __syncthreads();
    return v;
}

template <int MODE>
__device__ __forceinline__ void mode_loop(const Params& P, const Ctx& C, int layer, int probe_pass) {
    constexpr int NHG = MODE == 0 ? HA : HB;
    constexpr int H0 = MODE == 0 ? 0 : (MODE == 1 ? HA : HA + HB);
    constexpr int NPU = PB * NHG * (PT / 256), NSU = SB * NHG;
    unsigned* counter = (unsigned*)(P.ws + WS_CTL) + CW_QUEUE + 64 * (layer * 3 + MODE + 8 * probe_pass);
    const bf16* qkv = (const bf16*)(P.ws + WS_QKV);
    for (;;) {
        const int i = pull(C.lds, counter, C.tid);
        if (i >= NPU + NSU) break;
        Unit u;
        if (i < NPU) {
            const int qb = (PT / 256 - 1) - i / (PB * NHG), bh = i % (PB * NHG), b = bh / NHG, hg = bh % NHG, hh = H0 + hg;
            const size_t row0 = (size_t)b * PT;
            u.q = qkv + (row0 + (size_t)qb * 256) * LDQ + hh * HD; u.nq = 256; u.qpos0 = qb * 256; u.kv_len = PT; u.new_pos0 = 0;
            u.kn = qkv + row0 * LDQ + D + hh * HD; u.vn = qkv + row0 * LDQ + 2 * D + hh * HD; u.kc = u.kn; u.vc = u.vn; u.cstride = LDQ;
            u.t_hi = 4 * qb + 3; u.t_lo = MODE == 0 ? (4 * qb - 8 > 0 ? 4 * qb - 8 : 0) : 0;
            u.F = (const float*)(P.ws + WS_FP) + row0 * HB + hg; u.fref = MODE == 1 ? u.F[(size_t)u.qpos0 * HB] : 0.f;
            u.rel = P.in[17] + (size_t)layer * 257 * HA + hh;
            u.kmax = 0.f;
            if (MODE == 1) {
                const float* kn2 = (const float*)(P.ws + WS_KN2) + ((size_t)layer * MP + row0) * HB + hg; float mx = 0.f;
                for (int t = C.tid; t < u.qpos0 + 256; t += 512) mx = fmaxf(mx, kn2[(size_t)t * HB]);
#pragma unroll
                for (int o = 1; o < 64; o <<= 1) mx = fmaxf(mx, __shfl_xor(mx, o));
                LAS float* red = (LAS float*)(C.lds + OFF_VOTE);
                if (C.lane == 0) red[C.wave] = mx;
                LDS_WAIT(); __syncthreads();
                mx = fmaxf(fmaxf(fmaxf(red[0], red[1]), fmaxf(red[2], red[3])), fmaxf(fmaxf(red[4], red[5]), fmaxf(red[6], red[7])));
                __syncthreads();
                u.kmax = sqrtf(mx) * 1.01f; }
        } else {
            const int s = i - NPU, sb = s / NHG, hg = s % NHG, hh = H0 + hg;
            constexpr int CL = MODE == 0 ? AWIN : PAST;
            const size_t row0 = (size_t)MP + (size_t)sb * ST;
            u.q = qkv + row0 * LDQ + hh * HD; u.nq = ST; u.qpos0 = CL; u.kv_len = CL + ST; u.new_pos0 = CL;
            u.kn = qkv + row0 * LDQ + D + hh * HD; u.vn = qkv + row0 * LDQ + 2 * D + hh * HD;
            const size_t coff = ((size_t)(layer * SB + sb) * CL * NHG + hg) * HD;
            u.kc = (const bf16*)(P.ws + (MODE == 0 ? WS_CAK : (MODE == 1 ? WS_CBK : WS_CCK))) + coff; u.vc = (const bf16*)(P.ws + (MODE == 0 ? WS_CAV : (MODE == 1 ? WS_CBV : WS_CCV))) + coff;
            u.cstride = NHG * HD;
            u.t_hi = (CL + ST - 1) >> 6; u.t_lo = 0;
            u.F = (const float*)(P.ws + WS_FS) + (size_t)sb * (PAST + ST) * HB + hg; u.fref = MODE == 1 ? u.F[(size_t)u.qpos0 * HB] : 0.f;
            u.rel = P.in[17] + (size_t)layer * 257 * HA + hh; u.kmax = __builtin_inff();
        }
        u.o = (bf16*)u.q; u.ostride = LDQ;
        if (probe_pass) { u.o = (bf16*)(P.ws + WS_H) + (u.q - qkv) / LDQ * LDH + (u.q - qkv) % LDQ; u.ostride = LDH; }
        if constexpr (MODE == 1) run_unit_b(C.lds, u, C.tid, C.wave, C.lane); else run_unit<MODE>(C.lds, u, C.tid, C.wave, C.lane);
    }
}
}


#ifndef PHASE_MASK
#define PHASE_MASK 0xFFF
#endif
#define PH(n) ((PHASE_MASK >> (n)) & 1)
#ifndef DUP_MASK
#define DUP_MASK 0
#endif
#define DUP(n) ((DUP_MASK >> (n)) & 1)
typedef const Params __attribute__((address_space(4)))* KParams;
__device__ __forceinline__ const Params& kparams() {
    KParams p = (KParams)__builtin_amdgcn_kernarg_segment_ptr(); asm volatile("" : "+s"(p)); return *(const Params*)p;
}
#define P (kparams())
__device__ __forceinline__ Ctx make_ctx(LAS unsigned char* lds) {
    Ctx C; int t = threadIdx.x; asm volatile("" : "+v"(t));
    C.lds = lds; C.tid = t; C.lane = t & 63; C.wave = __builtin_amdgcn_readfirstlane(t >> 6); C.G = gridDim.x; C.blk = blockIdx.x; return C;
}
__global__ void __launch_bounds__(512, 2) hse_fwd(Params P_unused) {
    extern __shared__ __attribute__((aligned(16))) unsigned char lds_raw[];
    LAS unsigned char* const lds = (LAS unsigned char*)lds_raw;
    volatile LAS unsigned* MISC = (volatile LAS unsigned*)(lds + MISC_OFF);
    if (threadIdx.x < 64) MISC[threadIdx.x] = 0u;
    __syncthreads();
    XcdBarrier bar = xcd_barrier_post((unsigned*)(P.ws + WS_CTL) + CW_BAR, MISC + 8);

    if (PH(0)) { const Params& Q = P; const Ctx C = make_ctx(lds); p0_prologue(Q, C); }
    xcd_barrier(bar);


#pragma unroll 1
    for (int layer = 0; layer < 2; ++layer) {
        if (DUP(1)) { const Params& Q = P; const Ctx C = make_ctx(lds); norm_phase<true>(Q, C, layer, layer == 0 ? Q.in[0] : Q.out + O_Y_P, nullptr, Q.in[13] + layer * D, 0, D, 0, nullptr, 0); }
        if (PH(1)) { const Params& Q = P; const Ctx C = make_ctx(lds); norm_phase<true>(Q, C, layer, layer == 0 ? Q.in[0] : Q.out + O_Y_P, layer == 0 ? Q.in[1] : Q.out + O_Y_S, Q.in[13] + layer * D, 0, D,
                                      layer == 0 ? 0 : DFF / 256, (const float*)(Q.ws + WS_MOD), 5 * D); }
        xcd_barrier(bar);
        if (PH(2)) { const Params& Q = P; const Ctx C = make_ctx(lds); fcum_phase(Q, C, layer); }
#ifdef PROBE_CLOCK
        if (layer == PROBE_CLOCK - 1 && blockIdx.x == 0 && threadIdx.x == 0) { const unsigned long long c = clock64(), t = wall_clock64(); MISC[16] = (unsigned)c; MISC[17] = (unsigned)(c >> 32); MISC[18] = (unsigned)t; MISC[19] = (unsigned)(t >> 32); }
#endif
        if (PH(3)) { const Params& Q = P; const Ctx C = make_ctx(lds); pg8::Gemm g{(const bf16*)(Q.ws + WS_H), (const bf16*)(Q.ws + WS_WIN + layer * SZ_WIN)}; pg8::StaticOrder<MP / 256, NQKV / 256> S; S.init(C.G, C.blk);
          pg8::EpiQKV E{(bf16*)(Q.ws + WS_QKV), Q.out, layer, (float*)(Q.ws + WS_KN2) + (size_t)layer * MP * HB};
          pg8::gemm_phase<pg8::EpiQKV, pg8::StaticOrder<MP / 256, NQKV / 256>, true, true, D, LDH, LDW>(C.lds + RING_OFF, g, S, E);
          if (DUP(3)) { __syncthreads(); pg8::gemm_phase<pg8::EpiQKV, pg8::StaticOrder<MP / 256, NQKV / 256>, true, true, D, LDH, LDW>(C.lds + RING_OFF, g, S, E); }
          pg8::SampleOrder<MP / 256, NQKV / 256, 8> SS; SS.init(C.G, C.blk); pg8::EpiPartial<NQKV> EP{(float*)(Q.ws + WS_PART)};
          pg8::gemm_phase<pg8::EpiPartial<NQKV>, pg8::SampleOrder<MP / 256, NQKV / 256, 8>, true, true, 256, LDH, LDW>(C.lds + RING_OFF, g, SS, EP); }
#ifdef PROBE_CLOCK
        if (layer == PROBE_CLOCK - 1 && blockIdx.x == 0 && threadIdx.x == 0) { const unsigned long long c = clock64(), t = wall_clock64();
            const unsigned long long c0 = ((unsigned long long)MISC[17] << 32) | MISC[16], t0 = ((unsigned long long)MISC[19] << 32) | MISC[18];
            MISC[20] = (unsigned)(((c - c0) * 100ull) / (t - t0)); }
#endif
        xcd_barrier(bar);
        if (PH(3)) { const Params& Q = P; const Ctx C = make_ctx(lds); finish_qkv(Q, C, layer); }
        xcd_barrier(bar);
#if DUP_MASK & 0x70
        if (DUP(4)) { const Params& Q = P; const Ctx C = make_ctx(lds); att::mode_loop<1>(Q, C, layer, 1); }
        if (DUP(5)) { const Params& Q = P; const Ctx C = make_ctx(lds); att::mode_loop<0>(Q, C, layer, 1); }
        if (DUP(6)) { const Params& Q = P; const Ctx C = make_ctx(lds); att::mode_loop<2>(Q, C, layer, 1); }
#endif
        if (PH(4)) { const Params& Q = P; const Ctx C = make_ctx(lds); att::mode_loop<1>(Q, C, layer, 0); }
        if (PH(5)) { const Params& Q = P; const Ctx C = make_ctx(lds); att::mode_loop<0>(Q, C, layer, 0); }
        if (PH(6)) { const Params& Q = P; const Ctx C = make_ctx(lds); att::mode_loop<2>(Q, C, layer, 0); }
        xcd_barrier(bar);
        if (PH(7)) { const Params& Q = P; const Ctx C = make_ctx(lds); pg8::Gemm g{(const bf16*)(Q.ws + WS_QKV), (const bf16*)(Q.ws + WS_WO + layer * SZ_WO)}; pg8::StaticOrder<MP / 256, D / 256> S; S.init(C.G, C.blk);
          pg8::EpiResid E{layer == 0 ? Q.in[0] : Q.out + O_Y_P, Q.out + O_Y_P, (const float*)(Q.ws + WS_MOD) + (size_t)layer * NMIDX * NMOD + 2 * D};
          pg8::gemm_phase<pg8::EpiResid, pg8::StaticOrder<MP / 256, D / 256>, true, true, D, LDQ, LDW>(C.lds + RING_OFF, g, S, E);
          pg8::SampleOrder<MP / 256, D / 256, 8> SS; SS.init(C.G, C.blk); pg8::EpiPartial<D> EP{(float*)(Q.ws + WS_PART)};
          pg8::gemm_phase<pg8::EpiPartial<D>, pg8::SampleOrder<MP / 256, D / 256, 8>, true, true, 256, LDQ, LDW>(C.lds + RING_OFF, g, SS, EP); }
        xcd_barrier(bar);
        if (PH(8)) { const Params& Q = P; const Ctx C = make_ctx(lds); norm_phase<false>(Q, C, layer, Q.out + O_Y_P, layer == 0 ? Q.in[1] : Q.out + O_Y_S, Q.in[14] + layer * D, 3 * D, 4 * D,
                                       D / 256, (const float*)(Q.ws + WS_MOD) + (size_t)layer * NMIDX * NMOD, 2 * D); }
        xcd_barrier(bar);
        if (PH(9)) { const Params& Q = P; const Ctx C = make_ctx(lds); pg8::Gemm g{(const bf16*)(Q.ws + WS_H), (const bf16*)(Q.ws + WS_WGU + layer * SZ_WGU)}; pg8::StaticOrder<MP / 256, 2 * DFF / 256> S; S.init(C.G, C.blk);
          pg8::EpiSwiGLU E{(bf16*)(Q.ws + WS_QKV)};
          pg8::gemm_phase<pg8::EpiSwiGLU, pg8::StaticOrder<MP / 256, 2 * DFF / 256>, true, true, D, LDH, LDW>(C.lds + RING_OFF, g, S, E);
          if (DUP(9)) { __syncthreads(); pg8::gemm_phase<pg8::EpiSwiGLU, pg8::StaticOrder<MP / 256, 2 * DFF / 256>, true, true, D, LDH, LDW>(C.lds + RING_OFF, g, S, E); }
          pg8::SampleOrder<MP / 256, 2 * DFF / 256, 4> SS; SS.init(C.G, C.blk); pg8::EpiPartial<2 * DFF> EP{(float*)(Q.ws + WS_PART)};
          pg8::gemm_phase<pg8::EpiPartial<2 * DFF>, pg8::SampleOrder<MP / 256, 2 * DFF / 256, 4>, true, true, 512, LDH, LDW>(C.lds + RING_OFF, g, SS, EP); }
        xcd_barrier(bar);
        if (PH(9)) { const Params& Q = P; const Ctx C = make_ctx(lds); finish_act(Q, C); }
        xcd_barrier(bar);
        if (PH(10)) { const Params& Q = P; const Ctx C = make_ctx(lds); pg8::Gemm g{(const bf16*)(Q.ws + WS_QKV), (const bf16*)(Q.ws + WS_WDN + layer * SZ_WDN)}; pg8::StaticOrder<MP / 256, D / 256> S; S.init(C.G, C.blk);
          pg8::EpiResid E{Q.out + O_Y_P, Q.out + O_Y_P, (const float*)(Q.ws + WS_MOD) + (size_t)layer * NMIDX * NMOD + 5 * D};
          pg8::gemm_phase<pg8::EpiResid, pg8::StaticOrder<MP / 256, D / 256>, true, true, DFF, LDACT, LDWD>(C.lds + RING_OFF, g, S, E);
          pg8::SampleOrder<MP / 256, D / 256, DFF / 256> SS; SS.init(C.G, C.blk); pg8::EpiPartial<D> EP{(float*)(Q.ws + WS_PART)};
          pg8::gemm_phase<pg8::EpiPartial<D>, pg8::SampleOrder<MP / 256, D / 256, DFF / 256>, true, true, 256, LDACT, LDWD>(C.lds + RING_OFF, g, SS, EP); }
        xcd_barrier(bar);
    }
    if (PH(11)) { const Params& Q = P; const Ctx C = make_ctx(lds); final_norm(Q, C); }
#ifdef PROBE_CLOCK
    if (blockIdx.x == 0 && threadIdx.x == 0) { const unsigned long long t0 = wall_clock64(), wait = (unsigned long long)MISC[20] * 100ull; while (wall_clock64() - t0 < wait) __builtin_amdgcn_s_sleep(8); }
#endif
}
#undef P

extern "C" void kernel_launch(void* const* d_in, const int* in_sizes, int n_in, void* d_out, int out_size, void* d_ws, size_t ws_size, hipStream_t stream) {
    static int grid = 0;
    if (grid == 0) {
        if (n_in != 23 || (size_t)out_size != O_END || ws_size < WS_END) {
            fprintf(stderr, "kernel_launch: unexpected shapes (n_in %d, out %d (want %zu), ws %zu (want >= %zu)); nothing launched\n", n_in, out_size, (size_t)O_END, ws_size, (size_t)WS_END); grid = -1; return; }
        int dev = 0, cus = 0, per_cu = 0;
        if (hipGetDevice(&dev) != hipSuccess || hipDeviceGetAttribute(&cus, hipDeviceAttributeMultiprocessorCount, dev) != hipSuccess) { grid = -1; return; }
        if (hipFuncSetAttribute((const void*)hse_fwd, hipFuncAttributeMaxDynamicSharedMemorySize, LDS_BYTES) != hipSuccess) { fprintf(stderr, "kernel_launch: hipFuncSetAttribute failed\n"); grid = -1; return; }
        if (hipOccupancyMaxActiveBlocksPerMultiprocessor(&per_cu, (const void*)hse_fwd, 512, LDS_BYTES) != hipSuccess || per_cu < 1) { fprintf(stderr, "kernel_launch: occupancy query says %d\n", per_cu); (void)hipGetLastError(); grid = -1; return; }
        grid = cus;
    }
    if (grid < 0) return;
    (void)in_sizes;
    if (hipMemsetAsync((char*)d_ws + WS_CTL, 0, CTL_ZERO_BYTES, stream) != hipSuccess) return;
    Params p{};
    for (int i = 0; i < 23; ++i) p.in[i] = (const float*)d_in[i];
    p.out = (float*)d_out; p.ws = (unsigned char*)d_ws;
    hipLaunchKernelGGL(hse_fwd, dim3(grid), dim3(512), LDS_BYTES, stream, p);
}
```

```cpp
#include <hip/hip_runtime.h>
#include <cstdio>
#include <cstdint>

#define LAS __attribute__((address_space(3)))
#define GAS __attribute__((address_space(1)))
typedef unsigned short bf16;
typedef short bf16x8 __attribute__((ext_vector_type(8)));
typedef float f32x4 __attribute__((ext_vector_type(4)));
typedef float f32x2 __attribute__((ext_vector_type(2)));
typedef float f32x16 __attribute__((ext_vector_type(16)));
typedef unsigned u32x4 __attribute__((ext_vector_type(4)));
typedef unsigned u32x2 __attribute__((ext_vector_type(2)));

constexpr int D = 2048, NH = 16, HD = 128, DFF = 5632, NQKV = 6144, NIN = 6150, NMOD = 6 * D;
constexpr int PB = 4, PT = 8192, SB = 8, ST = 32, PAST = 1024, AWIN = 512;
constexpr int HA = 4, HB = 6, HC = 6;
constexpr int MP = PB * PT, MS = SB * ST, MT = MP + MS;
#ifndef ROWPAD
#define ROWPAD 64
#endif
constexpr int LDQ = NQKV + ROWPAD, LDH = D + ROWPAD, LDACT = DFF + ROWPAD, LDW = D + ROWPAD, LDWD = DFF + ROWPAD;
constexpr float EPS = 1e-6f;
constexpr float ATT_SCALE = 0.08838834764831845f, INV_SCALE = 11.313708498984761f, LOG2E = 1.4426950408889634f, LN2 = 0.6931471805599453f;
constexpr int NMIDX = PB + SB;

constexpr size_t O_Y_P = 0;
constexpr size_t O_Y_S = O_Y_P + (size_t)MP * D;
constexpr size_t O_AK_P = O_Y_S + (size_t)MS * D;
constexpr size_t SZ_A_P = (size_t)2 * PB * AWIN * HA * HD, SZ_B_P = (size_t)2 * PB * PT * HB * HD, SZ_LF_P = (size_t)2 * PB * PT * HB;
constexpr size_t SZ_A_S = (size_t)2 * SB * ST * HA * HD, SZ_B_S = (size_t)2 * SB * ST * HB * HD, SZ_LF_S = (size_t)2 * SB * ST * HB;
constexpr size_t O_AV_P = O_AK_P + SZ_A_P, O_BK_P = O_AV_P + SZ_A_P, O_BV_P = O_BK_P + SZ_B_P, O_BLF_P = O_BV_P + SZ_B_P, O_CK_P = O_BLF_P + SZ_LF_P, O_CV_P = O_CK_P + SZ_B_P;
constexpr size_t O_AK_S = O_CV_P + SZ_B_P, O_AV_S = O_AK_S + SZ_A_S, O_BK_S = O_AV_S + SZ_A_S, O_BV_S = O_BK_S + SZ_B_S, O_BLF_S = O_BV_S + SZ_B_S, O_CK_S = O_BLF_S + SZ_LF_S, O_CV_S = O_CK_S + SZ_B_S;
constexpr size_t O_END = O_CV_S + SZ_B_S;

constexpr size_t MiB = 1u << 20;
constexpr size_t WS_CTL = 0, CTL_ZERO_BYTES = 6 * MiB;
constexpr size_t WS_MOD = 2 * MiB;
constexpr size_t SZ_WIN = (size_t)NQKV * LDW * 2, SZ_WO = (size_t)D * LDW * 2, SZ_WGU = (size_t)2 * DFF * LDW * 2, SZ_WDN = (size_t)D * LDWD * 2;
constexpr size_t WS_KN2 = 4 * MiB;
constexpr size_t WS_WIN = 6 * MiB, WS_WO = WS_WIN + 2 * SZ_WIN, WS_WGU = WS_WO + 2 * SZ_WO, WS_WDN = WS_WGU + 2 * SZ_WGU;
constexpr size_t WS_H = WS_WDN + 2 * SZ_WDN;
constexpr size_t WS_QKV = WS_H + (size_t)MT * LDH * 2;
constexpr size_t WS_CACHE = WS_QKV + (size_t)MT * LDQ * 2;
constexpr size_t SZ_CA = (size_t)2 * SB * AWIN * HA * HD * 2, SZ_CB = (size_t)2 * SB * PAST * HB * HD * 2;
constexpr size_t WS_CAK = WS_CACHE, WS_CAV = WS_CAK + SZ_CA, WS_CBK = WS_CAV + SZ_CA, WS_CBV = WS_CBK + SZ_CB, WS_CCK = WS_CBV + SZ_CB, WS_CCV = WS_CCK + SZ_CB;
constexpr size_t WS_FP = WS_CCV + SZ_CB;
constexpr size_t WS_FS = WS_FP + (size_t)PB * PT * HB * 4;
constexpr size_t WS_PART = (WS_FS + (size_t)SB * (PAST + ST) * HB * 4 + 4095) / 4096 * 4096;
constexpr size_t WS_END = WS_PART + (size_t)8 * MS * NQKV * 4 + 4096;
static_assert((size_t)4 * MS * 2 * DFF * 4 <= (size_t)8 * MS * NQKV * 4 && (size_t)22 * MS * D * 4 <= (size_t)8 * MS * NQKV * 4, "partials buffer");
static_assert((size_t)MT * LDACT * 2 <= (size_t)MT * LDQ * 2, "ACT overlays QKV");
constexpr int CW_TMO = 0, CW_BAR = 4096, CW_QUEUE = 16384;

constexpr int RING_OFF = 0, RING_BYTES = 131072;
constexpr int MISC_OFF = RING_BYTES;
constexpr int LDS_BYTES = 147456;

#define LDS_WAIT() asm volatile("s_waitcnt lgkmcnt(0)" ::: "memory")
#define VM_WAIT() asm volatile("s_waitcnt vmcnt(0)" ::: "memory")
__device__ __forceinline__ unsigned cvt_pk_bf16(float lo, float hi) { unsigned r; asm volatile("v_cvt_pk_bf16_f32 %0, %1, %2" : "=v"(r) : "v"(lo), "v"(hi)); return r; }
__device__ __forceinline__ float fast_exp2(float x) { return __builtin_amdgcn_exp2f(x); }
__device__ __forceinline__ float fast_log2(float x) { return __builtin_amdgcn_logf(x); }
__device__ __forceinline__ float fast_rcp(float x) { return __builtin_amdgcn_rcpf(x); }
template <int CTRL, int ROWMASK> __device__ __forceinline__ float dpp_take(float v) {
    return __builtin_bit_cast(float, __builtin_amdgcn_update_dpp(0, __builtin_bit_cast(int, v), CTRL, ROWMASK, 0xf, false));
}
__device__ __forceinline__ float wave_sum(float v) {
    v += dpp_take<0x111, 0xf>(v); v += dpp_take<0x112, 0xf>(v); v += dpp_take<0x114, 0xf>(v); v += dpp_take<0x118, 0xf>(v);
    v += dpp_take<0x142, 0xa>(v); v += dpp_take<0x143, 0xc>(v);
    return __builtin_bit_cast(float, __builtin_amdgcn_readlane(__builtin_bit_cast(int, v), 63));
}
namespace pg8 {
#define PG8_LAS __attribute__((address_space(3)))
typedef unsigned short bf16_t;
typedef short bf16x8 __attribute__((ext_vector_type(8)));
typedef float f32x4 __attribute__((ext_vector_type(4)));
typedef unsigned u32x4 __attribute__((ext_vector_type(4)));
constexpr int BM = 256, BK = 64, HALF = 128, HTB = HALF * BK * 2  , STAGE_BYTES = 8 * HTB, NXCD = 8, WGM = 8;

__host__ __device__ __forceinline__ int lds_byte(int r, int c) { const int st = (r >> 4) * 2 + (c >> 5), rr = r & 15, cc = c & 31, ob = rr * 64 + cc * 2; return st * 1024 + (ob ^ (((ob >> 9) & 1) << 5)); }
__host__ __device__ __forceinline__ void stage_rc(int b, int& R, int& C) { const int st = b / 1024, sb = b % 1024, swz = sb ^ (((sb >> 9) & 1) << 5); R = (st >> 1) * 16 + swz / 64; C = (st & 1) * 32 + (swz % 64) / 2; }
__host__ __device__ __forceinline__ int perm32(int rho) { const int n = rho >> 4, i = rho & 15; return 8 * (i >> 2) + 4 * n + (i & 3); }

struct Unit { int pm, pn, kc; };
struct Gemm { const bf16_t* A; const bf16_t* Bt; };

template <int NM, int NN> struct StaticOrder {
    int G, c;
    __host__ __device__ void init(int G_, int c_) { G = G_; c = c_; }
    __host__ __device__ bool next(int i, Unit& u) const {
        constexpr int nM = NM, nN = NN, nwg = NM * NN;
        const int L = i * G + c; if (L >= nwg) return false;
        int wgid = L; { constexpr int q = nwg / NXCD, r = nwg % NXCD; const int xcd = wgid % NXCD, off = wgid / NXCD; wgid = (xcd < r ? xcd * (q + 1) : r * (q + 1) + (xcd - r) * q) + off; }
        constexpr int nig = WGM * nN; const int gid = wgid / nig, fm = gid * WGM, gsz = (nM - fm) < WGM ? (nM - fm) : WGM;
        u.pm = fm + ((wgid % nig) % gsz); u.pn = (wgid % nig) / gsz; u.kc = 0; return true;
    }
    __device__ __forceinline__ void a_ready(const Unit&) const {}
    __device__ __forceinline__ void done(const Unit&) const {}
};

__device__ __forceinline__ unsigned cvt_pk_bf16(float lo, float hi) { unsigned r; asm volatile("v_cvt_pk_bf16_f32 %0, %1, %2" : "=v"(r) : "v"(lo), "v"(hi)); return r; }

struct EpiQKV {
    static constexpr bool PERM = true, AFTER_DRAIN = false, PROBE_DUP = true;
    bf16_t* QKV; float* out; int layer; float* kn2;
    __device__ __forceinline__ void operator()(const f32x4 (&acc)[2][2][4][2], const Unit& u, int wr, int wc, int fr, int fq) const {
        const int which = u.pn >> 3;
        const int rl0 = wr * 64 + fr;
        const int d0 = wc * 32 + 8 * fq;
        bf16_t* qbase = QKV + (size_t)(u.pm * BM + rl0) * ::LDQ + u.pn * BM + d0;
        float* fb[2]; int rstride[2]; bool en[2];
#pragma unroll
        for (int bj = 0; bj < 2; ++bj) {
            const int hh = (u.pn & 7) * 2 + bj;
            en[bj] = which != 0; fb[bj] = out; rstride[bj] = 0;
            if (which != 0) {
                const bool isv = which == 2;
                {
                    const int b = u.pm >> 5, t0 = (u.pm & 31) * 256;
                    if (hh < ::HA) { en[bj] = t0 >= ::PT - ::AWIN; rstride[bj] = ::HA * ::HD;
                        fb[bj] = out + (isv ? ::O_AV_P : ::O_AK_P) + ((size_t)((layer * ::PB + b) * ::AWIN + (t0 - (::PT - ::AWIN))) * ::HA + hh) * ::HD; }
                    else { const int hg = hh < ::HA + ::HB ? hh - ::HA : hh - ::HA - ::HB; rstride[bj] = ::HB * ::HD;
                        const size_t ob = hh < ::HA + ::HB ? (isv ? ::O_BV_P : ::O_BK_P) : (isv ? ::O_CV_P : ::O_CK_P);
                        fb[bj] = out + ob + ((size_t)((layer * ::PB + b) * ::PT + t0) * ::HB + hg) * ::HD; }
                }
            }
        }
#pragma unroll
        for (int ai = 0; ai < 2; ++ai)
#pragma unroll
            for (int m = 0; m < 4; ++m) { const int rl = rl0 + ai * HALF + m * 16; bf16_t* rowp = qbase + (size_t)(ai * HALF + m * 16) * ::LDQ;
#pragma unroll
                for (int bj = 0; bj < 2; ++bj) { const f32x4 v0 = acc[ai][bj][m][0], v1 = acc[ai][bj][m][1];
                    u32x4 w; w.x = cvt_pk_bf16(v0[0], v0[1]); w.y = cvt_pk_bf16(v0[2], v0[3]); w.z = cvt_pk_bf16(v1[0], v1[1]); w.w = cvt_pk_bf16(v1[2], v1[3]);
                    *(u32x4*)(rowp + bj * HALF) = w;
                    if (en[bj]) { float* fp = fb[bj] + (size_t)rl * rstride[bj] + d0; *(f32x4*)fp = v0; *(f32x4*)(fp + 4) = v1; }
                    if (which == 1) { const int hh = (u.pn & 7) * 2 + bj;
                        if (hh >= ::HA && hh < ::HA + ::HB) {
                            float s = (v0[0] * v0[0] + v0[1] * v0[1]) + (v0[2] * v0[2] + v0[3] * v0[3]) + (v1[0] * v1[0] + v1[1] * v1[1]) + (v1[2] * v1[2] + v1[3] * v1[3]);
                            s += __shfl_xor(s, 16); s += __shfl_xor(s, 32);
                            if (fq == 0) __hip_atomic_fetch_add(kn2 + (size_t)(u.pm * BM + rl) * ::HB + (hh - ::HA), s, __ATOMIC_RELAXED, __HIP_MEMORY_SCOPE_AGENT); } } } }
    }
};
struct EpiResid {
    static constexpr bool PERM = false, AFTER_DRAIN = false, PROBE_DUP = false;
    const float* xin_p; float* xout_p; const float* gate;
    __device__ __forceinline__ void operator()(const f32x4 (&acc)[2][2][4][2], const Unit& u, int wr, int wc, int fr, int fq) const {
        const float* xi = xin_p + (size_t)u.pm * BM * ::D; float* xo = xout_p + (size_t)u.pm * BM * ::D;
        const int col0 = u.pn * BM + wc * 32 + 4 * fq; const float* gp = gate + (size_t)(u.pm >> 5) * ::NMOD + col0;
        f32x4 gv[2][2];
#pragma unroll
        for (int bj = 0; bj < 2; ++bj)
#pragma unroll
            for (int n = 0; n < 2; ++n) gv[bj][n] = *(const f32x4*)(gp + bj * HALF + n * 16);
        f32x4 x0[2][2], x1[2][2], x2[2][2];
#define PG8_RLOAD(X, g_) do { const size_t off_ = (size_t)(((g_) >> 2) * HALF + wr * 64 + ((g_) & 3) * 16 + fr) * ::D + col0; \
            _Pragma("unroll") for (int bj = 0; bj < 2; ++bj) _Pragma("unroll") for (int n = 0; n < 2; ++n) X[bj][n] = *(const f32x4*)(xi + off_ + bj * HALF + n * 16); } while (0)
#define PG8_RSTORE(X, g_) do { const size_t off_ = (size_t)(((g_) >> 2) * HALF + wr * 64 + ((g_) & 3) * 16 + fr) * ::D + col0; \
            _Pragma("unroll") for (int bj = 0; bj < 2; ++bj) _Pragma("unroll") for (int n = 0; n < 2; ++n) *(f32x4*)(xo + off_ + bj * HALF + n * 16) = X[bj][n] + gv[bj][n] * acc[(g_) >> 2][bj][(g_) & 3][n]; } while (0)
#define PG8_FENCE asm volatile("" ::: "memory")
        PG8_RLOAD(x0, 0); PG8_RLOAD(x1, 1);
        PG8_RLOAD(x2, 2); PG8_FENCE; PG8_RSTORE(x0, 0); PG8_FENCE;
        PG8_RLOAD(x0, 3); PG8_FENCE; PG8_RSTORE(x1, 1); PG8_FENCE;
        PG8_RLOAD(x1, 4); PG8_FENCE; PG8_RSTORE(x2, 2); PG8_FENCE;
        PG8_RLOAD(x2, 5); PG8_FENCE; PG8_RSTORE(x0, 3); PG8_FENCE;
        PG8_RLOAD(x0, 6); PG8_FENCE; PG8_RSTORE(x1, 4); PG8_FENCE;
        PG8_RLOAD(x1, 7); PG8_FENCE; PG8_RSTORE(x2, 5); PG8_FENCE;
        PG8_RSTORE(x0, 6); PG8_RSTORE(x1, 7);
#undef PG8_FENCE
#undef PG8_RLOAD
#undef PG8_RSTORE
    }
};
struct EpiSwiGLU {
    static constexpr bool PERM = true, AFTER_DRAIN = false, PROBE_DUP = false;
    bf16_t* ACT;
    __device__ __forceinline__ void operator()(const f32x4 (&acc)[2][2][4][2], const Unit& u, int wr, int wc, int fr, int fq) const {
        bf16_t* base = ACT + (size_t)(u.pm * BM + wr * 64 + fr) * ::LDACT + u.pn * HALF + wc * 32 + 8 * fq;
#pragma unroll
        for (int ai = 0; ai < 2; ++ai)
#pragma unroll
            for (int m = 0; m < 4; ++m) { float r[8];
#pragma unroll
                for (int n = 0; n < 2; ++n)
#pragma unroll
                    for (int j = 0; j < 4; ++j) { const float g = acc[ai][0][m][n][j], up = acc[ai][1][m][n][j];
                        r[4 * n + j] = g * __builtin_amdgcn_rcpf(1.0f + __builtin_amdgcn_exp2f(-g * ::LOG2E)) * up; }
                u32x4 w; w.x = cvt_pk_bf16(r[0], r[1]); w.y = cvt_pk_bf16(r[2], r[3]); w.z = cvt_pk_bf16(r[4], r[5]); w.w = cvt_pk_bf16(r[6], r[7]);
                *(u32x4*)(base + (size_t)(ai * HALF + m * 16) * ::LDACT) = w; }
    }
};


template <int PM, int NN, int NKC> struct SampleOrder {
    int G, c;
    __host__ __device__ void init(int G_, int c_) { G = G_; c = c_; }
    __host__ __device__ bool next(int i, Unit& u) const { const int L = i * G + c; if (L >= NN * NKC) return false; u.pm = PM; u.pn = L % NN; u.kc = L / NN; return true; }
    __device__ __forceinline__ void a_ready(const Unit&) const {}
    __device__ __forceinline__ void done(const Unit&) const {}
};
template <int N> struct EpiPartial {
    static constexpr bool PERM = false, AFTER_DRAIN = false, PROBE_DUP = false;
    float* part;
    __device__ __forceinline__ void operator()(const f32x4 (&acc)[2][2][4][2], const Unit& u, int wr, int wc, int fr, int fq) const {
        float* base = part + ((size_t)u.kc * BM + wr * 64 + fr) * N + u.pn * BM + wc * 32 + 4 * fq;
#pragma unroll
        for (int ai = 0; ai < 2; ++ai)
#pragma unroll
            for (int m = 0; m < 4; ++m) { float* rowp = base + (size_t)(ai * HALF + m * 16) * N;
#pragma unroll
                for (int bj = 0; bj < 2; ++bj)
#pragma unroll
                    for (int n = 0; n < 2; ++n) *(f32x4*)(rowp + bj * HALF + n * 16) = acc[ai][bj][m][n]; }
    }
};


template <class Epi, class Sched, bool ALIGN_EPI, bool SP2, int KK, int LDA, int LDB = KK>
__device__ __forceinline__ void gemm_phase(PG8_LAS unsigned char* lds, const Gemm g, const Sched& S, const Epi& E) {
    int tid = threadIdx.x; asm volatile("" : "+v"(tid));
    const int wid = __builtin_amdgcn_readfirstlane(tid >> 6), lane = tid & 63, wr = wid >> 2, wc = wid & 3, fr = lane & 15, fq = lane >> 4;
    constexpr int K = KK, nt = K / BK, lda = LDA, ldb = LDB;
    unsigned voffA[2], voffB[2];
#pragma unroll
    for (int i = 0; i < 2; ++i) { int R, C; stage_rc(tid * 16 + i * 8192, R, C); const int Rb = Epi::PERM ? ((R & ~31) + perm32(R & 31)) : R;
        voffA[i] = (unsigned)(R * lda + C) * 2u; voffB[i] = (unsigned)(Rb * ldb + C) * 2u; }
    constexpr size_t kstep = (size_t)(BK * 2);
    constexpr size_t hstepA = (size_t)HALF * lda * 2, hstepB = (size_t)HALF * ldb * 2;
    constexpr size_t tstepA = 2 * hstepA, tstepB = 2 * hstepB;
    const unsigned ldsw = (unsigned)wid * 1024u;
    const int aoff = lds_byte(wr * 64 + fr, fq * 8), boff = lds_byte(wc * 32 + fr, fq * 8);
#define PG8_SA(b, h) (((b) * 2 + (h)) * HTB)
#define PG8_SB(b, h) ((4 + (b) * 2 + (h)) * HTB)
#define PG8_STAGE(bufoff, gbase, voff) do { _Pragma("unroll") for (int _i = 0; _i < 2; ++_i) \
        __builtin_amdgcn_global_load_lds((const unsigned*)((const char*)(gbase) + (voff)[_i]), (PG8_LAS unsigned*)(lds + (bufoff) + ldsw + _i * 8192), 16, 0, 0); } while (0)
#define PG8_LDA(dst, b, h) do { _Pragma("unroll") for (int m = 0; m < 4; ++m) _Pragma("unroll") for (int k = 0; k < 2; ++k) dst[m][k] = *(const PG8_LAS bf16x8*)(lds + PG8_SA(b, h) + aoff + m * 2048 + k * 1024); } while (0)
#define PG8_LDB(dst, b, h) do { _Pragma("unroll") for (int n = 0; n < 2; ++n) _Pragma("unroll") for (int k = 0; k < 2; ++k) dst[n][k] = *(const PG8_LAS bf16x8*)(lds + PG8_SB(b, h) + boff + n * 2048 + k * 1024); } while (0)
#define PG8_MMA(ai, bj, At, Bt) do { __builtin_amdgcn_s_setprio(1); _Pragma("unroll") for (int m = 0; m < 4; ++m) _Pragma("unroll") for (int n = 0; n < 2; ++n) _Pragma("unroll") for (int k = 0; k < 2; ++k) \
        acc[ai][bj][m][n] = __builtin_amdgcn_mfma_f32_16x16x32_bf16(Bt[n][k], At[m][k], acc[ai][bj][m][n], 0, 0, 0); __builtin_amdgcn_s_setprio(0); } while (0)
#define PG8_WAIT_V(n) asm volatile("s_waitcnt vmcnt(" #n ")" ::: "memory")
#define PG8_WAIT_L(n) asm volatile("s_waitcnt lgkmcnt(" #n ")" ::: "memory")
#define PG8_BAR __builtin_amdgcn_s_barrier()
#define PG8_SCHED __builtin_amdgcn_sched_barrier(0)
    Unit cur, nxt; int ui = 0;
    if (!S.next(0, cur)) return;
    f32x4 acc[2][2][4][2];
#pragma unroll
    for (int a = 0; a < 2; ++a)
#pragma unroll
        for (int b = 0; b < 2; ++b)
#pragma unroll
            for (int m = 0; m < 4; ++m)
#pragma unroll
                for (int n = 0; n < 2; ++n) acc[a][b][m][n] = (f32x4){0.f, 0.f, 0.f, 0.f};
    bf16x8 At[4][2], B0[2][2], B1[2][2];
    const char* cA = (const char*)g.A + (size_t)cur.pm * tstepA + (size_t)cur.kc * (K * 2); const char* cB = (const char*)g.Bt + (size_t)cur.pn * tstepB + (size_t)cur.kc * (K * 2);
    S.a_ready(cur);
    if constexpr (SP2) {
        PG8_STAGE(PG8_SB(0, 0), cB, voffB); PG8_STAGE(PG8_SB(0, 1), cB + hstepB, voffB); PG8_STAGE(PG8_SA(0, 0), cA, voffA); PG8_STAGE(PG8_SA(0, 1), cA + hstepA, voffA);
        if (wr == 1) PG8_BAR;
        PG8_WAIT_V(2); PG8_BAR;
        PG8_STAGE(PG8_SB(1, 0), cB + kstep, voffB); PG8_STAGE(PG8_SA(1, 0), cA + kstep, voffA); PG8_STAGE(PG8_SB(1, 1), cB + hstepB + kstep, voffB);
        PG8_WAIT_V(6); PG8_BAR;
    } else {
        PG8_STAGE(PG8_SB(0, 0), cB, voffB); PG8_STAGE(PG8_SA(0, 0), cA, voffA); PG8_STAGE(PG8_SB(0, 1), cB + hstepB, voffB); PG8_STAGE(PG8_SA(0, 1), cA + hstepA, voffA);
        if (wr == 1) PG8_BAR;
        PG8_WAIT_V(4); PG8_BAR;
        PG8_STAGE(PG8_SB(1, 0), cB + kstep, voffB); PG8_STAGE(PG8_SA(1, 0), cA + kstep, voffA); PG8_STAGE(PG8_SB(1, 1), cB + hstepB + kstep, voffB);
        PG8_WAIT_V(6); PG8_BAR;
    }
    for (;;) {
        const bool has_next = S.next(ui + 1, nxt);
        const char* nA = has_next ? (const char*)g.A + (size_t)nxt.pm * tstepA + (size_t)nxt.kc * (K * 2) : cA; const char* nB = has_next ? (const char*)g.Bt + (size_t)nxt.pn * tstepB + (size_t)nxt.kc * (K * 2) : cB;
#pragma unroll 1
        for (int t = 0; t < nt; t += 2) {
            const bool last = (t == nt - 2);
            const char* a1 = cA + (size_t)(t + 1) * kstep;
            const char* a2 = last ? nA : cA + (size_t)(t + 2) * kstep; const char* b2 = last ? nB : cB + (size_t)(t + 2) * kstep;
            const char* a3 = a2 + kstep; const char* b3 = b2 + kstep;
            if (last && has_next) S.a_ready(nxt);
            if constexpr (SP2) {
            PG8_LDB(B0, 0, 0); PG8_LDB(B1, 0, 1); PG8_SCHED; PG8_LDA(At, 0, 0); PG8_STAGE(PG8_SA(1, 1), a1 + hstepA, voffA);
            PG8_WAIT_V(8); PG8_WAIT_L(0); PG8_BAR; PG8_MMA(0, 0, At, B0); PG8_MMA(0, 1, At, B1); PG8_BAR; PG8_SCHED;
            PG8_LDA(At, 0, 1); PG8_STAGE(PG8_SB(0, 0), b2, voffB); PG8_STAGE(PG8_SB(0, 1), b2 + hstepB, voffB); PG8_STAGE(PG8_SA(0, 0), a2, voffA);
            PG8_WAIT_V(8); PG8_WAIT_L(0); PG8_BAR; PG8_MMA(1, 0, At, B0); PG8_MMA(1, 1, At, B1); PG8_BAR; PG8_SCHED;
            PG8_LDB(B0, 1, 0); PG8_LDB(B1, 1, 1); PG8_SCHED; PG8_LDA(At, 1, 0); PG8_STAGE(PG8_SA(0, 1), a2 + hstepA, voffA);
            PG8_WAIT_V(8); PG8_WAIT_L(0); PG8_BAR; PG8_MMA(0, 0, At, B0); PG8_MMA(0, 1, At, B1); PG8_BAR; PG8_SCHED;
            PG8_LDA(At, 1, 1); PG8_STAGE(PG8_SB(1, 0), b3, voffB); PG8_STAGE(PG8_SB(1, 1), b3 + hstepB, voffB); PG8_STAGE(PG8_SA(1, 0), a3, voffA);
            PG8_WAIT_V(8); PG8_WAIT_L(0); PG8_BAR; PG8_MMA(1, 0, At, B0); PG8_MMA(1, 1, At, B1); PG8_BAR; PG8_SCHED;
            } else {
            PG8_LDB(B0, 0, 0); PG8_SCHED; PG8_LDA(At, 0, 0); PG8_STAGE(PG8_SA(1, 1), a1 + hstepA, voffA);
            PG8_WAIT_L(8); PG8_BAR; PG8_WAIT_L(0); PG8_MMA(0, 0, At, B0); PG8_BAR; PG8_SCHED;
            PG8_LDB(B1, 0, 1); PG8_STAGE(PG8_SB(0, 0), b2, voffB);
            PG8_BAR; PG8_WAIT_L(0); PG8_MMA(0, 1, At, B1); PG8_BAR;
            PG8_LDA(At, 0, 1); PG8_STAGE(PG8_SA(0, 0), a2, voffA);
            PG8_BAR; PG8_WAIT_L(0); PG8_MMA(1, 0, At, B0); PG8_BAR; PG8_SCHED;
            PG8_STAGE(PG8_SB(0, 1), b2 + hstepB, voffB);
            PG8_WAIT_V(6); PG8_BAR; PG8_MMA(1, 1, At, B1); PG8_BAR;
            PG8_LDB(B0, 1, 0); PG8_SCHED; PG8_LDA(At, 1, 0); PG8_STAGE(PG8_SA(0, 1), a2 + hstepA, voffA);
            PG8_WAIT_L(8); PG8_BAR; PG8_WAIT_L(0); PG8_MMA(0, 0, At, B0); PG8_BAR; PG8_SCHED;
            PG8_LDB(B1, 1, 1); PG8_STAGE(PG8_SB(1, 0), b3, voffB);
            PG8_BAR; PG8_WAIT_L(0); PG8_MMA(0, 1, At, B1); PG8_BAR;
            PG8_LDA(At, 1, 1); PG8_STAGE(PG8_SA(1, 0), a3, voffA);
            PG8_BAR; PG8_WAIT_L(0); PG8_MMA(1, 0, At, B0); PG8_BAR; PG8_SCHED;
            PG8_STAGE(PG8_SB(1, 1), b3 + hstepB, voffB);
            PG8_WAIT_V(6); PG8_BAR; PG8_MMA(1, 1, At, B1); PG8_BAR;
            }
        }
        if constexpr (ALIGN_EPI) { if (wr == 0) PG8_BAR; }
        if constexpr (!Epi::AFTER_DRAIN) { E(acc, cur, wr, wc, fr, fq);
#ifdef PROBE_EPI_DUP
            if constexpr (Epi::PROBE_DUP) { asm volatile("" ::: "memory"); E(acc, cur, wr, wc, fr, fq); }
#endif
            S.done(cur); }
        if (!has_next) break;
#pragma unroll
        for (int a = 0; a < 2; ++a)
#pragma unroll
            for (int b = 0; b < 2; ++b)
#pragma unroll
                for (int m = 0; m < 4; ++m)
#pragma unroll
                    for (int n = 0; n < 2; ++n) acc[a][b][m][n] = (f32x4){0.f, 0.f, 0.f, 0.f};
        cur = nxt; cA = nA; cB = nB; ++ui;
        if constexpr (ALIGN_EPI) { if (wr == 1) PG8_BAR; }
    }
    PG8_WAIT_V(0);
    if constexpr (!ALIGN_EPI) { if (wr == 0) PG8_BAR; }
    PG8_BAR;
    if constexpr (Epi::AFTER_DRAIN) { E.fused(acc, cur, wr, wc, fr, fq, lds, wid, lane); S.done(cur); }
#undef PG8_SA
#undef PG8_SB
#undef PG8_STAGE
#undef PG8_LDA
#undef PG8_LDB
#undef PG8_MMA
#undef PG8_WAIT_V
#undef PG8_WAIT_L
#undef PG8_BAR
#undef PG8_SCHED
}
}

#define XB_TMO      128
#define XB_XCNT(j)  (256  + 64 * (j))
#define XB_XSUB(j)  (1280 + 64 * (j))
#define XB_XGEN(j)  (2304 + 64 * (j))
#define XB_TOP      3328
#define XB_TOPGEN   3392
#define XCD_BAR_WORDS 3456
#define XB_SPIN_CAP (1u << 18)

__device__ __forceinline__ unsigned xb_ld(unsigned* p)              { return __hip_atomic_load(p, __ATOMIC_RELAXED, __HIP_MEMORY_SCOPE_AGENT); }
__device__ __forceinline__ unsigned xb_add(unsigned* p, unsigned v) { return __hip_atomic_fetch_add(p, v, __ATOMIC_RELAXED, __HIP_MEMORY_SCOPE_AGENT); }
__device__ __forceinline__ unsigned xb_xcc_id() { return (unsigned)__builtin_amdgcn_s_getreg((3 << 11) | 20) & 0xFu; }
#define XB_SPIN(cond, bar) do { unsigned _sp = 0; while (cond) { __builtin_amdgcn_s_sleep(1); \
    if ((++_sp & 255u) == 0u) { if (xb_ld(&(bar)[XB_TMO])) break; if (_sp > XB_SPIN_CAP) { atomicAdd(&(bar)[XB_TMO], 1u); break; } } } } while (0)

struct XcdBarrier {
    unsigned* bar; unsigned x;
    volatile LAS unsigned* st;
};

__device__ __forceinline__ XcdBarrier xcd_barrier_post(unsigned* bar, volatile LAS unsigned* st) {
    XcdBarrier b; b.bar = bar; b.x = xb_xcc_id(); b.st = st;
    if (threadIdx.x == 0) (void)xb_add(&bar[XB_XCNT(b.x)], 1u);
    return b;
}
__device__ __forceinline__ void xcd_barrier_complete(unsigned* bar, unsigned x, unsigned& nloc, unsigned& nx) {
    const unsigned G = gridDim.x * gridDim.y * gridDim.z;
    unsigned sum, cnt, mine, sp = 0u;
    for (;;) {
        sum = 0u; cnt = 0u; mine = 0u;
#pragma unroll
        for (unsigned j = 0; j < 16; ++j) { const unsigned c = xb_ld(&bar[XB_XCNT(j)]); sum += c; cnt += (c > 0u) ? 1u : 0u; mine = (j == x) ? c : mine; }
        if (sum == G) break;
        __builtin_amdgcn_s_sleep(1);
        if ((++sp & 255u) == 0u) { if (xb_ld(&bar[XB_TMO])) break; if (sp > XB_SPIN_CAP) { atomicAdd(&bar[XB_TMO], 1u); break; } }
    }
    nloc = mine > 0u ? mine : 1u; nx = cnt > 0u ? cnt : 1u;
}

__device__ __forceinline__ void xcd_barrier(const XcdBarrier& b) {
    asm volatile("s_waitcnt vmcnt(0)" ::: "memory");
    __syncthreads();
    if (threadIdx.x == 0) {
        unsigned* bar = b.bar; asm volatile("" : "+s"(bar));
        __builtin_amdgcn_s_waitcnt(0);
        unsigned nloc = b.st[0], nx = b.st[1];
        unsigned bx = b.x; asm volatile("" : "+s"(bx));
        if (nloc == 0u) { xcd_barrier_complete(bar, bx, nloc, nx); b.st[0] = nloc; b.st[1] = nx; }
        const unsigned old = xb_add(&bar[XB_XSUB(bx)], 1u);
        const unsigned gen = old / nloc;
        if (old + 1u == (gen + 1u) * nloc) {
            __builtin_amdgcn_fence(__ATOMIC_RELEASE, "agent");
            asm volatile("s_waitcnt vmcnt(0)" ::: "memory");
            const unsigned og = xb_add(&bar[XB_TOP], 1u);
            const unsigned tg = og / nx;
            if (og + 1u == (tg + 1u) * nx) xb_add(&bar[XB_TOPGEN], 1u);
            else XB_SPIN(xb_ld(&bar[XB_TOPGEN]) == tg, bar);
            __builtin_amdgcn_fence(__ATOMIC_ACQUIRE, "agent");
            xb_add(&bar[XB_XGEN(bx)], 1u);
            asm volatile("s_waitcnt vmcnt(0)" ::: "memory");
        } else {
            XB_SPIN(xb_ld(&bar[XB_XGEN(bx)]) == gen, bar);
            __builtin_amdgcn_fence(__ATOMIC_ACQUIRE, "agent");
            asm volatile("s_waitcnt vmcnt(0)" ::: "memory");
        }
    }
    __syncthreads();
}
struct Params {
    const float* in[23];
    float* out;
    unsigned char* ws;
};

struct Ctx {
    LAS unsigned char* lds;
    int tid, lane, wave, G, blk;
};

__device__ __forceinline__ void transpose_item(const float* W, int ld, bf16* WT, int Kd, int k0, int n0, int drow0, LAS float* scr, int lane) {
#pragma unroll 8
    for (int i = 0; i < 32; ++i) { const int kk = 2 * i + (lane >> 5); scr[kk * 33 + (lane & 31)] = W[(size_t)(k0 + kk) * ld + n0 + (lane & 31)]; }
    LDS_WAIT(); asm volatile("" ::: "memory");
    const int c = lane & 7;
#pragma unroll
    for (int j = 0; j < 4; ++j) { const int n = (lane >> 3) + 8 * j; const LAS float* s = scr + (8 * c) * 33 + n;
        u32x4 o; o.x = cvt_pk_bf16(s[0 * 33], s[1 * 33]); o.y = cvt_pk_bf16(s[2 * 33], s[3 * 33]); o.z = cvt_pk_bf16(s[4 * 33], s[5 * 33]); o.w = cvt_pk_bf16(s[6 * 33], s[7 * 33]);
        *(u32x4*)(WT + (size_t)(drow0 + n) * Kd + k0 + 8 * c) = o; }
    LDS_WAIT(); asm volatile("" ::: "memory");
}

__device__ __forceinline__ void cvt_copy(const float* src, bf16* dst, size_t n8, size_t i0, size_t stride) {
    for (size_t i = i0; i < n8; i += stride) { const f32x4 a = *(const f32x4*)(src + i * 8), b = *(const f32x4*)(src + i * 8 + 4);
        u32x4 o; o.x = cvt_pk_bf16(a[0], a[1]); o.y = cvt_pk_bf16(a[2], a[3]); o.z = cvt_pk_bf16(b[0], b[1]); o.w = cvt_pk_bf16(b[2], b[3]);
        *(u32x4*)(dst + i * 8) = o; }
}

__device__ __forceinline__ void p0_prologue(const Params& P, const Ctx& C) {
    unsigned char* ws = P.ws;
    {
        LAS float* scr = (LAS float*)(C.lds + RING_OFF + C.wave * 16384);
        const int gw = C.blk * 8 + C.wave, NGW = C.G * 8;
        constexpr int I_IN = (D / 64) * (NQKV / 32), I_O = (D / 64) * (D / 32), I_G = (D / 64) * (DFF / 32), I_D = (DFF / 64) * (D / 32);
        constexpr int I_L = I_IN + I_O + 2 * I_G + I_D;
        for (int it = gw; it < 2 * I_L; it += NGW) {
            const int l = it / I_L; int r = it % I_L;
            if (r < I_IN) { const int nb = NQKV / 32, kb = r / nb, n0 = (r % nb) * 32;
                transpose_item(P.in[15] + (size_t)l * D * NIN, NIN, (bf16*)(ws + WS_WIN + l * SZ_WIN), LDW, kb * 64, n0, n0, scr, C.lane); continue; }
            r -= I_IN;
            if (r < I_O) { const int nb = D / 32, kb = r / nb, n0 = (r % nb) * 32;
                transpose_item(P.in[18] + (size_t)l * D * D, D, (bf16*)(ws + WS_WO + l * SZ_WO), LDW, kb * 64, n0, n0, scr, C.lane); continue; }
            r -= I_O;
            if (r < 2 * I_G) { const int up = r >= I_G; if (up) r -= I_G; const int nb = DFF / 32, kb = r / nb, n0 = (r % nb) * 32;
                const int drow0 = (n0 >> 7) * 256 + (n0 & 127) + (up ? 128 : 0);
                transpose_item(P.in[up ? 20 : 19] + (size_t)l * D * DFF, DFF, (bf16*)(ws + WS_WGU + l * SZ_WGU), LDW, kb * 64, n0, drow0, scr, C.lane); continue; }
            r -= 2 * I_G;
            { const int nb = D / 32, kb = r / nb, n0 = (r % nb) * 32;
                transpose_item(P.in[21] + (size_t)l * DFF * D, D, (bf16*)(ws + WS_WDN + l * SZ_WDN), LDWD, kb * 64, n0, n0, scr, C.lane); }
        }
    }
    {
        __syncthreads();
        LAS float* st = (LAS float*)(C.lds + RING_OFF);
        for (int idx = C.tid; idx < NMIDX * D; idx += 512) { const int m = idx / D, k = idx % D;
            const float c = m < PB ? P.in[9][m * D + k] : P.in[10][(m - PB) * D + k];
            st[k * NMIDX + m] = c * fast_rcp(1.0f + fast_exp2(-c * LOG2E)); }
        __syncthreads();
        float* mod = (float*)(ws + WS_MOD);
        constexpr int KC = 256, NKC = D / KC, NNC = NMOD / 256;
        for (int it = C.wave * C.G + C.blk; it < 2 * NKC * NNC; it += 8 * C.G) {
            const int l = it / (NKC * NNC), r = it % (NKC * NNC), kc = r / NNC, nc = r % NNC, k0 = kc * KC, n0 = nc * 256 + C.lane * 4;
            const float* wp = P.in[11] + ((size_t)l * D + k0) * NMOD + n0;
            f32x4 acc[NMIDX];
#pragma unroll
            for (int m = 0; m < NMIDX; ++m) acc[m] = (f32x4){0.f, 0.f, 0.f, 0.f};
#pragma unroll 4
            for (int k = 0; k < KC; ++k) { const f32x4 w = *(const f32x4*)(wp + (size_t)k * NMOD);
                const LAS f32x4* sp = (const LAS f32x4*)(st + (k0 + k) * NMIDX); const f32x4 s0 = sp[0], s1 = sp[1], s2 = sp[2];
                acc[0] += w * s0[0]; acc[1] += w * s0[1]; acc[2] += w * s0[2]; acc[3] += w * s0[3];
                acc[4] += w * s1[0]; acc[5] += w * s1[1]; acc[6] += w * s1[2]; acc[7] += w * s1[3];
                acc[8] += w * s2[0]; acc[9] += w * s2[1]; acc[10] += w * s2[2]; acc[11] += w * s2[3]; }
            f32x4 bias = (f32x4){0.f, 0.f, 0.f, 0.f};
            if (kc == 0) bias = *(const f32x4*)(P.in[12] + (size_t)l * NMOD + n0);
#pragma unroll
            for (int m = 0; m < NMIDX; ++m) { float* mp = mod + ((size_t)l * NMIDX + m) * NMOD + n0;
#pragma unroll
                for (int j = 0; j < 4; ++j) __hip_atomic_fetch_add(mp + j, acc[m][j] + bias[j], __ATOMIC_RELAXED, __HIP_MEMORY_SCOPE_AGENT); }
        }
    }
}

template <bool WITH_LOGF>
__device__ __forceinline__ void norm_rows(const Ctx& C, const float* xrows, bf16* hrows, int nrows, const float* gvec, const float* shift, const float* scale,
                                          const LAS float* wf, const float* bf, float* lf_out) {
    f32x4 gm[8], sh[8];
#pragma unroll
    for (int j = 0; j < 8; ++j) { const int e = 4 * C.lane + 256 * j; const f32x4 g = *(const f32x4*)(gvec + e), sc = *(const f32x4*)(scale + e); sh[j] = *(const f32x4*)(shift + e); gm[j] = g * (sc + 1.0f); }
    f32x4 nx[8];
#pragma unroll
    for (int j = 0; j < 8; ++j) nx[j] = *(const f32x4*)(xrows + 4 * C.lane + 256 * j);
    for (int r = 0; r < nrows; ++r) {
        f32x4 v[8]; float ss = 0.f;
#pragma unroll
        for (int j = 0; j < 8; ++j) v[j] = nx[j];
        if (r + 1 < nrows) { const float* xr = xrows + (size_t)(r + 1) * D;
#pragma unroll
            for (int j = 0; j < 8; ++j) nx[j] = *(const f32x4*)(xr + 4 * C.lane + 256 * j); }
        asm volatile("" ::: "memory");
#pragma unroll
        for (int j = 0; j < 8; ++j) ss += (v[j][0] * v[j][0] + v[j][1] * v[j][1]) + (v[j][2] * v[j][2] + v[j][3] * v[j][3]);
        const float rstd = 1.0f / sqrtf(wave_sum(ss) * (1.0f / D) + EPS);
#pragma unroll
        for (int j = 0; j < 8; ++j) v[j] = v[j] * rstd * gm[j] + sh[j];
        bf16* hr = hrows + (size_t)r * LDH;
#pragma unroll
        for (int j = 0; j < 8; ++j) { u32x2 w; w.x = cvt_pk_bf16(v[j][0], v[j][1]); w.y = cvt_pk_bf16(v[j][2], v[j][3]); *(u32x2*)(hr + 4 * C.lane + 256 * j) = w; }
        if constexpr (WITH_LOGF) {
            float dots[6];
#pragma unroll
            for (int f = 0; f < 6; ++f) { float a = 0.f;
#pragma unroll
                for (int j = 0; j < 8; ++j) { const f32x4 w = *(const LAS f32x4*)(wf + f * D + 4 * C.lane + 256 * j); a += (v[j][0] * w[0] + v[j][1] * w[1]) + (v[j][2] * w[2] + v[j][3] * w[3]); }
                dots[f] = wave_sum(a); }
            if (C.lane < 6) { float z = C.lane == 0 ? dots[0] : C.lane == 1 ? dots[1] : C.lane == 2 ? dots[2] : C.lane == 3 ? dots[3] : C.lane == 4 ? dots[4] : dots[5];
                z += bf[C.lane];
                const float ls = fminf(z, 0.f) - LN2 * fast_log2(1.0f + fast_exp2(-fabsf(z) * LOG2E));
                lf_out[(size_t)r * HB + C.lane] = ls; }
        }
    }
}

__device__ __forceinline__ void sample_resid_row(const Ctx& C, const float* xin, float* xout, const float* part, int nkc, const float* gate) {
    f32x4 s[8];
#pragma unroll
    for (int j = 0; j < 8; ++j) s[j] = (f32x4){0.f, 0.f, 0.f, 0.f};
    for (int kc = 0; kc < nkc; ++kc) { const float* pp = part + (size_t)kc * MS * D;
#pragma unroll
        for (int j = 0; j < 8; ++j) s[j] += *(const f32x4*)(pp + 4 * C.lane + 256 * j); }
#pragma unroll
    for (int j = 0; j < 8; ++j) { const int e = 4 * C.lane + 256 * j; *(f32x4*)(xout + e) = *(const f32x4*)(xin + e) + *(const f32x4*)(gate + e) * s[j]; }
}
template <bool WITH_LOGF>
__device__ __forceinline__ void norm_phase(const Params& P, const Ctx& C, int layer, const float* xp, const float* xs, const float* gvec, int off_shift, int off_scale,
                                           int fix_nkc, const float* fix_mod, int fix_gate_off) {
    bf16* H = (bf16*)(P.ws + WS_H); const float* mod = (const float*)(P.ws + WS_MOD) + (size_t)layer * NMIDX * NMOD;
    LAS float* wf = (LAS float*)(C.lds + RING_OFF);
    if constexpr (WITH_LOGF) {
        const float* win = P.in[15] + (size_t)layer * D * NIN + NQKV;
        for (int idx = C.tid; idx < 6 * D; idx += 512) { const int k = idx / 6, f = idx % 6; wf[f * D + k] = win[(size_t)k * NIN + f]; }
        __syncthreads();
    }
    const float* bf = P.in[16] + layer * HB;
    float* lfp = P.out + O_BLF_P + (size_t)layer * PB * PT * HB; float* lfs = P.out + O_BLF_S + (size_t)layer * MS * HB;
    const int gw = C.blk * 8 + C.wave, NGW = C.G * 8;
    for (int it = gw; it < MP / 16; it += NGW) { const int r0 = it * 16, b = r0 >> 13; const float* mv = mod + (size_t)b * NMOD;
        norm_rows<WITH_LOGF>(C, xp + (size_t)r0 * D, H + (size_t)r0 * LDH, 16, gvec, mv + off_shift, mv + off_scale, wf, bf, lfp + (size_t)r0 * HB); }
    if (C.wave == 0 && xs != nullptr) for (int r = C.blk; r < MS; r += C.G) { const float* mv = mod + (size_t)(PB + (r >> 5)) * NMOD; const float* xr = xs + (size_t)r * D;
        if (fix_nkc > 0) { float* xo = P.out + O_Y_S + (size_t)r * D;
            sample_resid_row(C, xr, xo, (const float*)(P.ws + WS_PART) + (size_t)r * D, fix_nkc, fix_mod + (size_t)(PB + (r >> 5)) * NMOD + fix_gate_off); xr = xo; }
        norm_rows<WITH_LOGF>(C, xr, H + (size_t)(MP + r) * LDH, 1, gvec, mv + off_shift, mv + off_scale, wf, bf, lfs + (size_t)r * HB); }
    __syncthreads();
}

__device__ __forceinline__ void final_norm(const Params& P, const Ctx& C) {
    const float* g = P.in[22]; f32x4 gm[8];
#pragma unroll
    for (int j = 0; j < 8; ++j) gm[j] = *(const f32x4*)(g + 4 * C.lane + 256 * j);
    const int gw = C.blk * 8 + C.wave, NGW = C.G * 8;
    for (int it = gw; it < MP / 16; it += NGW) {
        float* x0 = P.out + (size_t)it * 16 * D; f32x4 nx[8];
#pragma unroll
        for (int j = 0; j < 8; ++j) nx[j] = *(const f32x4*)(x0 + 4 * C.lane + 256 * j);
        for (int r = 0; r < 16; ++r) { float* xr = x0 + (size_t)r * D; f32x4 v[8]; float ss = 0.f;
#pragma unroll
            for (int j = 0; j < 8; ++j) v[j] = nx[j];
            if (r + 1 < 16) {
#pragma unroll
                for (int j = 0; j < 8; ++j) nx[j] = *(const f32x4*)(xr + D + 4 * C.lane + 256 * j); }
            asm volatile("" ::: "memory");
#pragma unroll
            for (int j = 0; j < 8; ++j) ss += (v[j][0] * v[j][0] + v[j][1] * v[j][1]) + (v[j][2] * v[j][2] + v[j][3] * v[j][3]);
            const float rstd = 1.0f / sqrtf(wave_sum(ss) * (1.0f / D) + EPS);
#pragma unroll
            for (int j = 0; j < 8; ++j) *(f32x4*)(xr + 4 * C.lane + 256 * j) = v[j] * rstd * gm[j]; }
    }
    if (C.wave == 0) for (int rs = C.blk; rs < MS; rs += C.G) {
        float* xr = P.out + O_Y_S + (size_t)rs * D;
        sample_resid_row(C, xr, xr, (const float*)(P.ws + WS_PART) + (size_t)rs * D, DFF / 256, (const float*)(P.ws + WS_MOD) + ((size_t)NMIDX + PB + (rs >> 5)) * NMOD + 5 * D);
        f32x4 v[8]; float ss = 0.f;
#pragma unroll
        for (int j = 0; j < 8; ++j) { v[j] = *(const f32x4*)(xr + 4 * C.lane + 256 * j); ss += (v[j][0] * v[j][0] + v[j][1] * v[j][1]) + (v[j][2] * v[j][2] + v[j][3] * v[j][3]); }
        const float rstd = 1.0f / sqrtf(wave_sum(ss) * (1.0f / D) + EPS);
#pragma unroll
        for (int j = 0; j < 8; ++j) *(f32x4*)(xr + 4 * C.lane + 256 * j) = v[j] * rstd * gm[j]; }
}

__device__ __forceinline__ float block_excl_scan(const Ctx& C, LAS float* red, float s) {
    float incl = s;
#pragma unroll
    for (int o = 1; o < 64; o <<= 1) { const float t = __shfl_up(incl, o); if (C.lane >= o) incl += t; }
    if (C.lane == 63) red[C.wave] = incl;
    __syncthreads();
    float base = 0.f;
    for (int w = 0; w < C.wave; ++w) base += red[w];
    return base + incl - s;
}

__device__ __forceinline__ void fcum_phase(const Params& P, const Ctx& C, int layer) {
    LAS float* red = (LAS float*)(C.lds + RING_OFF);
    if (C.blk < PB * HB) {
        const int b = C.blk / HB, h = C.blk % HB; const float* lf = P.out + O_BLF_P + ((size_t)(layer * PB + b) * PT) * HB + h;
        float* F = (float*)(P.ws + WS_FP) + ((size_t)b * PT) * HB + h;
        float v[16]; float s = 0.f;
#pragma unroll
        for (int i = 0; i < 16; ++i) { v[i] = lf[(size_t)(C.tid * 16 + i) * HB]; s += v[i]; }
        float a = block_excl_scan(C, red, s);
#pragma unroll
        for (int i = 0; i < 16; ++i) { a += v[i]; F[(size_t)(C.tid * 16 + i) * HB] = a; }
        __syncthreads();
    } else if (C.blk < PB * HB + SB * HB) {
        const int q = C.blk - PB * HB, sb = q / HB, h = q % HB; constexpr int L = PAST + ST;
        const float* cl = P.in[6] + ((size_t)(layer * SB + sb) * PAST) * HB + h; const float* nl = P.out + O_BLF_S + ((size_t)(layer * SB + sb) * ST) * HB + h;
        float* F = (float*)(P.ws + WS_FS) + ((size_t)sb * L) * HB + h;
        float v[3]; float s = 0.f;
#pragma unroll
        for (int i = 0; i < 3; ++i) { const int p = C.tid * 3 + i; v[i] = p < PAST ? cl[(size_t)p * HB] : (p < L ? nl[(size_t)(p - PAST) * HB] : 0.f); s += v[i]; }
        float a = block_excl_scan(C, red, s);
#pragma unroll
        for (int i = 0; i < 3; ++i) { const int p = C.tid * 3 + i; a += v[i]; if (p < L) F[(size_t)p * HB] = a; }
        __syncthreads();
    }
}

__device__ __forceinline__ void finish_qkv(const Params& P, const Ctx& C, int layer) {
    const float* part = (const float*)(P.ws + WS_PART); bf16* qkv = (bf16*)(P.ws + WS_QKV);
    for (int r = C.blk; r < MS; r += C.G)
        for (int c4 = C.tid; c4 < NQKV / 4; c4 += 512) { const int c = c4 * 4; f32x4 s = (f32x4){0.f, 0.f, 0.f, 0.f};
#pragma unroll
            for (int kc = 0; kc < 8; ++kc) s += *(const f32x4*)(part + ((size_t)kc * MS + r) * NQKV + c);
            u32x2 w; w.x = cvt_pk_bf16(s[0], s[1]); w.y = cvt_pk_bf16(s[2], s[3]); *(u32x2*)(qkv + (size_t)(MP + r) * LDQ + c) = w;
            const int which = c / D;
            if (which != 0) { const int hh = (c % D) / HD, d = c % HD; const bool isv = which == 2; float* dst;
                if (hh < HA) dst = P.out + (isv ? O_AV_S : O_AK_S) + ((size_t)(layer * MS + r) * HA + hh) * HD + d;
                else if (hh < HA + HB) dst = P.out + (isv ? O_BV_S : O_BK_S) + ((size_t)(layer * MS + r) * HB + (hh - HA)) * HD + d;
                else dst = P.out + (isv ? O_CV_S : O_CK_S) + ((size_t)(layer * MS + r) * HC + (hh - HA - HB)) * HD + d;
                *(f32x4*)dst = s; } }
}
__device__ __forceinline__ void finish_act(const Params& P, const Ctx& C) {
    const float* part = (const float*)(P.ws + WS_PART); bf16* act = (bf16*)(P.ws + WS_QKV);
    for (int r = C.blk; r < MS; r += C.G)
        for (int j4 = C.tid; j4 < DFF / 4; j4 += 512) { const int j = j4 * 4, cg = (j >> 7) * 256 + (j & 127); f32x4 g = (f32x4){0.f, 0.f, 0.f, 0.f}, up = g;
#pragma unroll
            for (int kc = 0; kc < 4; ++kc) { const float* pr = part + ((size_t)kc * MS + r) * (2 * DFF) + cg; g += *(const f32x4*)pr; up += *(const f32x4*)(pr + 128); }
            float o[4];
#pragma unroll
            for (int i = 0; i < 4; ++i) o[i] = g[i] * fast_rcp(1.0f + fast_exp2(-g[i] * LOG2E)) * up[i];
            u32x2 w; w.x = cvt_pk_bf16(o[0], o[1]); w.y = cvt_pk_bf16(o[2], o[3]); *(u32x2*)(act + (size_t)(MP + r) * LDACT + j) = w; }
}


namespace att {
constexpr int KROW = 272, VROW = 144;
constexpr int KBUF = 64 * KROW, VBUF = 128 * VROW;
constexpr int OFF_K = 0, OFF_V = 2 * KBUF, OFF_FB = OFF_V + 2 * VBUF, OFF_REL = OFF_FB + 512, OFF_VOTE = OFF_REL + 1040, OFF_QW = OFF_VOTE + 64;
static_assert(OFF_QW + 16 <= RING_BYTES && (OFF_REL % 16) == 0 && (OFF_VOTE % 16) == 0, "attention LDS map");
constexpr float STICK_STOP = -105.0f;

struct Unit {
    const bf16* q; bf16* o; int ostride; int nq, qpos0, kv_len, new_pos0;
    const bf16 *kn, *vn; const float *kc, *vc; int cstride;
    int t_hi, t_lo;
    const float* F; float fref; float kmax;
    const float* rel;
};

__device__ __forceinline__ float partner32(float x, int hi) {
    auto rr = __builtin_amdgcn_permlane32_swap(__float_as_uint(x), __float_as_uint(x), false, false);
    return __uint_as_float(hi ? rr[0] : rr[1]);
}
__device__ __forceinline__ bf16x8 pack8(float a0, float a1, float a2, float a3, float a4, float a5, float a6, float a7) {
    u32x4 w = {cvt_pk_bf16(a0, a1), cvt_pk_bf16(a2, a3), cvt_pk_bf16(a4, a5), cvt_pk_bf16(a6, a7)};
    return __builtin_bit_cast(bf16x8, w);
}

template <int MODE>
__device__ __forceinline__ void run_unit(LAS unsigned char* lds, const Unit& u, int tid, int wave, int lane) {
    const int qr = lane & 31, hi = lane >> 5;
    const bool active = wave * 32 < u.nq;
    const int qpos_w0 = u.qpos0 + wave * 32, qpos = qpos_w0 + qr;
    int w_hi, w_lo;
    if (MODE == 0) { const int n = qpos_w0 >> 6; w_hi = n; w_lo = n - 8 > 0 ? n - 8 : 0; }
    else if (MODE == 1) { w_hi = (qpos_w0 + 31) >> 6; w_lo = 0; }
    else { w_hi = (qpos_w0 + 30) >> 6; w_lo = 0; }
    const int near_lo = (qpos_w0 >> 6) - 2;
    bf16x8 qf[8];
    { const bf16* qp = u.q + (size_t)((active ? wave * 32 : 0) + qr) * LDQ + 8 * hi;
#pragma unroll
      for (int ds = 0; ds < 8; ++ds) qf[ds] = *(const bf16x8*)(qp + 16 * ds); }
    float qk_bound = 0.f;
    if (MODE == 1) { float s = 0.f;
#pragma unroll
        for (int ds = 0; ds < 8; ++ds) { const u32x4 w = __builtin_bit_cast(u32x4, qf[ds]);
#pragma unroll
            for (int i = 0; i < 4; ++i) { const float lo = __uint_as_float(w[i] << 16), hi2 = __uint_as_float(w[i] & 0xffff0000u); s += lo * lo + hi2 * hi2; } }
        s += partner32(s, hi); qk_bound = sqrtf(s) * u.kmax; }
    LAS float* rel_l = (LAS float*)(lds + OFF_REL);
    if (MODE == 0) { for (int i = tid; i < 257; i += 512) rel_l[i] = u.rel[i * HA] * INV_SCALE; }
    f32x16 o[4];
#pragma unroll
    for (int b = 0; b < 4; ++b)
#pragma unroll
        for (int r = 0; r < 16; ++r) o[b][r] = 0.f;
    float m_run = -1e30f, l_run = 0.f, carry = 0.f;
    const int k_key = tid >> 4, k_dc = tid & 15;
    const int k_lds = k_key * KROW + k_dc * 16;
    const int v_dc = lane & 15, v_kq = lane >> 4;
    const int v_key0 = 16 * (wave >> 1) + 4 * (wave & 1) + 2 * (v_kq & 1) + 8 * (v_kq >> 1);
    const int v_pos0 = (v_key0 & ~0xC) | ((v_key0 & 4) << 1) | ((v_key0 & 8) >> 1);
    const int v_lds = (8 * v_dc) * VROW + ((((v_pos0 >> 3) ^ ((v_dc >> 1) & 7))) << 4) + (v_pos0 & 7) * 2;
    const int kr_lds = qr * KROW + hi * 16;
    const int vr_lds = qr * VROW + ((hi ^ (qr >> 4)) << 4);
    u32x4 kreg[2], vreg[2]; float freg = 0.f;
    auto stage_load = [&](int j) {
        const int last = u.kv_len - 1;
#pragma unroll
        for (int i = 0; i < 2; ++i) { int pos = 64 * j + k_key + 32 * i; pos = pos < last ? pos : last;
            if (64 * j >= u.new_pos0) kreg[i] = *(const u32x4*)(u.kn + (size_t)(pos - u.new_pos0) * LDQ + 8 * k_dc);
            else { const float* s = u.kc + (size_t)pos * u.cstride + 8 * k_dc; const f32x4 x = *(const f32x4*)s, y = *(const f32x4*)(s + 4);
                kreg[i] = (u32x4){cvt_pk_bf16(x[0], x[1]), cvt_pk_bf16(x[2], x[3]), cvt_pk_bf16(y[0], y[1]), cvt_pk_bf16(y[2], y[3])}; } }
#pragma unroll
        for (int i = 0; i < 2; ++i) { int pos = 64 * j + v_key0 + i; pos = pos < last ? pos : last;
            if (64 * j >= u.new_pos0) vreg[i] = *(const u32x4*)(u.vn + (size_t)(pos - u.new_pos0) * LDQ + 8 * v_dc);
            else { const float* s = u.vc + (size_t)pos * u.cstride + 8 * v_dc; const f32x4 x = *(const f32x4*)s, y = *(const f32x4*)(s + 4);
                vreg[i] = (u32x4){cvt_pk_bf16(x[0], x[1]), cvt_pk_bf16(x[2], x[3]), cvt_pk_bf16(y[0], y[1]), cvt_pk_bf16(y[2], y[3])}; } }
        if (MODE == 1 && tid < 64) { int pos = 64 * j + tid; pos = pos < last ? pos : last; freg = u.F[(size_t)pos * HB]; }
    };
    auto stage_store = [&](int buf) {
        LAS unsigned char* kb = lds + OFF_K + buf * KBUF + k_lds;
        *(LAS u32x4*)kb = kreg[0]; *(LAS u32x4*)(kb + 32 * KROW) = kreg[1];
        LAS unsigned char* vb = lds + OFF_V + buf * VBUF + v_lds;
        const unsigned a[4] = {vreg[0].x, vreg[0].y, vreg[0].z, vreg[0].w}, b[4] = {vreg[1].x, vreg[1].y, vreg[1].z, vreg[1].w};
#pragma unroll
        for (int i = 0; i < 4; ++i) {
            *(LAS unsigned*)(vb + (2 * i) * VROW) = (a[i] & 0xffffu) | (b[i] << 16);
            *(LAS unsigned*)(vb + (2 * i + 1) * VROW) = (a[i] >> 16) | (b[i] & 0xffff0000u); }
        if (MODE == 1 && tid < 64) ((LAS float*)(lds + OFF_FB + buf * 256))[tid] = (u.fref - freg) * INV_SCALE;
    };
    stage_load(u.t_hi);
    stage_store(0);
    LDS_WAIT(); __syncthreads();
    bool wave_done = !active;
    for (int j = u.t_hi, it = 0;; --j, ++it) {
        const int cur = it & 1;
        const bool more = j > u.t_lo;
        if (more) stage_load(j - 1);
        if (active && j <= w_hi && j >= w_lo && !(MODE != 0 && wave_done)) {
            f32x16 p0, p1;
            if (MODE == 1) { const LAS f32x4* fb = (const LAS f32x4*)(lds + OFF_FB + cur * 256);
#pragma unroll
                for (int g = 0; g < 4; ++g) { const f32x4 a = fb[2 * g + hi], b = fb[8 + 2 * g + hi];
#pragma unroll
                    for (int i = 0; i < 4; ++i) { p0[4 * g + i] = a[i]; p1[4 * g + i] = b[i]; } } }
            else if (MODE == 0) {
                if (j >= near_lo) { const int base = qpos - 64 * j - 4 * hi + 128;
#pragma unroll
                    for (int r = 0; r < 16; ++r) { const int c = (r & 3) + 8 * (r >> 2); int i0 = base - c, i1 = base - c - 32; i0 = i0 < 256 ? i0 : 256; i1 = i1 < 256 ? i1 : 256;
                        p0[r] = rel_l[i0]; p1[r] = rel_l[i1]; } }
                else { const float cb = rel_l[256];
#pragma unroll
                    for (int r = 0; r < 16; ++r) { p0[r] = cb; p1[r] = cb; } } }
            else {
#pragma unroll
                for (int r = 0; r < 16; ++r) { p0[r] = 0.f; p1[r] = 0.f; } }
            { const LAS unsigned char* kb = lds + OFF_K + cur * KBUF + kr_lds;
#define ATT_KFRAG(i) (*(const LAS bf16x8*)(kb + ((i) & 1) * 32 * KROW + 32 * ((i) >> 1)))
              bf16x8 kf[8];
#pragma unroll
              for (int i = 0; i < 8; ++i) kf[i] = ATT_KFRAG(i);
              __builtin_amdgcn_sched_barrier(0);
#pragma unroll
              for (int i = 0; i < 16; ++i) {
                  if (i & 1) p1 = __builtin_amdgcn_mfma_f32_32x32x16_bf16(kf[i & 7], qf[i >> 1], p1, 0, 0, 0); else p0 = __builtin_amdgcn_mfma_f32_32x32x16_bf16(kf[i & 7], qf[i >> 1], p0, 0, 0, 0);
                  if (i + 8 < 16) kf[i & 7] = ATT_KFRAG(i + 8);
                  __builtin_amdgcn_sched_barrier(0); }
#undef ATT_KFRAG
            }
            const int kp0 = 64 * j + 4 * hi;
            if (MODE != 2) {
                const bool need_mask = MODE == 1 ? (64 * j + 63 > qpos_w0) : (64 * j + 63 >= u.kv_len);
                if (need_mask) { const int lim = MODE == 1 ? qpos + 1 : u.kv_len;
#pragma unroll
                    for (int r = 0; r < 16; ++r) { const int kp = kp0 + (r & 3) + 8 * (r >> 2);
                        if (kp >= lim) p0[r] = -__builtin_inff(); if (kp + 32 >= lim) p1[r] = -__builtin_inff(); } }
                float mx = fmaxf(p0[0], p1[0]);
#pragma unroll
                for (int r = 1; r < 16; ++r) mx = fmaxf(mx, fmaxf(p0[r], p1[r]));
                mx = fmaxf(mx, partner32(mx, hi));
                const float mn = fmaxf(m_run, mx);
                constexpr float C2 = ATT_SCALE * LOG2E;
                if (__any(mn > m_run)) { const float alpha = fast_exp2((m_run - mn) * C2); l_run *= alpha; m_run = mn;
#pragma unroll
                    for (int b = 0; b < 4; ++b)
#pragma unroll
                        for (int r = 0; r < 16; ++r) o[b][r] *= alpha; }
                const float mc = m_run * C2; float ps = 0.f;
#pragma unroll
                for (int r = 0; r < 16; ++r) { p0[r] = fast_exp2(p0[r] * C2 - mc); p1[r] = fast_exp2(p1[r] * C2 - mc); ps += p0[r] + p1[r]; }
                l_run += ps;
                if (MODE == 1) {
                    const float bmax = ((const LAS float*)(lds + OFF_FB + cur * 256))[0];
                    wave_done = __all((qk_bound + bmax - m_run) * C2 < -150.0f); }
            } else {
                const bool need_mask = 64 * j + 63 >= qpos_w0;
                float ls0[16], ls1[16];
#pragma unroll
                for (int r = 0; r < 16; ++r) {
                    const float z0 = p0[r] * ATT_SCALE, z1 = p1[r] * ATT_SCALE;
                    const float sp0 = fmaxf(z0, 0.f) + LN2 * fast_log2(1.0f + fast_exp2(-fabsf(z0) * LOG2E)), sp1 = fmaxf(z1, 0.f) + LN2 * fast_log2(1.0f + fast_exp2(-fabsf(z1) * LOG2E));
                    p0[r] = z0 - sp0; p1[r] = z1 - sp1;
                    ls0[r] = -sp0; ls1[r] = -sp1; }
                if (need_mask) {
#pragma unroll
                    for (int r = 0; r < 16; ++r) { const int kp = kp0 + (r & 3) + 8 * (r >> 2);
                        if (kp >= qpos) { ls0[r] = 0.f; p0[r] = -__builtin_inff(); } if (kp + 32 >= qpos) { ls1[r] = 0.f; p1[r] = -__builtin_inff(); } } }
                float a[8], b[8], t[8];
#pragma unroll
                for (int g = 0; g < 4; ++g) { a[g] = (ls0[4 * g] + ls0[4 * g + 1]) + (ls0[4 * g + 2] + ls0[4 * g + 3]); a[4 + g] = (ls1[4 * g] + ls1[4 * g + 1]) + (ls1[4 * g + 2] + ls1[4 * g + 3]); }
#pragma unroll
                for (int g = 0; g < 8; ++g) { b[g] = partner32(a[g], hi); t[g] = a[g] + b[g]; }
                float ps = carry;
#pragma unroll
                for (int g = 7; g >= 0; --g) {
                    const float sg = ps + (hi ? 0.f : b[g]);
                    if (g < 4) { const float e3 = sg, e2 = e3 + ls0[4 * g + 3], e1 = e2 + ls0[4 * g + 2], e0 = e1 + ls0[4 * g + 1];
                        p0[4 * g + 3] = fast_exp2((p0[4 * g + 3] + e3) * LOG2E); p0[4 * g + 2] = fast_exp2((p0[4 * g + 2] + e2) * LOG2E);
                        p0[4 * g + 1] = fast_exp2((p0[4 * g + 1] + e1) * LOG2E); p0[4 * g] = fast_exp2((p0[4 * g] + e0) * LOG2E); }
                    else { const int gg = g - 4; const float e3 = sg, e2 = e3 + ls1[4 * gg + 3], e1 = e2 + ls1[4 * gg + 2], e0 = e1 + ls1[4 * gg + 1];
                        p1[4 * gg + 3] = fast_exp2((p1[4 * gg + 3] + e3) * LOG2E); p1[4 * gg + 2] = fast_exp2((p1[4 * gg + 2] + e2) * LOG2E);
                        p1[4 * gg + 1] = fast_exp2((p1[4 * gg + 1] + e1) * LOG2E); p1[4 * gg] = fast_exp2((p1[4 * gg] + e0) * LOG2E); }
                    ps += t[g];
                }
                carry = ps;
                wave_done = __all(carry < STICK_STOP) || j == 0;
            }
            { const LAS unsigned char* vb = lds + OFF_V + cur * VBUF + vr_lds;
#define ATT_VFRAG(i) (*(const LAS bf16x8*)(vb + 32 * ((i) & 3) * VROW + ((((i) >> 2) ^ ((i) & 3)) << 5)))
              bf16x8 pf[4], vf[8];
              pf[0] = pack8(p0[0], p0[1], p0[2], p0[3], p0[4], p0[5], p0[6], p0[7]); pf[1] = pack8(p0[8], p0[9], p0[10], p0[11], p0[12], p0[13], p0[14], p0[15]);
              pf[2] = pack8(p1[0], p1[1], p1[2], p1[3], p1[4], p1[5], p1[6], p1[7]); pf[3] = pack8(p1[8], p1[9], p1[10], p1[11], p1[12], p1[13], p1[14], p1[15]);
#pragma unroll
              for (int i = 0; i < 8; ++i) vf[i] = ATT_VFRAG(i);
              __builtin_amdgcn_sched_barrier(0);
#pragma unroll
              for (int i = 0; i < 16; ++i) {
                  o[i & 3] = __builtin_amdgcn_mfma_f32_32x32x16_bf16(vf[i & 7], pf[i >> 2], o[i & 3], 0, 0, 0);
                  if (i + 8 < 16) vf[i & 7] = ATT_VFRAG(i + 8);
                  __builtin_amdgcn_sched_barrier(0); }
#undef ATT_VFRAG
            }
        }
        if (more) stage_store(cur ^ 1);
        if (MODE != 0 && lane == 0) ((LAS unsigned*)(lds + OFF_VOTE))[cur * 8 + wave] = (wave_done || j - 1 < w_lo) ? 1u : 0u;
        LDS_WAIT(); __syncthreads();
        if (!more) break;
        if (MODE != 0) { const LAS u32x4* vv = (const LAS u32x4*)(lds + OFF_VOTE + cur * 32); const u32x4 x = vv[0], y = vv[1];
            if ((x.x & x.y & x.z & x.w & y.x & y.y & y.z & y.w) != 0u) break; }
    }
    if (active) {
        float inv = 1.0f;
        if (MODE != 2) { const float lt = l_run + partner32(l_run, hi); inv = 1.0f / lt; }
        bf16* op = u.o + (size_t)(wave * 32 + qr) * u.ostride + 4 * hi;
#pragma unroll
        for (int db = 0; db < 4; ++db)
#pragma unroll
            for (int g = 0; g < 4; ++g) { u32x2 w; w.x = cvt_pk_bf16(o[db][4 * g] * inv, o[db][4 * g + 1] * inv); w.y = cvt_pk_bf16(o[db][4 * g + 2] * inv, o[db][4 * g + 3] * inv);
                *(u32x2*)(op + 32 * db + 8 * g) = w; }
    }
    __syncthreads();
}


__device__ __forceinline__ float vmax3(float a, float b, float c) { float r; asm("v_max3_f32 %0, %1, %2, %3" : "=v"(r) : "v"(a), "v"(b), "v"(c)); return r; }

__device__ __forceinline__ void run_unit_b(LAS unsigned char* lds, const Unit& u, int tid, int wave, int lane) {
    const int qr = lane & 31, hi = lane >> 5;
    const bool active = wave * 32 < u.nq;
    const int qpos_w0 = u.qpos0 + wave * 32, qpos = qpos_w0 + qr;
    const int w_hi = (qpos_w0 + 31) >> 6;
    bf16x8 qf[8];
    { const bf16* qp = u.q + (size_t)((active ? wave * 32 : 0) + qr) * LDQ + 8 * hi;
#pragma unroll
      for (int ds = 0; ds < 8; ++ds) qf[ds] = *(const bf16x8*)(qp + 16 * ds); }
    float qk_bound;
    { float s = 0.f;
#pragma unroll
      for (int ds = 0; ds < 8; ++ds) { const u32x4 w = __builtin_bit_cast(u32x4, qf[ds]);
#pragma unroll
          for (int i = 0; i < 4; ++i) { const float lo = __uint_as_float(w[i] << 16), hi2 = __uint_as_float(w[i] & 0xffff0000u); s += lo * lo + hi2 * hi2; } }
      s += partner32(s, hi); qk_bound = sqrtf(s) * u.kmax; }
    f32x16 o[4];
#pragma unroll
    for (int b = 0; b < 4; ++b)
#pragma unroll
        for (int r = 0; r < 16; ++r) o[b][r] = 0.f;
    float m_run = -1e30f, l_run = 0.f;
    const int k_key = tid >> 4, k_dc = tid & 15, k_lds = k_key * KROW + k_dc * 16;
    const int v_dc = lane & 15, v_kq = lane >> 4;
    const int v_key0 = 16 * (wave >> 1) + 4 * (wave & 1) + 2 * (v_kq & 1) + 8 * (v_kq >> 1);
    const int v_pos0 = (v_key0 & ~0xC) | ((v_key0 & 4) << 1) | ((v_key0 & 8) >> 1);
    const int v_lds = (8 * v_dc) * VROW + ((((v_pos0 >> 3) ^ ((v_dc >> 1) & 7))) << 4) + (v_pos0 & 7) * 2;
    const int kr_lds = qr * KROW + hi * 16, vr_lds = qr * VROW + ((hi ^ (qr >> 4)) << 4);
    u32x4 kreg[2], vreg[2], kreg2[2], vreg2[2]; float freg = 0.f, freg2 = 0.f;
#define B_STAGE_LOAD(J, kreg, vreg, freg) do { const int last_ = u.kv_len - 1; \
        if (64 * (J) >= u.new_pos0) { \
        _Pragma("unroll") for (int i = 0; i < 2; ++i) { int pos = 64 * (J) + k_key + 32 * i; pos = pos < last_ ? pos : last_; kreg[i] = *(const u32x4*)(u.kn + (size_t)(pos - u.new_pos0) * LDQ + 8 * k_dc); } \
        _Pragma("unroll") for (int i = 0; i < 2; ++i) { int pos = 64 * (J) + v_key0 + i; pos = pos < last_ ? pos : last_; vreg[i] = *(const u32x4*)(u.vn + (size_t)(pos - u.new_pos0) * LDQ + 8 * v_dc); } \
        } else { \
        _Pragma("unroll") for (int i = 0; i < 2; ++i) { const float* s_ = u.kc + (size_t)(64 * (J) + k_key + 32 * i) * u.cstride + 8 * k_dc; const f32x4 x_ = *(const f32x4*)s_, y_ = *(const f32x4*)(s_ + 4); \
            kreg[i] = (u32x4){cvt_pk_bf16(x_[0], x_[1]), cvt_pk_bf16(x_[2], x_[3]), cvt_pk_bf16(y_[0], y_[1]), cvt_pk_bf16(y_[2], y_[3])}; } \
        _Pragma("unroll") for (int i = 0; i < 2; ++i) { const float* s_ = u.vc + (size_t)(64 * (J) + v_key0 + i) * u.cstride + 8 * v_dc; const f32x4 x_ = *(const f32x4*)s_, y_ = *(const f32x4*)(s_ + 4); \
            vreg[i] = (u32x4){cvt_pk_bf16(x_[0], x_[1]), cvt_pk_bf16(x_[2], x_[3]), cvt_pk_bf16(y_[0], y_[1]), cvt_pk_bf16(y_[2], y_[3])}; } } \
        if (tid < 64) { int pos = 64 * (J) + tid; pos = pos < last_ ? pos : last_; freg = u.F[(size_t)pos * HB]; } } while (0)
#define B_STAGE_STORE(B_, kreg, vreg, freg) do { LAS unsigned char* kb_ = lds + OFF_K + (B_) * KBUF + k_lds; *(LAS u32x4*)kb_ = kreg[0]; *(LAS u32x4*)(kb_ + 32 * KROW) = kreg[1]; \
        LAS unsigned char* vb_ = lds + OFF_V + (B_) * VBUF + v_lds; const unsigned a_[4] = {vreg[0].x, vreg[0].y, vreg[0].z, vreg[0].w}, b_[4] = {vreg[1].x, vreg[1].y, vreg[1].z, vreg[1].w}; \
        _Pragma("unroll") for (int i = 0; i < 4; ++i) { *(LAS unsigned*)(vb_ + (2 * i) * VROW) = (a_[i] & 0xffffu) | (b_[i] << 16); *(LAS unsigned*)(vb_ + (2 * i + 1) * VROW) = (a_[i] >> 16) | (b_[i] & 0xffff0000u); } \
        if (tid < 64) ((LAS float*)(lds + OFF_FB + (B_) * 256))[tid] = (u.fref - freg) * INV_SCALE; } while (0)
    B_STAGE_LOAD(u.t_hi, kreg, vreg, freg);
    B_STAGE_STORE(0, kreg, vreg, freg);
    if (u.t_hi > u.t_lo) B_STAGE_LOAD(u.t_hi - 1, kreg, vreg, freg);
    LDS_WAIT(); __syncthreads();
    constexpr float C2 = ATT_SCALE * LOG2E;
    bool wave_done = !active;
#define B_QK(PX, KH_) do { const LAS unsigned char* kb_ = lds + OFF_K + cur * KBUF + kr_lds + (KH_) * 32 * KROW; bf16x8 kf[4]; \
        _Pragma("unroll") for (int i = 0; i < 4; ++i) kf[i] = *(const LAS bf16x8*)(kb_ + 32 * i); \
        _Pragma("unroll") for (int i = 0; i < 8; ++i) { PX = __builtin_amdgcn_mfma_f32_32x32x16_bf16(kf[i & 3], qf[i], PX, 0, 0, 0); \
            if (i + 4 < 8) kf[i & 3] = *(const LAS bf16x8*)(kb_ + 32 * (i + 4)); } } while (0)
#define B_SM(PX, PFA, PFB, ALPHA) do { float mx = vmax3(PX[0], PX[1], PX[2]); \
        _Pragma("unroll") for (int r = 3; r < 15; r += 2) mx = vmax3(mx, PX[r], PX[r + 1]); \
        mx = fmaxf(mx, PX[15]); mx = fmaxf(mx, partner32(mx, hi)); const float mn = fmaxf(m_run, mx); ALPHA = fast_exp2((m_run - mn) * C2); l_run *= ALPHA; m_run = mn; \
        const float mc = mn * C2; float ps = 0.f; \
        _Pragma("unroll") for (int r = 0; r < 16; ++r) { PX[r] = fast_exp2(PX[r] * C2 - mc); ps += PX[r]; } \
        l_run += ps; PFA = pack8(PX[0], PX[1], PX[2], PX[3], PX[4], PX[5], PX[6], PX[7]); PFB = pack8(PX[8], PX[9], PX[10], PX[11], PX[12], PX[13], PX[14], PX[15]); } while (0)
#define B_PV(S0_, PFA, PFB) do { const LAS unsigned char* vb_ = lds + OFF_V + cur * VBUF + vr_lds; bf16x8 vf[4]; \
        _Pragma("unroll") for (int i = 0; i < 4; ++i) vf[i] = *(const LAS bf16x8*)(vb_ + 32 * (i & 3) * VROW + ((((S0_) + (i >> 2)) ^ (i & 3)) << 5)); \
        _Pragma("unroll") for (int i = 0; i < 8; ++i) { o[i & 3] = __builtin_amdgcn_mfma_f32_32x32x16_bf16(vf[i & 3], (i < 4 ? PFA : PFB), o[i & 3], 0, 0, 0); \
            if (i + 4 < 8) vf[i & 3] = *(const LAS bf16x8*)(vb_ + 32 * ((i + 4) & 3) * VROW + ((((S0_) + ((i + 4) >> 2)) ^ ((i + 4) & 3)) << 5)); } } while (0)
#define B_RESCALE(ALPHA) do { if (__any(ALPHA != 1.0f)) { _Pragma("unroll") for (int b = 0; b < 4; ++b) _Pragma("unroll") for (int r = 0; r < 16; ++r) o[b][r] *= ALPHA; } } while (0)
#define B_KFRAG1(i) (*(const LAS bf16x8*)(lds + OFF_K + cur * KBUF + kr_lds + 32 * KROW + 32 * (i)))
#define B_VFRAG0(i) (*(const LAS bf16x8*)(lds + OFF_V + cur * VBUF + vr_lds + 32 * ((i) & 3) * VROW + ((((i) >> 2) ^ ((i) & 3)) << 5)))
#define B_MFMA_SM(PX, PFA, PFB, ALPHA, FRAG_, MMA_) do { bf16x8 fr[4]; float mx_, mc_ = 0.f, ps_ = 0.f; \
        _Pragma("unroll") for (int i = 0; i < 4; ++i) fr[i] = FRAG_(i); \
        __builtin_amdgcn_sched_barrier(0); \
        _Pragma("unroll") for (int i = 0; i < 8; ++i) { MMA_; if (i + 4 < 8) fr[i & 3] = FRAG_(i + 4); \
            if (i == 0) { mx_ = vmax3(PX[0], PX[1], PX[2]); mx_ = vmax3(mx_, PX[3], PX[4]); mx_ = vmax3(mx_, PX[5], PX[6]); mx_ = vmax3(mx_, PX[7], PX[8]); } \
            if (i == 1) { mx_ = vmax3(mx_, PX[9], PX[10]); mx_ = vmax3(mx_, PX[11], PX[12]); mx_ = vmax3(mx_, PX[13], PX[14]); mx_ = fmaxf(mx_, PX[15]); mx_ = fmaxf(mx_, partner32(mx_, hi)); asm volatile("" : "+v"(mx_)); } \
            if (i == 2) { const float mn_ = fmaxf(m_run, mx_); ALPHA = fast_exp2((m_run - mn_) * C2); l_run *= ALPHA; m_run = mn_; mc_ = mn_ * C2; asm volatile("" : "+v"(mc_), "+v"(ALPHA)); } \
            if (i >= 3 && i <= 6) { _Pragma("unroll") for (int r = 4 * (i - 3); r < 4 * (i - 3) + 4; ++r) { PX[r] = fast_exp2(PX[r] * C2 - mc_); ps_ += PX[r]; } \
                asm volatile("" : "+v"(PX[4 * (i - 3)]), "+v"(PX[4 * (i - 3) + 1]), "+v"(PX[4 * (i - 3) + 2]), "+v"(PX[4 * (i - 3) + 3]), "+v"(ps_)); } \
            if (i == 7) { l_run += ps_; PFA = pack8(PX[0], PX[1], PX[2], PX[3], PX[4], PX[5], PX[6], PX[7]); PFB = pack8(PX[8], PX[9], PX[10], PX[11], PX[12], PX[13], PX[14], PX[15]); } \
            __builtin_amdgcn_sched_barrier(0); } } while (0)
#define B_HINT() do { _Pragma("unroll") for (int i = 0; i < 8; ++i) { __builtin_amdgcn_sched_group_barrier(0x008, 1, 0); __builtin_amdgcn_sched_group_barrier(0x100, 1, 0); __builtin_amdgcn_sched_group_barrier(0x002, 10, 0); } } while (0)
#define B_ITER(KS, VS, FS, KL, VL, FL) { \
        const int cur = it & 1; \
        const bool more = j > u.t_lo; \
        if (j - 1 > u.t_lo) B_STAGE_LOAD(j - 2, KL, VL, FL); \
        if (active && j <= w_hi && !wave_done) { \
            f32x16 p0, p1; bf16x8 pf0, pf1, pf2, pf3; float alpha_a, alpha_b; \
            const LAS f32x4* fb = (const LAS f32x4*)(lds + OFF_FB + cur * 256); const float bmax = ((const LAS float*)fb)[0]; \
        _Pragma("unroll") \
            for (int g = 0; g < 4; ++g) { const f32x4 a = fb[2 * g + hi], b = fb[8 + 2 * g + hi]; \
        _Pragma("unroll") \
                for (int i = 0; i < 4; ++i) { p0[4 * g + i] = a[i]; p1[4 * g + i] = b[i]; } } \
            const bool need_mask = 64 * j + 63 > qpos_w0; const int kp0 = 64 * j + 4 * hi; \
            B_QK(p0, 0); \
            if (need_mask) { \
        _Pragma("unroll") \
                for (int r = 0; r < 16; ++r) { if (kp0 + (r & 3) + 8 * (r >> 2) > qpos) p0[r] = -__builtin_inff(); } } \
            B_MFMA_SM(p0, pf0, pf1, alpha_a, B_KFRAG1, p1 = __builtin_amdgcn_mfma_f32_32x32x16_bf16(fr[i & 3], qf[i], p1, 0, 0, 0)); \
            if (need_mask) { \
        _Pragma("unroll") \
                for (int r = 0; r < 16; ++r) { if (kp0 + 32 + (r & 3) + 8 * (r >> 2) > qpos) p1[r] = -__builtin_inff(); } } \
            B_RESCALE(alpha_a); \
            B_MFMA_SM(p1, pf2, pf3, alpha_b, B_VFRAG0, o[i & 3] = __builtin_amdgcn_mfma_f32_32x32x16_bf16(fr[i & 3], (i < 4 ? pf0 : pf1), o[i & 3], 0, 0, 0)); \
            B_RESCALE(alpha_b); \
            B_PV(2, pf2, pf3); \
            wave_done = __all((qk_bound + bmax - m_run) * C2 < -150.0f); \
        } \
        if (more) B_STAGE_STORE(cur ^ 1, KS, VS, FS); \
        if (lane == 0) ((LAS unsigned*)(lds + OFF_VOTE))[cur * 8 + wave] = (wave_done || j == 0) ? 1u : 0u; \
        LDS_WAIT(); __syncthreads(); \
        if (!more) break; \
        { const LAS u32x4* vv = (const LAS u32x4*)(lds + OFF_VOTE + cur * 32); const u32x4 x = vv[0], y = vv[1]; \
          if ((x.x & x.y & x.z & x.w & y.x & y.y & y.z & y.w) != 0u) break; } \
    }
    for (int j = u.t_hi, it = 0;;) {
        B_ITER(kreg, vreg, freg, kreg2, vreg2, freg2) --j; ++it;
        B_ITER(kreg2, vreg2, freg2, kreg, vreg, freg) --j; ++it;
    }
#undef B_ITER
#undef B_STAGE_LOAD
#undef B_STAGE_STORE
#undef B_QK
#undef B_SM
#undef B_PV
#undef B_RESCALE
#undef B_HINT
#undef B_MFMA_SM
#undef B_KFRAG1
#undef B_VFRAG0
    if (active) {
        const float lt = l_run + partner32(l_run, hi), inv = 1.0f / lt;
        bf16* op = u.o + (size_t)(wave * 32 + qr) * u.ostride + 4 * hi;
#pragma unroll
        for (int db = 0; db < 4; ++db)
#pragma unroll
            for (int g = 0; g < 4; ++g) { u32x2 w; w.x = cvt_pk_bf16(o[db][4 * g] * inv, o[db][4 * g + 1] * inv); w.y = cvt_pk_bf16(o[db][4 * g + 2] * inv, o[db][4 * g + 3] * inv);
                *(u32x2*)(op + 32 * db + 8 * g) = w; }
    }
    __syncthreads();
}

__device__ __forceinline__ int pull(LAS unsigned char* lds, unsigned* counter, int tid) {
    LAS int* qw = (LAS int*)(lds + OFF_QW);
    if (tid == 0) *qw = (int)__hip_atomic_fetch_add(counter, 1u, __ATOMIC_RELAXED, __HIP_MEMORY_SCOPE_AGENT);
    LDS_WAIT(); __syncthreads();
    const int v = *qw;
    __syncthreads();
    return v;
}

template <int MODE>
__device__ __forceinline__ void mode_loop(const Params& P, const Ctx& C, int layer, int probe_pass) {
    constexpr int NHG = MODE == 0 ? HA : HB;
    constexpr int H0 = MODE == 0 ? 0 : (MODE == 1 ? HA : HA + HB);
    constexpr int NPU = PB * NHG * (PT / 256), NSU = SB * NHG;
    unsigned* counter = (unsigned*)(P.ws + WS_CTL) + CW_QUEUE + 64 * (layer * 3 + MODE + 8 * probe_pass);
    const bf16* qkv = (const bf16*)(P.ws + WS_QKV);
    for (;;) {
        const int i = pull(C.lds, counter, C.tid);
        if (i >= NPU + NSU) break;
        Unit u;
        if (i < NPU) {
            const int qb = (PT / 256 - 1) - i / (PB * NHG), bh = i % (PB * NHG), b = bh / NHG, hg = bh % NHG, hh = H0 + hg;
            const size_t row0 = (size_t)b * PT;
            u.q = qkv + (row0 + (size_t)qb * 256) * LDQ + hh * HD; u.nq = 256; u.qpos0 = qb * 256; u.kv_len = PT; u.new_pos0 = 0;
            u.kn = qkv + row0 * LDQ + D + hh * HD; u.vn = qkv + row0 * LDQ + 2 * D + hh * HD; u.kc = P.in[2]; u.vc = P.in[3]; u.cstride = 0;
            u.t_hi = 4 * qb + 3; u.t_lo = MODE == 0 ? (4 * qb - 8 > 0 ? 4 * qb - 8 : 0) : 0;
            u.F = (const float*)(P.ws + WS_FP) + row0 * HB + hg; u.fref = MODE == 1 ? u.F[(size_t)u.qpos0 * HB] : 0.f;
            u.rel = P.in[17] + (size_t)layer * 257 * HA + hh;
            u.kmax = 0.f;
            if (MODE == 1) {
                const float* kn2 = (const float*)(P.ws + WS_KN2) + ((size_t)layer * MP + row0) * HB + hg; float mx = 0.f;
                for (int t = C.tid; t < u.qpos0 + 256; t += 512) mx = fmaxf(mx, kn2[(size_t)t * HB]);
#pragma unroll
                for (int o = 1; o < 64; o <<= 1) mx = fmaxf(mx, __shfl_xor(mx, o));
                LAS float* red = (LAS float*)(C.lds + OFF_VOTE);
                if (C.lane == 0) red[C.wave] = mx;
                LDS_WAIT(); __syncthreads();
                mx = fmaxf(fmaxf(fmaxf(red[0], red[1]), fmaxf(red[2], red[3])), fmaxf(fmaxf(red[4], red[5]), fmaxf(red[6], red[7])));
                __syncthreads();
                u.kmax = sqrtf(mx) * 1.01f; }
        } else {
            const int s = i - NPU, sb = s / NHG, hg = s % NHG, hh = H0 + hg;
            constexpr int CL = MODE == 0 ? AWIN : PAST;
            const size_t row0 = (size_t)MP + (size_t)sb * ST;
            u.q = qkv + row0 * LDQ + hh * HD; u.nq = ST; u.qpos0 = CL; u.kv_len = CL + ST; u.new_pos0 = CL;
            u.kn = qkv + row0 * LDQ + D + hh * HD; u.vn = qkv + row0 * LDQ + 2 * D + hh * HD;
            const size_t coff = ((size_t)(layer * SB + sb) * CL * NHG + hg) * HD;
            u.kc = P.in[MODE == 0 ? 2 : (MODE == 1 ? 4 : 7)] + coff; u.vc = P.in[MODE == 0 ? 3 : (MODE == 1 ? 5 : 8)] + coff;
            u.cstride = NHG * HD;
            u.t_hi = (CL + ST - 1) >> 6; u.t_lo = 0;
            u.F = (const float*)(P.ws + WS_FS) + (size_t)sb * (PAST + ST) * HB + hg; u.fref = MODE == 1 ? u.F[(size_t)u.qpos0 * HB] : 0.f;
            u.rel = P.in[17] + (size_t)layer * 257 * HA + hh; u.kmax = __builtin_inff();
        }
        u.o = (bf16*)u.q; u.ostride = LDQ;
        if (probe_pass) { u.o = (bf16*)(P.ws + WS_H) + (u.q - qkv) / LDQ * LDH + (u.q - qkv) % LDQ; u.ostride = LDH; }
        if constexpr (MODE == 1) run_unit_b(C.lds, u, C.tid, C.wave, C.lane); else run_unit<MODE>(C.lds, u, C.tid, C.wave, C.lane);
    }
}
}


#ifndef PHASE_MASK
#define PHASE_MASK 0xFFF
#endif
#define PH(n) ((PHASE_MASK >> (n)) & 1)
#ifndef DUP_MASK
#define DUP_MASK 0
#endif
#define DUP(n) ((DUP_MASK >> (n)) & 1)
typedef const Params __attribute__((address_space(4)))* KParams;
__device__ __forceinline__ const Params& kparams() {
    KParams p = (KParams)__builtin_amdgcn_kernarg_segment_ptr(); asm volatile("" : "+s"(p)); return *(const Params*)p;
}
#define P (kparams())
__device__ __forceinline__ Ctx make_ctx(LAS unsigned char* lds) {
    Ctx C; int t = threadIdx.x; asm volatile("" : "+v"(t));
    C.lds = lds; C.tid = t; C.lane = t & 63; C.wave = __builtin_amdgcn_readfirstlane(t >> 6); C.G = gridDim.x; C.blk = blockIdx.x; return C;
}
__global__ void __launch_bounds__(512, 2) hse_fwd(Params P_unused) {
    extern __shared__ __attribute__((aligned(16))) unsigned char lds_raw[];
    LAS unsigned char* const lds = (LAS unsigned char*)lds_raw;
    volatile LAS unsigned* MISC = (volatile LAS unsigned*)(lds + MISC_OFF);
    if (threadIdx.x < 64) MISC[threadIdx.x] = 0u;
    __syncthreads();
    XcdBarrier bar = xcd_barrier_post((unsigned*)(P.ws + WS_CTL) + CW_BAR, MISC + 8);

    if (PH(0)) { const Params& Q = P; const Ctx C = make_ctx(lds); p0_prologue(Q, C); }
    xcd_barrier(bar);


#pragma unroll 1
    for (int layer = 0; layer < 2; ++layer) {
        if (DUP(1)) { const Params& Q = P; const Ctx C = make_ctx(lds); norm_phase<true>(Q, C, layer, layer == 0 ? Q.in[0] : Q.out + O_Y_P, nullptr, Q.in[13] + layer * D, 0, D, 0, nullptr, 0); }
        if (PH(1)) { const Params& Q = P; const Ctx C = make_ctx(lds); norm_phase<true>(Q, C, layer, layer == 0 ? Q.in[0] : Q.out + O_Y_P, layer == 0 ? Q.in[1] : Q.out + O_Y_S, Q.in[13] + layer * D, 0, D,
                                      layer == 0 ? 0 : DFF / 256, (const float*)(Q.ws + WS_MOD), 5 * D); }
        xcd_barrier(bar);
        if (PH(2)) { const Params& Q = P; const Ctx C = make_ctx(lds); fcum_phase(Q, C, layer); }
#ifdef PROBE_CLOCK
        if (layer == PROBE_CLOCK - 1 && blockIdx.x == 0 && threadIdx.x == 0) { const unsigned long long c = clock64(), t = wall_clock64(); MISC[16] = (unsigned)c; MISC[17] = (unsigned)(c >> 32); MISC[18] = (unsigned)t; MISC[19] = (unsigned)(t >> 32); }
#endif
        if (PH(3)) { const Params& Q = P; const Ctx C = make_ctx(lds); pg8::Gemm g{(const bf16*)(Q.ws + WS_H), (const bf16*)(Q.ws + WS_WIN + layer * SZ_WIN)}; pg8::StaticOrder<MP / 256, NQKV / 256> S; S.init(C.G, C.blk);
          pg8::EpiQKV E{(bf16*)(Q.ws + WS_QKV), Q.out, layer, (float*)(Q.ws + WS_KN2) + (size_t)layer * MP * HB};
          pg8::gemm_phase<pg8::EpiQKV, pg8::StaticOrder<MP / 256, NQKV / 256>, true, true, D, LDH, LDW>(C.lds + RING_OFF, g, S, E);
          if (DUP(3)) { __syncthreads(); pg8::gemm_phase<pg8::EpiQKV, pg8::StaticOrder<MP / 256, NQKV / 256>, true, true, D, LDH, LDW>(C.lds + RING_OFF, g, S, E); }
          pg8::SampleOrder<MP / 256, NQKV / 256, 8> SS; SS.init(C.G, C.blk); pg8::EpiPartial<NQKV> EP{(float*)(Q.ws + WS_PART)};
          pg8::gemm_phase<pg8::EpiPartial<NQKV>, pg8::SampleOrder<MP / 256, NQKV / 256, 8>, true, true, 256, LDH, LDW>(C.lds + RING_OFF, g, SS, EP); }
#ifdef PROBE_CLOCK
        if (layer == PROBE_CLOCK - 1 && blockIdx.x == 0 && threadIdx.x == 0) { const unsigned long long c = clock64(), t = wall_clock64();
            const unsigned long long c0 = ((unsigned long long)MISC[17] << 32) | MISC[16], t0 = ((unsigned long long)MISC[19] << 32) | MISC[18];
            MISC[20] = (unsigned)(((c - c0) * 100ull) / (t - t0)); }
#endif
        xcd_barrier(bar);
        if (PH(3)) { const Params& Q = P; const Ctx C = make_ctx(lds); finish_qkv(Q, C, layer); }
        xcd_barrier(bar);
#if DUP_MASK & 0x70
        if (DUP(4)) { const Params& Q = P; const Ctx C = make_ctx(lds); att::mode_loop<1>(Q, C, layer, 1); }
        if (DUP(5)) { const Params& Q = P; const Ctx C = make_ctx(lds); att::mode_loop<0>(Q, C, layer, 1); }
        if (DUP(6)) { const Params& Q = P; const Ctx C = make_ctx(lds); att::mode_loop<2>(Q, C, layer, 1); }
#endif
        if (PH(4)) { const Params& Q = P; const Ctx C = make_ctx(lds); att::mode_loop<1>(Q, C, layer, 0); }
        if (PH(5)) { const Params& Q = P; const Ctx C = make_ctx(lds); att::mode_loop<0>(Q, C, layer, 0); }
        if (PH(6)) { const Params& Q = P; const Ctx C = make_ctx(lds); att::mode_loop<2>(Q, C, layer, 0); }
        xcd_barrier(bar);
        if (PH(7)) { const Params& Q = P; const Ctx C = make_ctx(lds); pg8::Gemm g{(const bf16*)(Q.ws + WS_QKV), (const bf16*)(Q.ws + WS_WO + layer * SZ_WO)}; pg8::StaticOrder<MP / 256, D / 256> S; S.init(C.G, C.blk);
          pg8::EpiResid E{layer == 0 ? Q.in[0] : Q.out + O_Y_P, Q.out + O_Y_P, (const float*)(Q.ws + WS_MOD) + (size_t)layer * NMIDX * NMOD + 2 * D};
          pg8::gemm_phase<pg8::EpiResid, pg8::StaticOrder<MP / 256, D / 256>, true, true, D, LDQ, LDW>(C.lds + RING_OFF, g, S, E);
          pg8::SampleOrder<MP / 256, D / 256, 8> SS; SS.init(C.G, C.blk); pg8::EpiPartial<D> EP{(float*)(Q.ws + WS_PART)};
          pg8::gemm_phase<pg8::EpiPartial<D>, pg8::SampleOrder<MP / 256, D / 256, 8>, true, true, 256, LDQ, LDW>(C.lds + RING_OFF, g, SS, EP); }
        xcd_barrier(bar);
        if (PH(8)) { const Params& Q = P; const Ctx C = make_ctx(lds); norm_phase<false>(Q, C, layer, Q.out + O_Y_P, layer == 0 ? Q.in[1] : Q.out + O_Y_S, Q.in[14] + layer * D, 3 * D, 4 * D,
                                       D / 256, (const float*)(Q.ws + WS_MOD) + (size_t)layer * NMIDX * NMOD, 2 * D); }
        xcd_barrier(bar);
        if (PH(9)) { const Params& Q = P; const Ctx C = make_ctx(lds); pg8::Gemm g{(const bf16*)(Q.ws + WS_H), (const bf16*)(Q.ws + WS_WGU + layer * SZ_WGU)}; pg8::StaticOrder<MP / 256, 2 * DFF / 256> S; S.init(C.G, C.blk);
          pg8::EpiSwiGLU E{(bf16*)(Q.ws + WS_QKV)};
          pg8::gemm_phase<pg8::EpiSwiGLU, pg8::StaticOrder<MP / 256, 2 * DFF / 256>, true, true, D, LDH, LDW>(C.lds + RING_OFF, g, S, E);
          if (DUP(9)) { __syncthreads(); pg8::gemm_phase<pg8::EpiSwiGLU, pg8::StaticOrder<MP / 256, 2 * DFF / 256>, true, true, D, LDH, LDW>(C.lds + RING_OFF, g, S, E); }
          pg8::SampleOrder<MP / 256, 2 * DFF / 256, 4> SS; SS.init(C.G, C.blk); pg8::EpiPartial<2 * DFF> EP{(float*)(Q.ws + WS_PART)};
          pg8::gemm_phase<pg8::EpiPartial<2 * DFF>, pg8::SampleOrder<MP / 256, 2 * DFF / 256, 4>, true, true, 512, LDH, LDW>(C.lds + RING_OFF, g, SS, EP); }
        xcd_barrier(bar);
        if (PH(9)) { const Params& Q = P; const Ctx C = make_ctx(lds); finish_act(Q, C); }
        xcd_barrier(bar);
        if (PH(10)) { const Params& Q = P; const Ctx C = make_ctx(lds); pg8::Gemm g{(const bf16*)(Q.ws + WS_QKV), (const bf16*)(Q.ws + WS_WDN + layer * SZ_WDN)}; pg8::StaticOrder<MP / 256, D / 256> S; S.init(C.G, C.blk);
          pg8::EpiResid E{Q.out + O_Y_P, Q.out + O_Y_P, (const float*)(Q.ws + WS_MOD) + (size_t)layer * NMIDX * NMOD + 5 * D};
          pg8::gemm_phase<pg8::EpiResid, pg8::StaticOrder<MP / 256, D / 256>, true, true, DFF, LDACT, LDWD>(C.lds + RING_OFF, g, S, E);
          pg8::SampleOrder<MP / 256, D / 256, DFF / 256> SS; SS.init(C.G, C.blk); pg8::EpiPartial<D> EP{(float*)(Q.ws + WS_PART)};
          pg8::gemm_phase<pg8::EpiPartial<D>, pg8::SampleOrder<MP / 256, D / 256, DFF / 256>, true, true, 256, LDACT, LDWD>(C.lds + RING_OFF, g, SS, EP); }
        xcd_barrier(bar);
    }
    if (PH(11)) { const Params& Q = P; const Ctx C = make_ctx(lds); final_norm(Q, C); }
#ifdef PROBE_CLOCK
    if (blockIdx.x == 0 && threadIdx.x == 0) { const unsigned long long t0 = wall_clock64(), wait = (unsigned long long)MISC[20] * 100ull; while (wall_clock64() - t0 < wait) __builtin_amdgcn_s_sleep(8); }
#endif
}
#undef P

extern "C" void kernel_launch(void* const* d_in, const int* in_sizes, int n_in, void* d_out, int out_size, void* d_ws, size_t ws_size, hipStream_t stream) {
    static int grid = 0;
    if (grid == 0) {
        if (n_in != 23 || (size_t)out_size != O_END || ws_size < WS_END) {
            fprintf(stderr, "kernel_launch: unexpected shapes (n_in %d, out %d (want %zu), ws %zu (want >= %zu)); nothing launched\n", n_in, out_size, (size_t)O_END, ws_size, (size_t)WS_END); grid = -1; return; }
        int dev = 0, cus = 0, per_cu = 0;
        if (hipGetDevice(&dev) != hipSuccess || hipDeviceGetAttribute(&cus, hipDeviceAttributeMultiprocessorCount, dev) != hipSuccess) { grid = -1; return; }
        if (hipFuncSetAttribute((const void*)hse_fwd, hipFuncAttributeMaxDynamicSharedMemorySize, LDS_BYTES) != hipSuccess) { fprintf(stderr, "kernel_launch: hipFuncSetAttribute failed\n"); grid = -1; return; }
        if (hipOccupancyMaxActiveBlocksPerMultiprocessor(&per_cu, (const void*)hse_fwd, 512, LDS_BYTES) != hipSuccess || per_cu < 1) { fprintf(stderr, "kernel_launch: occupancy query says %d\n", per_cu); (void)hipGetLastError(); grid = -1; return; }
        grid = cus;
    }
    if (grid < 0) return;
    (void)in_sizes;
    if (hipMemsetAsync((char*)d_ws + WS_CTL, 0, CTL_ZERO_BYTES, stream) != hipSuccess) return;
    Params p{};
    for (int i = 0; i < 23; ++i) p.in[i] = (const float*)d_in[i];
    p.out = (float*)d_out; p.ws = (unsigned char*)d_ws;
    hipLaunchKernelGGL(hse_fwd, dim3(grid), dim3(512), LDS_BYTES, stream, p);
}
```

```cpp
#include <hip/hip_runtime.h>
#include <cstdio>
#include <cstdint>

#define LAS __attribute__((address_space(3)))
#define GAS __attribute__((address_space(1)))
typedef unsigned short bf16;
typedef short bf16x8 __attribute__((ext_vector_type(8)));
typedef float f32x4 __attribute__((ext_vector_type(4)));
typedef float f32x2 __attribute__((ext_vector_type(2)));
typedef float f32x16 __attribute__((ext_vector_type(16)));
typedef unsigned u32x4 __attribute__((ext_vector_type(4)));
typedef unsigned u32x2 __attribute__((ext_vector_type(2)));

constexpr int D = 2048, NH = 16, HD = 128, DFF = 5632, NQKV = 6144, NIN = 6150, NMOD = 6 * D;
constexpr int PB = 4, PT = 8192, SB = 8, ST = 32, PAST = 1024, AWIN = 512;
constexpr int HA = 4, HB = 6, HC = 6;
constexpr int MP = PB * PT, MS = SB * ST, MT = MP + MS;
#ifndef ROWPAD
#define ROWPAD 64
#endif
constexpr int LDQ = NQKV + ROWPAD, LDH = D + ROWPAD, LDACT = DFF + ROWPAD, LDW = D + ROWPAD, LDWD = DFF + ROWPAD;
constexpr float EPS = 1e-6f;
constexpr float ATT_SCALE = 0.08838834764831845f, INV_SCALE = 11.313708498984761f, LOG2E = 1.4426950408889634f, LN2 = 0.6931471805599453f;
constexpr int NMIDX = PB + SB;

constexpr size_t O_Y_P = 0;
constexpr size_t O_Y_S = O_Y_P + (size_t)MP * D;
constexpr size_t O_AK_P = O_Y_S + (size_t)MS * D;
constexpr size_t SZ_A_P = (size_t)2 * PB * AWIN * HA * HD, SZ_B_P = (size_t)2 * PB * PT * HB * HD, SZ_LF_P = (size_t)2 * PB * PT * HB;
constexpr size_t SZ_A_S = (size_t)2 * SB * ST * HA * HD, SZ_B_S = (size_t)2 * SB * ST * HB * HD, SZ_LF_S = (size_t)2 * SB * ST * HB;
constexpr size_t O_AV_P = O_AK_P + SZ_A_P, O_BK_P = O_AV_P + SZ_A_P, O_BV_P = O_BK_P + SZ_B_P, O_BLF_P = O_BV_P + SZ_B_P, O_CK_P = O_BLF_P + SZ_LF_P, O_CV_P = O_CK_P + SZ_B_P;
constexpr size_t O_AK_S = O_CV_P + SZ_B_P, O_AV_S = O_AK_S + SZ_A_S, O_BK_S = O_AV_S + SZ_A_S, O_BV_S = O_BK_S + SZ_B_S, O_BLF_S = O_BV_S + SZ_B_S, O_CK_S = O_BLF_S + SZ_LF_S, O_CV_S = O_CK_S + SZ_B_S;
constexpr size_t O_END = O_CV_S + SZ_B_S;

constexpr size_t MiB = 1u << 20;
constexpr size_t WS_CTL = 0, CTL_ZERO_BYTES = 6 * MiB;
constexpr size_t WS_MOD = 2 * MiB;
constexpr size_t SZ_WIN = (size_t)NQKV * LDW * 2, SZ_WO = (size_t)D * LDW * 2, SZ_WGU = (size_t)2 * DFF * LDW * 2, SZ_WDN = (size_t)D * LDWD * 2;
constexpr size_t WS_KN2 = 4 * MiB;
constexpr size_t WS_WIN = 6 * MiB, WS_WO = WS_WIN + 2 * SZ_WIN, WS_WGU = WS_WO + 2 * SZ_WO, WS_WDN = WS_WGU + 2 * SZ_WGU;
constexpr size_t WS_H = WS_WDN + 2 * SZ_WDN;
constexpr size_t WS_QKV = WS_H + (size_t)MT * LDH * 2;
constexpr size_t WS_CACHE = WS_QKV + (size_t)MT * LDQ * 2;
constexpr size_t SZ_CA = (size_t)2 * SB * AWIN * HA * HD * 2, SZ_CB = (size_t)2 * SB * PAST * HB * HD * 2;
constexpr size_t WS_CAK = WS_CACHE, WS_CAV = WS_CAK + SZ_CA, WS_CBK = WS_CAV + SZ_CA, WS_CBV = WS_CBK + SZ_CB, WS_CCK = WS_CBV + SZ_CB, WS_CCV = WS_CCK + SZ_CB;
constexpr size_t WS_FP = WS_CCV + SZ_CB;
constexpr size_t WS_FS = WS_FP + (size_t)PB * PT * HB * 4;
constexpr size_t WS_PART = (WS_FS + (size_t)SB * (PAST + ST) * HB * 4 + 4095) / 4096 * 4096;
constexpr size_t WS_END = WS_PART + (size_t)8 * MS * NQKV * 4 + 4096;
static_assert((size_t)4 * MS * 2 * DFF * 4 <= (size_t)8 * MS * NQKV * 4 && (size_t)22 * MS * D * 4 <= (size_t)8 * MS * NQKV * 4, "partials buffer");
static_assert((size_t)MT * LDACT * 2 <= (size_t)MT * LDQ * 2, "ACT overlays QKV");
constexpr int CW_TMO = 0, CW_BAR = 4096, CW_QUEUE = 16384;

constexpr int RING_OFF = 0, RING_BYTES = 131072;
constexpr int MISC_OFF = RING_BYTES;
constexpr int LDS_BYTES = 147456;

#define LDS_WAIT() asm volatile("s_waitcnt lgkmcnt(0)" ::: "memory")
#define VM_WAIT() asm volatile("s_waitcnt vmcnt(0)" ::: "memory")
__device__ __forceinline__ unsigned cvt_pk_bf16(float lo, float hi) { unsigned r; asm volatile("v_cvt_pk_bf16_f32 %0, %1, %2" : "=v"(r) : "v"(lo), "v"(hi)); return r; }
__device__ __forceinline__ float fast_exp2(float x) { return __builtin_amdgcn_exp2f(x); }
__device__ __forceinline__ float fast_log2(float x) { return __builtin_amdgcn_logf(x); }
__device__ __forceinline__ float fast_rcp(float x) { return __builtin_amdgcn_rcpf(x); }
template <int CTRL, int ROWMASK> __device__ __forceinline__ float dpp_take(float v) {
    return __builtin_bit_cast(float, __builtin_amdgcn_update_dpp(0, __builtin_bit_cast(int, v), CTRL, ROWMASK, 0xf, false));
}
__device__ __forceinline__ float wave_sum(float v) {
    v += dpp_take<0x111, 0xf>(v); v += dpp_take<0x112, 0xf>(v); v += dpp_take<0x114, 0xf>(v); v += dpp_take<0x118, 0xf>(v);
    v += dpp_take<0x142, 0xa>(v); v += dpp_take<0x143, 0xc>(v);
    return __builtin_bit_cast(float, __builtin_amdgcn_readlane(__builtin_bit_cast(int, v), 63));
}
namespace pg8 {
#define PG8_LAS __attribute__((address_space(3)))
typedef unsigned short bf16_t;
typedef short bf16x8 __attribute__((ext_vector_type(8)));
typedef float f32x4 __attribute__((ext_vector_type(4)));
typedef unsigned u32x4 __attribute__((ext_vector_type(4)));
constexpr int BM = 256, BK = 64, HALF = 128, HTB = HALF * BK * 2  , STAGE_BYTES = 8 * HTB, NXCD = 8, WGM = 8;

__host__ __device__ __forceinline__ int lds_byte(int r, int c) { const int st = (r >> 4) * 2 + (c >> 5), rr = r & 15, cc = c & 31, ob = rr * 64 + cc * 2; return st * 1024 + (ob ^ (((ob >> 9) & 1) << 5)); }
__host__ __device__ __forceinline__ void stage_rc(int b, int& R, int& C) { const int st = b / 1024, sb = b % 1024, swz = sb ^ (((sb >> 9) & 1) << 5); R = (st >> 1) * 16 + swz / 64; C = (st & 1) * 32 + (swz % 64) / 2; }
__host__ __device__ __forceinline__ int perm32(int rho) { const int n = rho >> 4, i = rho & 15; return 8 * (i >> 2) + 4 * n + (i & 3); }

struct Unit { int pm, pn, kc; };
struct Gemm { const bf16_t* A; const bf16_t* Bt; };

template <int NM, int NN> struct StaticOrder {
    int G, c;
    __host__ __device__ void init(int G_, int c_) { G = G_; c = c_; }
    __host__ __device__ bool next(int i, Unit& u) const {
        constexpr int nM = NM, nN = NN, nwg = NM * NN;
        const int L = i * G + c; if (L >= nwg) return false;
        int wgid = L; { constexpr int q = nwg / NXCD, r = nwg % NXCD; const int xcd = wgid % NXCD, off = wgid / NXCD; wgid = (xcd < r ? xcd * (q + 1) : r * (q + 1) + (xcd - r) * q) + off; }
        constexpr int nig = WGM * nN; const int gid = wgid / nig, fm = gid * WGM, gsz = (nM - fm) < WGM ? (nM - fm) : WGM;
        u.pm = fm + ((wgid % nig) % gsz); u.pn = (wgid % nig) / gsz; u.kc = 0; return true;
    }
    __device__ __forceinline__ void a_ready(const Unit&) const {}
    __device__ __forceinline__ void done(const Unit&) const {}
};

__device__ __forceinline__ unsigned cvt_pk_bf16(float lo, float hi) { unsigned r; asm volatile("v_cvt_pk_bf16_f32 %0, %1, %2" : "=v"(r) : "v"(lo), "v"(hi)); return r; }

struct EpiQKV {
    static constexpr bool PERM = true, AFTER_DRAIN = false, PROBE_DUP = true;
    bf16_t* QKV; float* out; int layer; float* kn2;
    __device__ __forceinline__ void operator()(const f32x4 (&acc)[2][2][4][2], const Unit& u, int wr, int wc, int fr, int fq) const {
        const int which = u.pn >> 3;
        const int rl0 = wr * 64 + fr;
        const int d0 = wc * 32 + 8 * fq;
        bf16_t* qbase = QKV + (size_t)(u.pm * BM + rl0) * ::LDQ + u.pn * BM + d0;
        float* fb[2]; int rstride[2]; bool en[2];
#pragma unroll
        for (int bj = 0; bj < 2; ++bj) {
            const int hh = (u.pn & 7) * 2 + bj;
            en[bj] = which != 0; fb[bj] = out; rstride[bj] = 0;
            if (which != 0) {
                const bool isv = which == 2;
                {
                    const int b = u.pm >> 5, t0 = (u.pm & 31) * 256;
                    if (hh < ::HA) { en[bj] = t0 >= ::PT - ::AWIN; rstride[bj] = ::HA * ::HD;
                        fb[bj] = out + (isv ? ::O_AV_P : ::O_AK_P) + ((size_t)((layer * ::PB + b) * ::AWIN + (t0 - (::PT - ::AWIN))) * ::HA + hh) * ::HD; }
                    else { const int hg = hh < ::HA + ::HB ? hh - ::HA : hh - ::HA - ::HB; rstride[bj] = ::HB * ::HD;
                        const size_t ob = hh < ::HA + ::HB ? (isv ? ::O_BV_P : ::O_BK_P) : (isv ? ::O_CV_P : ::O_CK_P);
                        fb[bj] = out + ob + ((size_t)((layer * ::PB + b) * ::PT + t0) * ::HB + hg) * ::HD; }
                }
            }
        }
#pragma unroll
        for (int ai = 0; ai < 2; ++ai)
#pragma unroll
            for (int m = 0; m < 4; ++m) { const int rl = rl0 + ai * HALF + m * 16; bf16_t* rowp = qbase + (size_t)(ai * HALF + m * 16) * ::LDQ;
#pragma unroll
                for (int bj = 0; bj < 2; ++bj) { const f32x4 v0 = acc[ai][bj][m][0], v1 = acc[ai][bj][m][1];
                    u32x4 w; w.x = cvt_pk_bf16(v0[0], v0[1]); w.y = cvt_pk_bf16(v0[2], v0[3]); w.z = cvt_pk_bf16(v1[0], v1[1]); w.w = cvt_pk_bf16(v1[2], v1[3]);
                    *(u32x4*)(rowp + bj * HALF) = w;
                    if (en[bj]) { float* fp = fb[bj] + (size_t)rl * rstride[bj] + d0; *(f32x4*)fp = v0; *(f32x4*)(fp + 4) = v1; }
                    if (which == 1) { const int hh = (u.pn & 7) * 2 + bj;
                        if (hh >= ::HA && hh < ::HA + ::HB) {
                            float s = (v0[0] * v0[0] + v0[1] * v0[1]) + (v0[2] * v0[2] + v0[3] * v0[3]) + (v1[0] * v1[0] + v1[1] * v1[1]) + (v1[2] * v1[2] + v1[3] * v1[3]);
                            s += __shfl_xor(s, 16); s += __shfl_xor(s, 32);
                            if (fq == 0) __hip_atomic_fetch_add(kn2 + (size_t)(u.pm * BM + rl) * ::HB + (hh - ::HA), s, __ATOMIC_RELAXED, __HIP_MEMORY_SCOPE_AGENT); } } } }
    }
};
struct EpiResid {
    static constexpr bool PERM = false, AFTER_DRAIN = false, PROBE_DUP = false;
    const float* xin_p; float* xout_p; const float* gate;
    __device__ __forceinline__ void operator()(const f32x4 (&acc)[2][2][4][2], const Unit& u, int wr, int wc, int fr, int fq) const {
        const float* xi = xin_p + (size_t)u.pm * BM * ::D; float* xo = xout_p + (size_t)u.pm * BM * ::D;
        const int col0 = u.pn * BM + wc * 32 + 4 * fq; const float* gp = gate + (size_t)(u.pm >> 5) * ::NMOD + col0;
        f32x4 gv[2][2];
#pragma unroll
        for (int bj = 0; bj < 2; ++bj)
#pragma unroll
            for (int n = 0; n < 2; ++n) gv[bj][n] = *(const f32x4*)(gp + bj * HALF + n * 16);
        f32x4 x0[2][2], x1[2][2], x2[2][2];
#define PG8_RLOAD(X, g_) do { const size_t off_ = (size_t)(((g_) >> 2) * HALF + wr * 64 + ((g_) & 3) * 16 + fr) * ::D + col0; \
            _Pragma("unroll") for (int bj = 0; bj < 2; ++bj) _Pragma("unroll") for (int n = 0; n < 2; ++n) X[bj][n] = *(const f32x4*)(xi + off_ + bj * HALF + n * 16); } while (0)
#define PG8_RSTORE(X, g_) do { const size_t off_ = (size_t)(((g_) >> 2) * HALF + wr * 64 + ((g_) & 3) * 16 + fr) * ::D + col0; \
            _Pragma("unroll") for (int bj = 0; bj < 2; ++bj) _Pragma("unroll") for (int n = 0; n < 2; ++n) *(f32x4*)(xo + off_ + bj * HALF + n * 16) = X[bj][n] + gv[bj][n] * acc[(g_) >> 2][bj][(g_) & 3][n]; } while (0)
#define PG8_FENCE asm volatile("" ::: "memory")
        PG8_RLOAD(x0, 0); PG8_RLOAD(x1, 1);
        PG8_RLOAD(x2, 2); PG8_FENCE; PG8_RSTORE(x0, 0); PG8_FENCE;
        PG8_RLOAD(x0, 3); PG8_FENCE; PG8_RSTORE(x1, 1); PG8_FENCE;
        PG8_RLOAD(x1, 4); PG8_FENCE; PG8_RSTORE(x2, 2); PG8_FENCE;
        PG8_RLOAD(x2, 5); PG8_FENCE; PG8_RSTORE(x0, 3); PG8_FENCE;
        PG8_RLOAD(x0, 6); PG8_FENCE; PG8_RSTORE(x1, 4); PG8_FENCE;
        PG8_RLOAD(x1, 7); PG8_FENCE; PG8_RSTORE(x2, 5); PG8_FENCE;
        PG8_RSTORE(x0, 6); PG8_RSTORE(x1, 7);
#undef PG8_FENCE
#undef PG8_RLOAD
#undef PG8_RSTORE
    }
};
struct EpiSwiGLU {
    static constexpr bool PERM = true, AFTER_DRAIN = false, PROBE_DUP = false;
    bf16_t* ACT;
    __device__ __forceinline__ void operator()(const f32x4 (&acc)[2][2][4][2], const Unit& u, int wr, int wc, int fr, int fq) const {
        bf16_t* base = ACT + (size_t)(u.pm * BM + wr * 64 + fr) * ::LDACT + u.pn * HALF + wc * 32 + 8 * fq;
#pragma unroll
        for (int ai = 0; ai < 2; ++ai)
#pragma unroll
            for (int m = 0; m < 4; ++m) { float r[8];
#pragma unroll
                for (int n = 0; n < 2; ++n)
#pragma unroll
                    for (int j = 0; j < 4; ++j) { const float g = acc[ai][0][m][n][j], up = acc[ai][1][m][n][j];
                        r[4 * n + j] = g * __builtin_amdgcn_rcpf(1.0f + __builtin_amdgcn_exp2f(-g * ::LOG2E)) * up; }
                u32x4 w; w.x = cvt_pk_bf16(r[0], r[1]); w.y = cvt_pk_bf16(r[2], r[3]); w.z = cvt_pk_bf16(r[4], r[5]); w.w = cvt_pk_bf16(r[6], r[7]);
                *(u32x4*)(base + (size_t)(ai * HALF + m * 16) * ::LDACT) = w; }
    }
};


template <int PM, int NN, int NKC> struct SampleOrder {
    int G, c;
    __host__ __device__ void init(int G_, int c_) { G = G_; c = c_; }
    __host__ __device__ bool next(int i, Unit& u) const { const int L = i * G + c; if (L >= NN * NKC) return false; u.pm = PM; u.pn = L % NN; u.kc = L / NN; return true; }
    __device__ __forceinline__ void a_ready(const Unit&) const {}
    __device__ __forceinline__ void done(const Unit&) const {}
};
template <int N> struct EpiPartial {
    static constexpr bool PERM = false, AFTER_DRAIN = false, PROBE_DUP = false;
    float* part;
    __device__ __forceinline__ void operator()(const f32x4 (&acc)[2][2][4][2], const Unit& u, int wr, int wc, int fr, int fq) const {
        float* base = part + ((size_t)u.kc * BM + wr * 64 + fr) * N + u.pn * BM + wc * 32 + 4 * fq;
#pragma unroll
        for (int ai = 0; ai < 2; ++ai)
#pragma unroll
            for (int m = 0; m < 4; ++m) { float* rowp = base + (size_t)(ai * HALF + m * 16) * N;
#pragma unroll
                for (int bj = 0; bj < 2; ++bj)
#pragma unroll
                    for (int n = 0; n < 2; ++n) *(f32x4*)(rowp + bj * HALF + n * 16) = acc[ai][bj][m][n]; }
    }
};


template <class Epi, class Sched, bool ALIGN_EPI, bool SP2, int KK, int LDA, int LDB = KK>
__device__ __forceinline__ void gemm_phase(PG8_LAS unsigned char* lds, const Gemm g, const Sched& S, const Epi& E) {
    int tid = threadIdx.x; asm volatile("" : "+v"(tid));
    const int wid = __builtin_amdgcn_readfirstlane(tid >> 6), lane = tid & 63, wr = wid >> 2, wc = wid & 3, fr = lane & 15, fq = lane >> 4;
    constexpr int K = KK, nt = K / BK, lda = LDA, ldb = LDB;
    unsigned voffA[2], voffB[2];
#pragma unroll
    for (int i = 0; i < 2; ++i) { int R, C; stage_rc(tid * 16 + i * 8192, R, C); const int Rb = Epi::PERM ? ((R & ~31) + perm32(R & 31)) : R;
        voffA[i] = (unsigned)(R * lda + C) * 2u; voffB[i] = (unsigned)(Rb * ldb + C) * 2u; }
    constexpr size_t kstep = (size_t)(BK * 2);
    constexpr size_t hstepA = (size_t)HALF * lda * 2, hstepB = (size_t)HALF * ldb * 2;
    constexpr size_t tstepA = 2 * hstepA, tstepB = 2 * hstepB;
    const unsigned ldsw = (unsigned)wid * 1024u;
    const int aoff = lds_byte(wr * 64 + fr, fq * 8), boff = lds_byte(wc * 32 + fr, fq * 8);
#define PG8_SA(b, h) (((b) * 2 + (h)) * HTB)
#define PG8_SB(b, h) ((4 + (b) * 2 + (h)) * HTB)
#define PG8_STAGE(bufoff, gbase, voff) do { _Pragma("unroll") for (int _i = 0; _i < 2; ++_i) \
        __builtin_amdgcn_global_load_lds((const unsigned*)((const char*)(gbase) + (voff)[_i]), (PG8_LAS unsigned*)(lds + (bufoff) + ldsw + _i * 8192), 16, 0, 0); } while (0)
#define PG8_LDA(dst, b, h) do { _Pragma("unroll") for (int m = 0; m < 4; ++m) _Pragma("unroll") for (int k = 0; k < 2; ++k) dst[m][k] = *(const PG8_LAS bf16x8*)(lds + PG8_SA(b, h) + aoff + m * 2048 + k * 1024); } while (0)
#define PG8_LDB(dst, b, h) do { _Pragma("unroll") for (int n = 0; n < 2; ++n) _Pragma("unroll") for (int k = 0; k < 2; ++k) dst[n][k] = *(const PG8_LAS bf16x8*)(lds + PG8_SB(b, h) + boff + n * 2048 + k * 1024); } while (0)
#define PG8_MMA(ai, bj, At, Bt) do { __builtin_amdgcn_s_setprio(1); _Pragma("unroll") for (int m = 0; m < 4; ++m) _Pragma("unroll") for (int n = 0; n < 2; ++n) _Pragma("unroll") for (int k = 0; k < 2; ++k) \
        acc[ai][bj][m][n] = __builtin_amdgcn_mfma_f32_16x16x32_bf16(Bt[n][k], At[m][k], acc[ai][bj][m][n], 0, 0, 0); __builtin_amdgcn_s_setprio(0); } while (0)
#define PG8_WAIT_V(n) asm volatile("s_waitcnt vmcnt(" #n ")" ::: "memory")
#define PG8_WAIT_L(n) asm volatile("s_waitcnt lgkmcnt(" #n ")" ::: "memory")
#define PG8_BAR __builtin_amdgcn_s_barrier()
#define PG8_SCHED __builtin_amdgcn_sched_barrier(0)
    Unit cur, nxt; int ui = 0;
    if (!S.next(0, cur)) return;
    f32x4 acc[2][2][4][2];
#pragma unroll
    for (int a = 0; a < 2; ++a)
#pragma unroll
        for (int b = 0; b < 2; ++b)
#pragma unroll
            for (int m = 0; m < 4; ++m)
#pragma unroll
                for (int n = 0; n < 2; ++n) acc[a][b][m][n] = (f32x4){0.f, 0.f, 0.f, 0.f};
    bf16x8 At[4][2], B0[2][2], B1[2][2];
    const char* cA = (const char*)g.A + (size_t)cur.pm * tstepA + (size_t)cur.kc * (K * 2); const char* cB = (const char*)g.Bt + (size_t)cur.pn * tstepB + (size_t)cur.kc * (K * 2);
    S.a_ready(cur);
    if constexpr (SP2) {
        PG8_STAGE(PG8_SB(0, 0), cB, voffB); PG8_STAGE(PG8_SB(0, 1), cB + hstepB, voffB); PG8_STAGE(PG8_SA(0, 0), cA, voffA); PG8_STAGE(PG8_SA(0, 1), cA + hstepA, voffA);
        if (wr == 1) PG8_BAR;
        PG8_WAIT_V(2); PG8_BAR;
        PG8_STAGE(PG8_SB(1, 0), cB + kstep, voffB); PG8_STAGE(PG8_SA(1, 0), cA + kstep, voffA); PG8_STAGE(PG8_SB(1, 1), cB + hstepB + kstep, voffB);
        PG8_WAIT_V(6); PG8_BAR;
    } else {
        PG8_STAGE(PG8_SB(0, 0), cB, voffB); PG8_STAGE(PG8_SA(0, 0), cA, voffA); PG8_STAGE(PG8_SB(0, 1), cB + hstepB, voffB); PG8_STAGE(PG8_SA(0, 1), cA + hstepA, voffA);
        if (wr == 1) PG8_BAR;
        PG8_WAIT_V(4); PG8_BAR;
        PG8_STAGE(PG8_SB(1, 0), cB + kstep, voffB); PG8_STAGE(PG8_SA(1, 0), cA + kstep, voffA); PG8_STAGE(PG8_SB(1, 1), cB + hstepB + kstep, voffB);
        PG8_WAIT_V(6); PG8_BAR;
    }
    for (;;) {
        const bool has_next = S.next(ui + 1, nxt);
        const char* nA = has_next ? (const char*)g.A + (size_t)nxt.pm * tstepA + (size_t)nxt.kc * (K * 2) : cA; const char* nB = has_next ? (const char*)g.Bt + (size_t)nxt.pn * tstepB + (size_t)nxt.kc * (K * 2) : cB;
#pragma unroll 1
        for (int t = 0; t < nt; t += 2) {
            const bool last = (t == nt - 2);
            const char* a1 = cA + (size_t)(t + 1) * kstep;
            const char* a2 = last ? nA : cA + (size_t)(t + 2) * kstep; const char* b2 = last ? nB : cB + (size_t)(t + 2) * kstep;
            const char* a3 = a2 + kstep; const char* b3 = b2 + kstep;
            if (last && has_next) S.a_ready(nxt);
            if constexpr (SP2) {
            PG8_LDB(B0, 0, 0); PG8_LDB(B1, 0, 1); PG8_SCHED; PG8_LDA(At, 0, 0); PG8_STAGE(PG8_SA(1, 1), a1 + hstepA, voffA);
            PG8_WAIT_V(8); PG8_WAIT_L(0); PG8_BAR; PG8_MMA(0, 0, At, B0); PG8_MMA(0, 1, At, B1); PG8_BAR; PG8_SCHED;
            PG8_LDA(At, 0, 1); PG8_STAGE(PG8_SB(0, 0), b2, voffB); PG8_STAGE(PG8_SB(0, 1), b2 + hstepB, voffB); PG8_STAGE(PG8_SA(0, 0), a2, voffA);
            PG8_WAIT_V(8); PG8_WAIT_L(0); PG8_BAR; PG8_MMA(1, 0, At, B0); PG8_MMA(1, 1, At, B1); PG8_BAR; PG8_SCHED;
            PG8_LDB(B0, 1, 0); PG8_LDB(B1, 1, 1); PG8_SCHED; PG8_LDA(At, 1, 0); PG8_STAGE(PG8_SA(0, 1), a2 + hstepA, voffA);
            PG8_WAIT_V(8); PG8_WAIT_L(0); PG8_BAR; PG8_MMA(0, 0, At, B0); PG8_MMA(0, 1, At, B1); PG8_BAR; PG8_SCHED;
            PG8_LDA(At, 1, 1); PG8_STAGE(PG8_SB(1, 0), b3, voffB); PG8_STAGE(PG8_SB(1, 1), b3 + hstepB, voffB); PG8_STAGE(PG8_SA(1, 0), a3, voffA);
            PG8_WAIT_V(8); PG8_WAIT_L(0); PG8_BAR; PG8_MMA(1, 0, At, B0); PG8_MMA(1, 1, At, B1); PG8_BAR; PG8_SCHED;
            } else {
            PG8_LDB(B0, 0, 0); PG8_SCHED; PG8_LDA(At, 0, 0); PG8_STAGE(PG8_SA(1, 1), a1 + hstepA, voffA);
            PG8_WAIT_L(8); PG8_BAR; PG8_WAIT_L(0); PG8_MMA(0, 0, At, B0); PG8_BAR; PG8_SCHED;
            PG8_LDB(B1, 0, 1); PG8_STAGE(PG8_SB(0, 0), b2, voffB);
            PG8_BAR; PG8_WAIT_L(0); PG8_MMA(0, 1, At, B1); PG8_BAR;
            PG8_LDA(At, 0, 1); PG8_STAGE(PG8_SA(0, 0), a2, voffA);
            PG8_BAR; PG8_WAIT_L(0); PG8_MMA(1, 0, At, B0); PG8_BAR; PG8_SCHED;
            PG8_STAGE(PG8_SB(0, 1), b2 + hstepB, voffB);
            PG8_WAIT_V(6); PG8_BAR; PG8_MMA(1, 1, At, B1); PG8_BAR;
            PG8_LDB(B0, 1, 0); PG8_SCHED; PG8_LDA(At, 1, 0); PG8_STAGE(PG8_SA(0, 1), a2 + hstepA, voffA);
            PG8_WAIT_L(8); PG8_BAR; PG8_WAIT_L(0); PG8_MMA(0, 0, At, B0); PG8_BAR; PG8_SCHED;
            PG8_LDB(B1, 1, 1); PG8_STAGE(PG8_SB(1, 0), b3, voffB);
            PG8_BAR; PG8_WAIT_L(0); PG8_MMA(0, 1, At, B1); PG8_BAR;
            PG8_LDA(At, 1, 1); PG8_STAGE(PG8_SA(1, 0), a3, voffA);
            PG8_BAR; PG8_WAIT_L(0); PG8_MMA(1, 0, At, B0); PG8_BAR; PG8_SCHED;
            PG8_STAGE(PG8_SB(1, 1), b3 + hstepB, voffB);
            PG8_WAIT_V(6); PG8_BAR; PG8_MMA(1, 1, At, B1); PG8_BAR;
            }
        }
        if constexpr (ALIGN_EPI) { if (wr == 0) PG8_BAR; }
        if constexpr (!Epi::AFTER_DRAIN) { E(acc, cur, wr, wc, fr, fq);
#ifdef PROBE_EPI_DUP
            if constexpr (Epi::PROBE_DUP) { asm volatile("" ::: "memory"); E(acc, cur, wr, wc, fr, fq); }
#endif
            S.done(cur); }
        if (!has_next) break;
#pragma unroll
        for (int a = 0; a < 2; ++a)
#pragma unroll
            for (int b = 0; b < 2; ++b)
#pragma unroll
                for (int m = 0; m < 4; ++m)
#pragma unroll
                    for (int n = 0; n < 2; ++n) acc[a][b][m][n] = (f32x4){0.f, 0.f, 0.f, 0.f};
        cur = nxt; cA = nA; cB = nB; ++ui;
        if constexpr (ALIGN_EPI) { if (wr == 1) PG8_BAR; }
    }
    PG8_WAIT_V(0);
    if constexpr (!ALIGN_EPI) { if (wr == 0) PG8_BAR; }
    PG8_BAR;
    if constexpr (Epi::AFTER_DRAIN) { E.fused(acc, cur, wr, wc, fr, fq, lds, wid, lane); S.done(cur); }
#undef PG8_SA
#undef PG8_SB
#undef PG8_STAGE
#undef PG8_LDA
#undef PG8_LDB
#undef PG8_MMA
#undef PG8_WAIT_V
#undef PG8_WAIT_L
#undef PG8_BAR
#undef PG8_SCHED
}
}

#define XB_TMO      128
#define XB_XCNT(j)  (256  + 64 * (j))
#define XB_XSUB(j)  (1280 + 64 * (j))
#define XB_XGEN(j)  (2304 + 64 * (j))
#define XB_TOP      3328
#define XB_TOPGEN   3392
#define XCD_BAR_WORDS 3456
#define XB_SPIN_CAP (1u << 18)

__device__ __forceinline__ unsigned xb_ld(unsigned* p)              { return __hip_atomic_load(p, __ATOMIC_RELAXED, __HIP_MEMORY_SCOPE_AGENT); }
__device__ __forceinline__ unsigned xb_add(unsigned* p, unsigned v) { return __hip_atomic_fetch_add(p, v, __ATOMIC_RELAXED, __HIP_MEMORY_SCOPE_AGENT); }
__device__ __forceinline__ unsigned xb_xcc_id() { return (unsigned)__builtin_amdgcn_s_getreg((3 << 11) | 20) & 0xFu; }
#define XB_SPIN(cond, bar) do { unsigned _sp = 0; while (cond) { __builtin_amdgcn_s_sleep(1); \
    if ((++_sp & 255u) == 0u) { if (xb_ld(&(bar)[XB_TMO])) break; if (_sp > XB_SPIN_CAP) { atomicAdd(&(bar)[XB_TMO], 1u); break; } } } } while (0)

struct XcdBarrier {
    unsigned* bar; unsigned x;
    volatile LAS unsigned* st;
};

__device__ __forceinline__ XcdBarrier xcd_barrier_post(unsigned* bar, volatile LAS unsigned* st) {
    XcdBarrier b; b.bar = bar; b.x = xb_xcc_id(); b.st = st;
    if (threadIdx.x == 0) (void)xb_add(&bar[XB_XCNT(b.x)], 1u);
    return b;
}
__device__ __forceinline__ void xcd_barrier_complete(unsigned* bar, unsigned x, unsigned& nloc, unsigned& nx) {
    const unsigned G = gridDim.x * gridDim.y * gridDim.z;
    unsigned sum, cnt, mine, sp = 0u;
    for (;;) {
        sum = 0u; cnt = 0u; mine = 0u;
#pragma unroll
        for (unsigned j = 0; j < 16; ++j) { const unsigned c = xb_ld(&bar[XB_XCNT(j)]); sum += c; cnt += (c > 0u) ? 1u : 0u; mine = (j == x) ? c : mine; }
        if (sum == G) break;
        __builtin_amdgcn_s_sleep(1);
        if ((++sp & 255u) == 0u) { if (xb_ld(&bar[XB_TMO])) break; if (sp > XB_SPIN_CAP) { atomicAdd(&bar[XB_TMO], 1u); break; } }
    }
    nloc = mine > 0u ? mine : 1u; nx = cnt > 0u ? cnt : 1u;
}

__device__ __forceinline__ void xcd_barrier(const XcdBarrier& b) {
    asm volatile("s_waitcnt vmcnt(0)" ::: "memory");
    __syncthreads();
    if (threadIdx.x == 0) {
        unsigned* bar = b.bar; asm volatile("" : "+s"(bar));
        __builtin_amdgcn_s_waitcnt(0);
        unsigned nloc = b.st[0], nx = b.st[1];
        unsigned bx = b.x; asm volatile("" : "+s"(bx));
        if (nloc == 0u) { xcd_barrier_complete(bar, bx, nloc, nx); b.st[0] = nloc; b.st[1] = nx; }
        const unsigned old = xb_add(&bar[XB_XSUB(bx)], 1u);
        const unsigned gen = old / nloc;
        if (old + 1u == (gen + 1u) * nloc) {
            __builtin_amdgcn_fence(__ATOMIC_RELEASE, "agent");
            asm volatile("s_waitcnt vmcnt(0)" ::: "memory");
            const unsigned og = xb_add(&bar[XB_TOP], 1u);
            const unsigned tg = og / nx;
            if (og + 1u == (tg + 1u) * nx) xb_add(&bar[XB_TOPGEN], 1u);
            else XB_SPIN(xb_ld(&bar[XB_TOPGEN]) == tg, bar);
            __builtin_amdgcn_fence(__ATOMIC_ACQUIRE, "agent");
            xb_add(&bar[XB_XGEN(bx)], 1u);
            asm volatile("s_waitcnt vmcnt(0)" ::: "memory");
        } else {
            XB_SPIN(xb_ld(&bar[XB_XGEN(bx)]) == gen, bar);
            __builtin_amdgcn_fence(__ATOMIC_ACQUIRE, "agent");
            asm volatile("s_waitcnt vmcnt(0)" ::: "memory");
        }
    }
    __syncthreads();
}
struct Params {
    const float* in[23];
    float* out;
    unsigned char* ws;
};

struct Ctx {
    LAS unsigned char* lds;
    int tid, lane, wave, G, blk;
};

__device__ __forceinline__ void transpose_item(const float* W, int ld, bf16* WT, int Kd, int k0, int n0, int drow0, LAS float* scr, int lane) {
#pragma unroll 8
    for (int i = 0; i < 32; ++i) { const int kk = 2 * i + (lane >> 5); scr[kk * 33 + (lane & 31)] = W[(size_t)(k0 + kk) * ld + n0 + (lane & 31)]; }
    LDS_WAIT(); asm volatile("" ::: "memory");
    const int c = lane & 7;
#pragma unroll
    for (int j = 0; j < 4; ++j) { const int n = (lane >> 3) + 8 * j; const LAS float* s = scr + (8 * c) * 33 + n;
        u32x4 o; o.x = cvt_pk_bf16(s[0 * 33], s[1 * 33]); o.y = cvt_pk_bf16(s[2 * 33], s[3 * 33]); o.z = cvt_pk_bf16(s[4 * 33], s[5 * 33]); o.w = cvt_pk_bf16(s[6 * 33], s[7 * 33]);
        *(u32x4*)(WT + (size_t)(drow0 + n) * Kd + k0 + 8 * c) = o; }
    LDS_WAIT(); asm volatile("" ::: "memory");
}

__device__ __forceinline__ void cvt_copy(const float* src, bf16* dst, size_t n8, size_t i0, size_t stride) {
    for (size_t i = i0; i < n8; i += stride) { const f32x4 a = *(const f32x4*)(src + i * 8), b = *(const f32x4*)(src + i * 8 + 4);
        u32x4 o; o.x = cvt_pk_bf16(a[0], a[1]); o.y = cvt_pk_bf16(a[2], a[3]); o.z = cvt_pk_bf16(b[0], b[1]); o.w = cvt_pk_bf16(b[2], b[3]);
        *(u32x4*)(dst + i * 8) = o; }
}

__device__ __forceinline__ void p0_prologue(const Params& P, const Ctx& C) {
    unsigned char* ws = P.ws;
    {
        LAS float* scr = (LAS float*)(C.lds + RING_OFF + C.wave * 16384);
        const int gw = C.blk * 8 + C.wave, NGW = C.G * 8;
        constexpr int I_IN = (D / 64) * (NQKV / 32), I_O = (D / 64) * (D / 32), I_G = (D / 64) * (DFF / 32), I_D = (DFF / 64) * (D / 32);
        constexpr int I_L = I_IN + I_O + 2 * I_G + I_D;
        for (int it = gw; it < 2 * I_L; it += NGW) {
            const int l = it / I_L; int r = it % I_L;
            if (r < I_IN) { const int nb = NQKV / 32, kb = r / nb, n0 = (r % nb) * 32;
                transpose_item(P.in[15] + (size_t)l * D * NIN, NIN, (bf16*)(ws + WS_WIN + l * SZ_WIN), LDW, kb * 64, n0, n0, scr, C.lane); continue; }
            r -= I_IN;
            if (r < I_O) { const int nb = D / 32, kb = r / nb, n0 = (r % nb) * 32;
                transpose_item(P.in[18] + (size_t)l * D * D, D, (bf16*)(ws + WS_WO + l * SZ_WO), LDW, kb * 64, n0, n0, scr, C.lane); continue; }
            r -= I_O;
            if (r < 2 * I_G) { const int up = r >= I_G; if (up) r -= I_G; const int nb = DFF / 32, kb = r / nb, n0 = (r % nb) * 32;
                const int drow0 = (n0 >> 7) * 256 + (n0 & 127) + (up ? 128 : 0);
                transpose_item(P.in[up ? 20 : 19] + (size_t)l * D * DFF, DFF, (bf16*)(ws + WS_WGU + l * SZ_WGU), LDW, kb * 64, n0, drow0, scr, C.lane); continue; }
            r -= 2 * I_G;
            { const int nb = D / 32, kb = r / nb, n0 = (r % nb) * 32;
                transpose_item(P.in[21] + (size_t)l * DFF * D, D, (bf16*)(ws + WS_WDN + l * SZ_WDN), LDWD, kb * 64, n0, n0, scr, C.lane); }
        }
    }
    {
        __syncthreads();
        LAS float* st = (LAS float*)(C.lds + RING_OFF);
        for (int idx = C.tid; idx < NMIDX * D; idx += 512) { const int m = idx / D, k = idx % D;
            const float c = m < PB ? P.in[9][m * D + k] : P.in[10][(m - PB) * D + k];
            st[k * NMIDX + m] = c * fast_rcp(1.0f + fast_exp2(-c * LOG2E)); }
        __syncthreads();
        float* mod = (float*)(ws + WS_MOD);
        constexpr int KC = 256, NKC = D / KC, NNC = NMOD / 256;
        for (int it = C.wave * C.G + C.blk; it < 2 * NKC * NNC; it += 8 * C.G) {
            const int l = it / (NKC * NNC), r = it % (NKC * NNC), kc = r / NNC, nc = r % NNC, k0 = kc * KC, n0 = nc * 256 + C.lane * 4;
            const float* wp = P.in[11] + ((size_t)l * D + k0) * NMOD + n0;
            f32x4 acc[NMIDX];
#pragma unroll
            for (int m = 0; m < NMIDX; ++m) acc[m] = (f32x4){0.f, 0.f, 0.f, 0.f};
#pragma unroll 4
            for (int k = 0; k < KC; ++k) { const f32x4 w = *(const f32x4*)(wp + (size_t)k * NMOD);
                const LAS f32x4* sp = (const LAS f32x4*)(st + (k0 + k) * NMIDX); const f32x4 s0 = sp[0], s1 = sp[1], s2 = sp[2];
                acc[0] += w * s0[0]; acc[1] += w * s0[1]; acc[2] += w * s0[2]; acc[3] += w * s0[3];
                acc[4] += w * s1[0]; acc[5] += w * s1[1]; acc[6] += w * s1[2]; acc[7] += w * s1[3];
                acc[8] += w * s2[0]; acc[9] += w * s2[1]; acc[10] += w * s2[2]; acc[11] += w * s2[3]; }
            f32x4 bias = (f32x4){0.f, 0.f, 0.f, 0.f};
            if (kc == 0) bias = *(const f32x4*)(P.in[12] + (size_t)l * NMOD + n0);
#pragma unroll
            for (int m = 0; m < NMIDX; ++m) { float* mp = mod + ((size_t)l * NMIDX + m) * NMOD + n0;
#pragma unroll
                for (int j = 0; j < 4; ++j) __hip_atomic_fetch_add(mp + j, acc[m][j] + bias[j], __ATOMIC_RELAXED, __HIP_MEMORY_SCOPE_AGENT); }
        }
    }
}

template <bool WITH_LOGF>
__device__ __forceinline__ void norm_rows(const Ctx& C, const float* xrows, bf16* hrows, int nrows, const float* gvec, const float* shift, const float* scale,
                                          const LAS float* wf, const float* bf, float* lf_out) {
    f32x4 gm[8], sh[8];
#pragma unroll
    for (int j = 0; j < 8; ++j) { const int e = 4 * C.lane + 256 * j; const f32x4 g = *(const f32x4*)(gvec + e), sc = *(const f32x4*)(scale + e); sh[j] = *(const f32x4*)(shift + e); gm[j] = g * (sc + 1.0f); }
    f32x4 nx[8];
#pragma unroll
    for (int j = 0; j < 8; ++j) nx[j] = *(const f32x4*)(xrows + 4 * C.lane + 256 * j);
    for (int r = 0; r < nrows; ++r) {
        f32x4 v[8]; float ss = 0.f;
#pragma unroll
        for (int j = 0; j < 8; ++j) v[j] = nx[j];
        if (r + 1 < nrows) { const float* xr = xrows + (size_t)(r + 1) * D;
#pragma unroll
            for (int j = 0; j < 8; ++j) nx[j] = *(const f32x4*)(xr + 4 * C.lane + 256 * j); }
        asm volatile("" ::: "memory");
#pragma unroll
        for (int j = 0; j < 8; ++j) ss += (v[j][0] * v[j][0] + v[j][1] * v[j][1]) + (v[j][2] * v[j][2] + v[j][3] * v[j][3]);
        const float rstd = 1.0f / sqrtf(wave_sum(ss) * (1.0f / D) + EPS);
#pragma unroll
        for (int j = 0; j < 8; ++j) v[j] = v[j] * rstd * gm[j] + sh[j];
        bf16* hr = hrows + (size_t)r * LDH;
#pragma unroll
        for (int j = 0; j < 8; ++j) { u32x2 w; w.x = cvt_pk_bf16(v[j][0], v[j][1]); w.y = cvt_pk_bf16(v[j][2], v[j][3]); *(u32x2*)(hr + 4 * C.lane + 256 * j) = w; }
        if constexpr (WITH_LOGF) {
            float dots[6];
#pragma unroll
            for (int f = 0; f < 6; ++f) { float a = 0.f;
#pragma unroll
                for (int j = 0; j < 8; ++j) { const f32x4 w = *(const LAS f32x4*)(wf + f * D + 4 * C.lane + 256 * j); a += (v[j][0] * w[0] + v[j][1] * w[1]) + (v[j][2] * w[2] + v[j][3] * w[3]); }
                dots[f] = wave_sum(a); }
            if (C.lane < 6) { float z = C.lane == 0 ? dots[0] : C.lane == 1 ? dots[1] : C.lane == 2 ? dots[2] : C.lane == 3 ? dots[3] : C.lane == 4 ? dots[4] : dots[5];
                z += bf[C.lane];
                const float ls = fminf(z, 0.f) - LN2 * fast_log2(1.0f + fast_exp2(-fabsf(z) * LOG2E));
                lf_out[(size_t)r * HB + C.lane] = ls; }
        }
    }
}

__device__ __forceinline__ void sample_resid_row(const Ctx& C, const float* xin, float* xout, const float* part, int nkc, const float* gate) {
    f32x4 s[8];
#pragma unroll
    for (int j = 0; j < 8; ++j) s[j] = (f32x4){0.f, 0.f, 0.f, 0.f};
    for (int kc = 0; kc < nkc; ++kc) { const float* pp = part + (size_t)kc * MS * D;
#pragma unroll
        for (int j = 0; j < 8; ++j) s[j] += *(const f32x4*)(pp + 4 * C.lane + 256 * j); }
#pragma unroll
    for (int j = 0; j < 8; ++j) { const int e = 4 * C.lane + 256 * j; *(f32x4*)(xout + e) = *(const f32x4*)(xin + e) + *(const f32x4*)(gate + e) * s[j]; }
}
template <bool WITH_LOGF>
__device__ __forceinline__ void norm_phase(const Params& P, const Ctx& C, int layer, const float* xp, const float* xs, const float* gvec, int off_shift, int off_scale,
                                           int fix_nkc, const float* fix_mod, int fix_gate_off) {
    bf16* H = (bf16*)(P.ws + WS_H); const float* mod = (const float*)(P.ws + WS_MOD) + (size_t)layer * NMIDX * NMOD;
    LAS float* wf = (LAS float*)(C.lds + RING_OFF);
    if constexpr (WITH_LOGF) {
        const float* win = P.in[15] + (size_t)layer * D * NIN + NQKV;
        for (int idx = C.tid; idx < 6 * D; idx += 512) { const int k = idx / 6, f = idx % 6; wf[f * D + k] = win[(size_t)k * NIN + f]; }
        __syncthreads();
    }
    const float* bf = P.in[16] + layer * HB;
    float* lfp = P.out + O_BLF_P + (size_t)layer * PB * PT * HB; float* lfs = P.out + O_BLF_S + (size_t)layer * MS * HB;
    const int gw = C.blk * 8 + C.wave, NGW = C.G * 8;
    for (int it = gw; it < MP / 16; it += NGW) { const int r0 = it * 16, b = r0 >> 13; const float* mv = mod + (size_t)b * NMOD;
        norm_rows<WITH_LOGF>(C, xp + (size_t)r0 * D, H + (size_t)r0 * LDH, 16, gvec, mv + off_shift, mv + off_scale, wf, bf, lfp + (size_t)r0 * HB); }
    if (C.wave == 0 && xs != nullptr) for (int r = C.blk; r < MS; r += C.G) { const float* mv = mod + (size_t)(PB + (r >> 5)) * NMOD; const float* xr = xs + (size_t)r * D;
        if (fix_nkc > 0) { float* xo = P.out + O_Y_S + (size_t)r * D;
            sample_resid_row(C, xr, xo, (const float*)(P.ws + WS_PART) + (size_t)r * D, fix_nkc, fix_mod + (size_t)(PB + (r >> 5)) * NMOD + fix_gate_off); xr = xo; }
        norm_rows<WITH_LOGF>(C, xr, H + (size_t)(MP + r) * LDH, 1, gvec, mv + off_shift, mv + off_scale, wf, bf, lfs + (size_t)r * HB); }
    __syncthreads();
}

__device__ __forceinline__ void final_norm(const Params& P, const Ctx& C) {
    const float* g = P.in[22]; f32x4 gm[8];
#pragma unroll
    for (int j = 0; j < 8; ++j) gm[j] = *(const f32x4*)(g + 4 * C.lane + 256 * j);
    const int gw = C.blk * 8 + C.wave, NGW = C.G * 8;
    for (int it = gw; it < MP / 16; it += NGW) {
        float* x0 = P.out + (size_t)it * 16 * D; f32x4 nx[8];
#pragma unroll
        for (int j = 0; j < 8; ++j) nx[j] = *(const f32x4*)(x0 + 4 * C.lane + 256 * j);
        for (int r = 0; r < 16; ++r) { float* xr = x0 + (size_t)r * D; f32x4 v[8]; float ss = 0.f;
#pragma unroll
            for (int j = 0; j < 8; ++j) v[j] = nx[j];
            if (r + 1 < 16) {
#pragma unroll
                for (int j = 0; j < 8; ++j) nx[j] = *(const f32x4*)(xr + D + 4 * C.lane + 256 * j); }
            asm volatile("" ::: "memory");
#pragma unroll
            for (int j = 0; j < 8; ++j) ss += (v[j][0] * v[j][0] + v[j][1] * v[j][1]) + (v[j][2] * v[j][2] + v[j][3] * v[j][3]);
            const float rstd = 1.0f / sqrtf(wave_sum(ss) * (1.0f / D) + EPS);
#pragma unroll
            for (int j = 0; j < 8; ++j) *(f32x4*)(xr + 4 * C.lane + 256 * j) = v[j] * rstd * gm[j]; }
    }
    if (C.wave == 0) for (int rs = C.blk; rs < MS; rs += C.G) {
        float* xr = P.out + O_Y_S + (size_t)rs * D;
        sample_resid_row(C, xr, xr, (const float*)(P.ws + WS_PART) + (size_t)rs * D, DFF / 256, (const float*)(P.ws + WS_MOD) + ((size_t)NMIDX + PB + (rs >> 5)) * NMOD + 5 * D);
        f32x4 v[8]; float ss = 0.f;
#pragma unroll
        for (int j = 0; j < 8; ++j) { v[j] = *(const f32x4*)(xr + 4 * C.lane + 256 * j); ss += (v[j][0] * v[j][0] + v[j][1] * v[j][1]) + (v[j][2] * v[j][2] + v[j][3] * v[j][3]); }
        const float rstd = 1.0f / sqrtf(wave_sum(ss) * (1.0f / D) + EPS);
#pragma unroll
        for (int j = 0; j < 8; ++j) *(f32x4*)(xr + 4 * C.lane + 256 * j) = v[j] * rstd * gm[j]; }
}

__device__ __forceinline__ float block_excl_scan(const Ctx& C, LAS float* red, float s) {
    float incl = s;
#pragma unroll
    for (int o = 1; o < 64; o <<= 1) { const float t = __shfl_up(incl, o); if (C.lane >= o) incl += t; }
    if (C.lane == 63) red[C.wave] = incl;
    __syncthreads();
    float base = 0.f;
    for (int w = 0; w < C.wave; ++w) base += red[w];
    return base + incl - s;
}

__device__ __forceinline__ void fcum_phase(const Params& P, const Ctx& C, int layer) {
    LAS float* red = (LAS float*)(C.lds + RING_OFF);
    if (C.blk < PB * HB) {
        const int b = C.blk / HB, h = C.blk % HB; const float* lf = P.out + O_BLF_P + ((size_t)(layer * PB + b) * PT) * HB + h;
        float* F = (float*)(P.ws + WS_FP) + ((size_t)b * PT) * HB + h;
        float v[16]; float s = 0.f;
#pragma unroll
        for (int i = 0; i < 16; ++i) { v[i] = lf[(size_t)(C.tid * 16 + i) * HB]; s += v[i]; }
        float a = block_excl_scan(C, red, s);
#pragma unroll
        for (int i = 0; i < 16; ++i) { a += v[i]; F[(size_t)(C.tid * 16 + i) * HB] = a; }
        __syncthreads();
    } else if (C.blk < PB * HB + SB * HB) {
        const int q = C.blk - PB * HB, sb = q / HB, h = q % HB; constexpr int L = PAST + ST;
        const float* cl = P.in[6] + ((size_t)(layer * SB + sb) * PAST) * HB + h; const float* nl = P.out + O_BLF_S + ((size_t)(layer * SB + sb) * ST) * HB + h;
        float* F = (float*)(P.ws + WS_FS) + ((size_t)sb * L) * HB + h;
        float v[3]; float s = 0.f;
#pragma unroll
        for (int i = 0; i < 3; ++i) { const int p = C.tid * 3 + i; v[i] = p < PAST ? cl[(size_t)p * HB] : (p < L ? nl[(size_t)(p - PAST) * HB] : 0.f); s += v[i]; }
        float a = block_excl_scan(C, red, s);
#pragma unroll
        for (int i = 0; i < 3; ++i) { const int p = C.tid * 3 + i; a += v[i]; if (p < L) F[(size_t)p * HB] = a; }
        __syncthreads();
    }
}

__device__ __forceinline__ void finish_qkv(const Params& P, const Ctx& C, int layer) {
    const float* part = (const float*)(P.ws + WS_PART); bf16* qkv = (bf16*)(P.ws + WS_QKV);
    for (int r = C.blk; r < MS; r += C.G)
        for (int c4 = C.tid; c4 < NQKV / 4; c4 += 512) { const int c = c4 * 4; f32x4 s = (f32x4){0.f, 0.f, 0.f, 0.f};
#pragma unroll
            for (int kc = 0; kc < 8; ++kc) s += *(const f32x4*)(part + ((size_t)kc * MS + r) * NQKV + c);
            u32x2 w; w.x = cvt_pk_bf16(s[0], s[1]); w.y = cvt_pk_bf16(s[2], s[3]); *(u32x2*)(qkv + (size_t)(MP + r) * LDQ + c) = w;
            const int which = c / D;
            if (which != 0) { const int hh = (c % D) / HD, d = c % HD; const bool isv = which == 2; float* dst;
                if (hh < HA) dst = P.out + (isv ? O_AV_S : O_AK_S) + ((size_t)(layer * MS + r) * HA + hh) * HD + d;
                else if (hh < HA + HB) dst = P.out + (isv ? O_BV_S : O_BK_S) + ((size_t)(layer * MS + r) * HB + (hh - HA)) * HD + d;
                else dst = P.out + (isv ? O_CV_S : O_CK_S) + ((size_t)(layer * MS + r) * HC + (hh - HA - HB)) * HD + d;
                *(f32x4*)dst = s; } }
}
__device__ __forceinline__ void finish_act(const Params& P, const Ctx& C) {
    const float* part = (const float*)(P.ws + WS_PART); bf16* act = (bf16*)(P.ws + WS_QKV);
    for (int r = C.blk; r < MS; r += C.G)
        for (int j4 = C.tid; j4 < DFF / 4; j4 += 512) { const int j = j4 * 4, cg = (j >> 7) * 256 + (j & 127); f32x4 g = (f32x4){0.f, 0.f, 0.f, 0.f}, up = g;
#pragma unroll
            for (int kc = 0; kc < 4; ++kc) { const float* pr = part + ((size_t)kc * MS + r) * (2 * DFF) + cg; g += *(const f32x4*)pr; up += *(const f32x4*)(pr + 128); }
            float o[4];
#pragma unroll
            for (int i = 0; i < 4; ++i) o[i] = g[i] * fast_rcp(1.0f + fast_exp2(-g[i] * LOG2E)) * up[i];
            u32x2 w; w.x = cvt_pk_bf16(o[0], o[1]); w.y = cvt_pk_bf16(o[2], o[3]); *(u32x2*)(act + (size_t)(MP + r) * LDACT + j) = w; }
}


namespace att {
constexpr int KROW = 272, VROW = 144;
constexpr int KBUF = 64 * KROW, VBUF = 128 * VROW;
constexpr int OFF_K = 0, OFF_V = 2 * KBUF, OFF_FB = OFF_V + 2 * VBUF, OFF_REL = OFF_FB + 512, OFF_VOTE = OFF_REL + 1040, OFF_QW = OFF_VOTE + 64;
static_assert(OFF_QW + 16 <= RING_BYTES && (OFF_REL % 16) == 0 && (OFF_VOTE % 16) == 0, "attention LDS map");
constexpr float STICK_STOP = -105.0f;

struct Unit {
    const bf16* q; bf16* o; int ostride; int nq, qpos0, kv_len, new_pos0;
    const bf16 *kn, *vn; const float *kc, *vc; int cstride;
    int t_hi, t_lo;
    const float* F; float fref; float kmax;
    const float* rel;
};

__device__ __forceinline__ float partner32(float x, int hi) {
    auto rr = __builtin_amdgcn_permlane32_swap(__float_as_uint(x), __float_as_uint(x), false, false);
    return __uint_as_float(hi ? rr[0] : rr[1]);
}
__device__ __forceinline__ bf16x8 pack8(float a0, float a1, float a2, float a3, float a4, float a5, float a6, float a7) {
    u32x4 w = {cvt_pk_bf16(a0, a1), cvt_pk_bf16(a2, a3), cvt_pk_bf16(a4, a5), cvt_pk_bf16(a6, a7)};
    return __builtin_bit_cast(bf16x8, w);
}

template <int MODE>
__device__ __forceinline__ void run_unit(LAS unsigned char* lds, const Unit& u, int tid, int wave, int lane) {
    const int qr = lane & 31, hi = lane >> 5;
    const bool active = wave * 32 < u.nq;
    const int qpos_w0 = u.qpos0 + wave * 32, qpos = qpos_w0 + qr;
    int w_hi, w_lo;
    if (MODE == 0) { const int n = qpos_w0 >> 6; w_hi = n; w_lo = n - 8 > 0 ? n - 8 : 0; }
    else if (MODE == 1) { w_hi = (qpos_w0 + 31) >> 6; w_lo = 0; }
    else { w_hi = (qpos_w0 + 30) >> 6; w_lo = 0; }
    const int near_lo = (qpos_w0 >> 6) - 2;
    bf16x8 qf[8];
    { const bf16* qp = u.q + (size_t)((active ? wave * 32 : 0) + qr) * LDQ + 8 * hi;
#pragma unroll
      for (int ds = 0; ds < 8; ++ds) qf[ds] = *(const bf16x8*)(qp + 16 * ds); }
    float qk_bound = 0.f;
    if (MODE == 1) { float s = 0.f;
#pragma unroll
        for (int ds = 0; ds < 8; ++ds) { const u32x4 w = __builtin_bit_cast(u32x4, qf[ds]);
#pragma unroll
            for (int i = 0; i < 4; ++i) { const float lo = __uint_as_float(w[i] << 16), hi2 = __uint_as_float(w[i] & 0xffff0000u); s += lo * lo + hi2 * hi2; } }
        s += partner32(s, hi); qk_bound = sqrtf(s) * u.kmax; }
    LAS float* rel_l = (LAS float*)(lds + OFF_REL);
    if (MODE == 0) { for (int i = tid; i < 257; i += 512) rel_l[i] = u.rel[i * HA] * INV_SCALE; }
    f32x16 o[4];
#pragma unroll
    for (int b = 0; b < 4; ++b)
#pragma unroll
        for (int r = 0; r < 16; ++r) o[b][r] = 0.f;
    float m_run = -1e30f, l_run = 0.f, carry = 0.f;
    const int k_key = tid >> 4, k_dc = tid & 15;
    const int k_lds = k_key * KROW + k_dc * 16;
    const int v_dc = lane & 15, v_kq = lane >> 4;
    const int v_key0 = 16 * (wave >> 1) + 4 * (wave & 1) + 2 * (v_kq & 1) + 8 * (v_kq >> 1);
    const int v_pos0 = (v_key0 & ~0xC) | ((v_key0 & 4) << 1) | ((v_key0 & 8) >> 1);
    const int v_lds = (8 * v_dc) * VROW + ((((v_pos0 >> 3) ^ ((v_dc >> 1) & 7))) << 4) + (v_pos0 & 7) * 2;
    const int kr_lds = qr * KROW + hi * 16;
    const int vr_lds = qr * VROW + ((hi ^ (qr >> 4)) << 4);
    u32x4 kreg[2], vreg[2]; float freg = 0.f;
    auto stage_load = [&](int j) {
        const int last = u.kv_len - 1;
#pragma unroll
        for (int i = 0; i < 2; ++i) { int pos = 64 * j + k_key + 32 * i; pos = pos < last ? pos : last;
            if (64 * j >= u.new_pos0) kreg[i] = *(const u32x4*)(u.kn + (size_t)(pos - u.new_pos0) * LDQ + 8 * k_dc);
            else { const float* s = u.kc + (size_t)pos * u.cstride + 8 * k_dc; const f32x4 x = *(const f32x4*)s, y = *(const f32x4*)(s + 4);
                kreg[i] = (u32x4){cvt_pk_bf16(x[0], x[1]), cvt_pk_bf16(x[2], x[3]), cvt_pk_bf16(y[0], y[1]), cvt_pk_bf16(y[2], y[3])}; } }
#pragma unroll
        for (int i = 0; i < 2; ++i) { int pos = 64 * j + v_key0 + i; pos = pos < last ? pos : last;
            if (64 * j >= u.new_pos0) vreg[i] = *(const u32x4*)(u.vn + (size_t)(pos - u.new_pos0) * LDQ + 8 * v_dc);
            else { const float* s = u.vc + (size_t)pos * u.cstride + 8 * v_dc; const f32x4 x = *(const f32x4*)s, y = *(const f32x4*)(s + 4);
                vreg[i] = (u32x4){cvt_pk_bf16(x[0], x[1]), cvt_pk_bf16(x[2], x[3]), cvt_pk_bf16(y[0], y[1]), cvt_pk_bf16(y[2], y[3])}; } }
        if (MODE == 1 && tid < 64) { int pos = 64 * j + tid; pos = pos < last ? pos : last; freg = u.F[(size_t)pos * HB]; }
    };
    auto stage_store = [&](int buf) {
        LAS unsigned char* kb = lds + OFF_K + buf * KBUF + k_lds;
        *(LAS u32x4*)kb = kreg[0]; *(LAS u32x4*)(kb + 32 * KROW) = kreg[1];
        LAS unsigned char* vb = lds + OFF_V + buf * VBUF + v_lds;
        const unsigned a[4] = {vreg[0].x, vreg[0].y, vreg[0].z, vreg[0].w}, b[4] = {vreg[1].x, vreg[1].y, vreg[1].z, vreg[1].w};
#pragma unroll
        for (int i = 0; i < 4; ++i) {
            *(LAS unsigned*)(vb + (2 * i) * VROW) = (a[i] & 0xffffu) | (b[i] << 16);
            *(LAS unsigned*)(vb + (2 * i + 1) * VROW) = (a[i] >> 16) | (b[i] & 0xffff0000u); }
        if (MODE == 1 && tid < 64) ((LAS float*)(lds + OFF_FB + buf * 256))[tid] = (u.fref - freg) * INV_SCALE;
    };
    stage_load(u.t_hi);
    stage_store(0);
    LDS_WAIT(); __syncthreads();
    bool wave_done = !active;
    for (int j = u.t_hi, it = 0;; --j, ++it) {
        const int cur = it & 1;
        const bool more = j > u.t_lo;
        if (more) stage_load(j - 1);
        if (active && j <= w_hi && j >= w_lo && !(MODE != 0 && wave_done)) {
            f32x16 p0, p1;
            if (MODE == 1) { const LAS f32x4* fb = (const LAS f32x4*)(lds + OFF_FB + cur * 256);
#pragma unroll
                for (int g = 0; g < 4; ++g) { const f32x4 a = fb[2 * g + hi], b = fb[8 + 2 * g + hi];
#pragma unroll
                    for (int i = 0; i < 4; ++i) { p0[4 * g + i] = a[i]; p1[4 * g + i] = b[i]; } } }
            else if (MODE == 0) {
                if (j >= near_lo) { const int base = qpos - 64 * j - 4 * hi + 128;
#pragma unroll
                    for (int r = 0; r < 16; ++r) { const int c = (r & 3) + 8 * (r >> 2); int i0 = base - c, i1 = base - c - 32; i0 = i0 < 256 ? i0 : 256; i1 = i1 < 256 ? i1 : 256;
                        p0[r] = rel_l[i0]; p1[r] = rel_l[i1]; } }
                else { const float cb = rel_l[256];
#pragma unroll
                    for (int r = 0; r < 16; ++r) { p0[r] = cb; p1[r] = cb; } } }
            else {
#pragma unroll
                for (int r = 0; r < 16; ++r) { p0[r] = 0.f; p1[r] = 0.f; } }
            { const LAS unsigned char* kb = lds + OFF_K + cur * KBUF + kr_lds;
#define ATT_KFRAG(i) (*(const LAS bf16x8*)(kb + ((i) & 1) * 32 * KROW + 32 * ((i) >> 1)))
              bf16x8 kf[8];
#pragma unroll
              for (int i = 0; i < 8; ++i) kf[i] = ATT_KFRAG(i);
              __builtin_amdgcn_sched_barrier(0);
#pragma unroll
              for (int i = 0; i < 16; ++i) {
                  if (i & 1) p1 = __builtin_amdgcn_mfma_f32_32x32x16_bf16(kf[i & 7], qf[i >> 1], p1, 0, 0, 0); else p0 = __builtin_amdgcn_mfma_f32_32x32x16_bf16(kf[i & 7], qf[i >> 1], p0, 0, 0, 0);
                  if (i + 8 < 16) kf[i & 7] = ATT_KFRAG(i + 8);
                  __builtin_amdgcn_sched_barrier(0); }
#undef ATT_KFRAG
            }
            const int kp0 = 64 * j + 4 * hi;
            if (MODE != 2) {
                const bool need_mask = MODE == 1 ? (64 * j + 63 > qpos_w0) : (64 * j + 63 >= u.kv_len);
                if (need_mask) { const int lim = MODE == 1 ? qpos + 1 : u.kv_len;
#pragma unroll
                    for (int r = 0; r < 16; ++r) { const int kp = kp0 + (r & 3) + 8 * (r >> 2);
                        if (kp >= lim) p0[r] = -__builtin_inff(); if (kp + 32 >= lim) p1[r] = -__builtin_inff(); } }
                float mx = fmaxf(p0[0], p1[0]);
#pragma unroll
                for (int r = 1; r < 16; ++r) mx = fmaxf(mx, fmaxf(p0[r], p1[r]));
                mx = fmaxf(mx, partner32(mx, hi));
                const float mn = fmaxf(m_run, mx);
                constexpr float C2 = ATT_SCALE * LOG2E;
                if (__any(mn > m_run)) { const float alpha = fast_exp2((m_run - mn) * C2); l_run *= alpha; m_run = mn;
#pragma unroll
                    for (int b = 0; b < 4; ++b)
#pragma unroll
                        for (int r = 0; r < 16; ++r) o[b][r] *= alpha; }
                const float mc = m_run * C2; float ps = 0.f;
#pragma unroll
                for (int r = 0; r < 16; ++r) { p0[r] = fast_exp2(p0[r] * C2 - mc); p1[r] = fast_exp2(p1[r] * C2 - mc); ps += p0[r] + p1[r]; }
                l_run += ps;
                if (MODE == 1) {
                    const float bmax = ((const LAS float*)(lds + OFF_FB + cur * 256))[0];
                    wave_done = __all((qk_bound + bmax - m_run) * C2 < -150.0f); }
            } else {
                const bool need_mask = 64 * j + 63 >= qpos_w0;
                float ls0[16], ls1[16];
#pragma unroll
                for (int r = 0; r < 16; ++r) {
                    const float z0 = p0[r] * ATT_SCALE, z1 = p1[r] * ATT_SCALE;
                    const float sp0 = fmaxf(z0, 0.f) + LN2 * fast_log2(1.0f + fast_exp2(-fabsf(z0) * LOG2E)), sp1 = fmaxf(z1, 0.f) + LN2 * fast_log2(1.0f + fast_exp2(-fabsf(z1) * LOG2E));
                    p0[r] = z0 - sp0; p1[r] = z1 - sp1;
                    ls0[r] = -sp0; ls1[r] = -sp1; }
                if (need_mask) {
#pragma unroll
                    for (int r = 0; r < 16; ++r) { const int kp = kp0 + (r & 3) + 8 * (r >> 2);
                        if (kp >= qpos) { ls0[r] = 0.f; p0[r] = -__builtin_inff(); } if (kp + 32 >= qpos) { ls1[r] = 0.f; p1[r] = -__builtin_inff(); } } }
                float a[8], b[8], t[8];
#pragma unroll
                for (int g = 0; g < 4; ++g) { a[g] = (ls0[4 * g] + ls0[4 * g + 1]) + (ls0[4 * g + 2] + ls0[4 * g + 3]); a[4 + g] = (ls1[4 * g] + ls1[4 * g + 1]) + (ls1[4 * g + 2] + ls1[4 * g + 3]); }
#pragma unroll
                for (int g = 0; g < 8; ++g) { b[g] = partner32(a[g], hi); t[g] = a[g] + b[g]; }
                float ps = carry;
#pragma unroll
                for (int g = 7; g >= 0; --g) {
                    const float sg = ps + (hi ? 0.f : b[g]);
                    if (g < 4) { const float e3 = sg, e2 = e3 + ls0[4 * g + 3], e1 = e2 + ls0[4 * g + 2], e0 = e1 + ls0[4 * g + 1];
                        p0[4 * g + 3] = fast_exp2((p0[4 * g + 3] + e3) * LOG2E); p0[4 * g + 2] = fast_exp2((p0[4 * g + 2] + e2) * LOG2E);
                        p0[4 * g + 1] = fast_exp2((p0[4 * g + 1] + e1) * LOG2E); p0[4 * g] = fast_exp2((p0[4 * g] + e0) * LOG2E); }
                    else { const int gg = g - 4; const float e3 = sg, e2 = e3 + ls1[4 * gg + 3], e1 = e2 + ls1[4 * gg + 2], e0 = e1 + ls1[4 * gg + 1];
                        p1[4 * gg + 3] = fast_exp2((p1[4 * gg + 3] + e3) * LOG2E); p1[4 * gg + 2] = fast_exp2((p1[4 * gg + 2] + e2) * LOG2E);
                        p1[4 * gg + 1] = fast_exp2((p1[4 * gg + 1] + e1) * LOG2E); p1[4 * gg] = fast_exp2((p1[4 * gg] + e0) * LOG2E); }
                    ps += t[g];
                }
                carry = ps;
                wave_done = __all(carry < STICK_STOP) || j == 0;
            }
            { const LAS unsigned char* vb = lds + OFF_V + cur * VBUF + vr_lds;
#define ATT_VFRAG(i) (*(const LAS bf16x8*)(vb + 32 * ((i) & 3) * VROW + ((((i) >> 2) ^ ((i) & 3)) << 5)))
              bf16x8 pf[4], vf[8];
              pf[0] = pack8(p0[0], p0[1], p0[2], p0[3], p0[4], p0[5], p0[6], p0[7]); pf[1] = pack8(p0[8], p0[9], p0[10], p0[11], p0[12], p0[13], p0[14], p0[15]);
              pf[2] = pack8(p1[0], p1[1], p1[2], p1[3], p1[4], p1[5], p1[6], p1[7]); pf[3] = pack8(p1[8], p1[9], p1[10], p1[11], p1[12], p1[13], p1[14], p1[15]);
#pragma unroll
              for (int i = 0; i < 8; ++i) vf[i] = ATT_VFRAG(i);
              __builtin_amdgcn_sched_barrier(0);
#pragma unroll
              for (int i = 0; i < 16; ++i) {
                  o[i & 3] = __builtin_amdgcn_mfma_f32_32x32x16_bf16(vf[i & 7], pf[i >> 2], o[i & 3], 0, 0, 0);
                  if (i + 8 < 16) vf[i & 7] = ATT_VFRAG(i + 8);
                  __builtin_amdgcn_sched_barrier(0); }
#undef ATT_VFRAG
            }
        }
        if (more) stage_store(cur ^ 1);
        if (MODE != 0 && lane == 0) ((LAS unsigned*)(lds + OFF_VOTE))[cur * 8 + wave] = (wave_done || j - 1 < w_lo) ? 1u : 0u;
        LDS_WAIT(); __syncthreads();
        if (!more) break;
        if (MODE != 0) { const LAS u32x4* vv = (const LAS u32x4*)(lds + OFF_VOTE + cur * 32); const u32x4 x = vv[0], y = vv[1];
            if ((x.x & x.y & x.z & x.w & y.x & y.y & y.z & y.w) != 0u) break; }
    }
    if (active) {
        float inv = 1.0f;
        if (MODE != 2) { const float lt = l_run + partner32(l_run, hi); inv = 1.0f / lt; }
        bf16* op = u.o + (size_t)(wave * 32 + qr) * u.ostride + 4 * hi;
#pragma unroll
        for (int db = 0; db < 4; ++db)
#pragma unroll
            for (int g = 0; g < 4; ++g) { u32x2 w; w.x = cvt_pk_bf16(o[db][4 * g] * inv, o[db][4 * g + 1] * inv); w.y = cvt_pk_bf16(o[db][4 * g + 2] * inv, o[db][4 * g + 3] * inv);
                *(u32x2*)(op + 32 * db + 8 * g) = w; }
    }
    __syncthreads();
}


__device__ __forceinline__ float vmax3(float a, float b, float c) { float r; asm("v_max3_f32 %0, %1, %2, %3" : "=v"(r) : "v"(a), "v"(b), "v"(c)); return r; }

__device__ __forceinline__ void run_unit_b(LAS unsigned char* lds, const Unit& u, int tid, int wave, int lane) {
    const int qr = lane & 31, hi = lane >> 5;
    const bool active = wave * 32 < u.nq;
    const int qpos_w0 = u.qpos0 + wave * 32, qpos = qpos_w0 + qr;
    const int w_hi = (qpos_w0 + 31) >> 6;
    bf16x8 qf[8];
    { const bf16* qp = u.q + (size_t)((active ? wave * 32 : 0) + qr) * LDQ + 8 * hi;
#pragma unroll
      for (int ds = 0; ds < 8; ++ds) qf[ds] = *(const bf16x8*)(qp + 16 * ds); }
    float qk_bound;
    { float s = 0.f;
#pragma unroll
      for (int ds = 0; ds < 8; ++ds) { const u32x4 w = __builtin_bit_cast(u32x4, qf[ds]);
#pragma unroll
          for (int i = 0; i < 4; ++i) { const float lo = __uint_as_float(w[i] << 16), hi2 = __uint_as_float(w[i] & 0xffff0000u); s += lo * lo + hi2 * hi2; } }
      s += partner32(s, hi); qk_bound = sqrtf(s) * u.kmax; }
    f32x16 o[4];
#pragma unroll
    for (int b = 0; b < 4; ++b)
#pragma unroll
        for (int r = 0; r < 16; ++r) o[b][r] = 0.f;
    float m_run = -1e30f, l_run = 0.f;
    const int k_key = tid >> 4, k_dc = tid & 15, k_lds = k_key * KROW + k_dc * 16;
    const int v_dc = lane & 15, v_kq = lane >> 4;
    const int v_key0 = 16 * (wave >> 1) + 4 * (wave & 1) + 2 * (v_kq & 1) + 8 * (v_kq >> 1);
    const int v_pos0 = (v_key0 & ~0xC) | ((v_key0 & 4) << 1) | ((v_key0 & 8) >> 1);
    const int v_lds = (8 * v_dc) * VROW + ((((v_pos0 >> 3) ^ ((v_dc >> 1) & 7))) << 4) + (v_pos0 & 7) * 2;
    const int kr_lds = qr * KROW + hi * 16, vr_lds = qr * VROW + ((hi ^ (qr >> 4)) << 4);
    u32x4 kreg[2], vreg[2], kreg2[2], vreg2[2]; float freg = 0.f, freg2 = 0.f;
#define B_STAGE_LOAD(J, kreg, vreg, freg) do { const int last_ = u.kv_len - 1; \
        if (64 * (J) >= u.new_pos0) { \
        _Pragma("unroll") for (int i = 0; i < 2; ++i) { int pos = 64 * (J) + k_key + 32 * i; pos = pos < last_ ? pos : last_; kreg[i] = *(const u32x4*)(u.kn + (size_t)(pos - u.new_pos0) * LDQ + 8 * k_dc); } \
        _Pragma("unroll") for (int i = 0; i < 2; ++i) { int pos = 64 * (J) + v_key0 + i; pos = pos < last_ ? pos : last_; vreg[i] = *(const u32x4*)(u.vn + (size_t)(pos - u.new_pos0) * LDQ + 8 * v_dc); } \
        } else { \
        _Pragma("unroll") for (int i = 0; i < 2; ++i) { const float* s_ = u.kc + (size_t)(64 * (J) + k_key + 32 * i) * u.cstride + 8 * k_dc; const f32x4 x_ = *(const f32x4*)s_, y_ = *(const f32x4*)(s_ + 4); \
            kreg[i] = (u32x4){cvt_pk_bf16(x_[0], x_[1]), cvt_pk_bf16(x_[2], x_[3]), cvt_pk_bf16(y_[0], y_[1]), cvt_pk_bf16(y_[2], y_[3])}; } \
        _Pragma("unroll") for (int i = 0; i < 2; ++i) { const float* s_ = u.vc + (size_t)(64 * (J) + v_key0 + i) * u.cstride + 8 * v_dc; const f32x4 x_ = *(const f32x4*)s_, y_ = *(const f32x4*)(s_ + 4); \
            vreg[i] = (u32x4){cvt_pk_bf16(x_[0], x_[1]), cvt_pk_bf16(x_[2], x_[3]), cvt_pk_bf16(y_[0], y_[1]), cvt_pk_bf16(y_[2], y_[3])}; } } \
        if (tid < 64) { int pos = 64 * (J) + tid; pos = pos < last_ ? pos : last_; freg = u.F[(size_t)pos * HB]; } } while (0)
#define B_STAGE_STORE(B_, kreg, vreg, freg) do { LAS unsigned char* kb_ = lds + OFF_K + (B_) * KBUF + k_lds; *(LAS u32x4*)kb_ = kreg[0]; *(LAS u32x4*)(kb_ + 32 * KROW) = kreg[1]; \
        LAS unsigned char* vb_ = lds + OFF_V + (B_) * VBUF + v_lds; const unsigned a_[4] = {vreg[0].x, vreg[0].y, vreg[0].z, vreg[0].w}, b_[4] = {vreg[1].x, vreg[1].y, vreg[1].z, vreg[1].w}; \
        _Pragma("unroll") for (int i = 0; i < 4; ++i) { *(LAS unsigned*)(vb_ + (2 * i) * VROW) = (a_[i] & 0xffffu) | (b_[i] << 16); *(LAS unsigned*)(vb_ + (2 * i + 1) * VROW) = (a_[i] >> 16) | (b_[i] & 0xffff0000u); } \
        if (tid < 64) ((LAS float*)(lds + OFF_FB + (B_) * 256))[tid] = (u.fref - freg) * INV_SCALE; } while (0)
    B_STAGE_LOAD(u.t_hi, kreg, vreg, freg);
    B_STAGE_STORE(0, kreg, vreg, freg);
    if (u.t_hi > u.t_lo) B_STAGE_LOAD(u.t_hi - 1, kreg, vreg, freg);
    LDS_WAIT(); __syncthreads();
    constexpr float C2 = ATT_SCALE * LOG2E;
    bool wave_done = !active;
#define B_QK(PX, KH_) do { const LAS unsigned char* kb_ = lds + OFF_K + cur * KBUF + kr_lds + (KH_) * 32 * KROW; bf16x8 kf[4]; \
        _Pragma("unroll") for (int i = 0; i < 4; ++i) kf[i] = *(const LAS bf16x8*)(kb_ + 32 * i); \
        _Pragma("unroll") for (int i = 0; i < 8; ++i) { PX = __builtin_amdgcn_mfma_f32_32x32x16_bf16(kf[i & 3], qf[i], PX, 0, 0, 0); \
            if (i + 4 < 8) kf[i & 3] = *(const LAS bf16x8*)(kb_ + 32 * (i + 4)); } } while (0)
#define B_SM(PX, PFA, PFB, ALPHA) do { float mx = vmax3(PX[0], PX[1], PX[2]); \
        _Pragma("unroll") for (int r = 3; r < 15; r += 2) mx = vmax3(mx, PX[r], PX[r + 1]); \
        mx = fmaxf(mx, PX[15]); mx = fmaxf(mx, partner32(mx, hi)); const float mn = fmaxf(m_run, mx); ALPHA = fast_exp2((m_run - mn) * C2); l_run *= ALPHA; m_run = mn; \
        const float mc = mn * C2; float ps = 0.f; \
        _Pragma("unroll") for (int r = 0; r < 16; ++r) { PX[r] = fast_exp2(PX[r] * C2 - mc); ps += PX[r]; } \
        l_run += ps; PFA = pack8(PX[0], PX[1], PX[2], PX[3], PX[4], PX[5], PX[6], PX[7]); PFB = pack8(PX[8], PX[9], PX[10], PX[11], PX[12], PX[13], PX[14], PX[15]); } while (0)
#define B_PV(S0_, PFA, PFB) do { const LAS unsigned char* vb_ = lds + OFF_V + cur * VBUF + vr_lds; bf16x8 vf[4]; \
        _Pragma("unroll") for (int i = 0; i < 4; ++i) vf[i] = *(const LAS bf16x8*)(vb_ + 32 * (i & 3) * VROW + ((((S0_) + (i >> 2)) ^ (i & 3)) << 5)); \
        _Pragma("unroll") for (int i = 0; i < 8; ++i) { o[i & 3] = __builtin_amdgcn_mfma_f32_32x32x16_bf16(vf[i & 3], (i < 4 ? PFA : PFB), o[i & 3], 0, 0, 0); \
            if (i + 4 < 8) vf[i & 3] = *(const LAS bf16x8*)(vb_ + 32 * ((i + 4) & 3) * VROW + ((((S0_) + ((i + 4) >> 2)) ^ ((i + 4) & 3)) << 5)); } } while (0)
#define B_RESCALE(ALPHA) do { if (__any(ALPHA != 1.0f)) { _Pragma("unroll") for (int b = 0; b < 4; ++b) _Pragma("unroll") for (int r = 0; r < 16; ++r) o[b][r] *= ALPHA; } } while (0)
#define B_KFRAG1(i) (*(const LAS bf16x8*)(lds + OFF_K + cur * KBUF + kr_lds + 32 * KROW + 32 * (i)))
#define B_VFRAG0(i) (*(const LAS bf16x8*)(lds + OFF_V + cur * VBUF + vr_lds + 32 * ((i) & 3) * VROW + ((((i) >> 2) ^ ((i) & 3)) << 5)))
#define B_MFMA_SM(PX, PFA, PFB, ALPHA, FRAG_, MMA_) do { bf16x8 fr[4]; float mx_, mc_ = 0.f, ps_ = 0.f; \
        _Pragma("unroll") for (int i = 0; i < 4; ++i) fr[i] = FRAG_(i); \
        __builtin_amdgcn_sched_barrier(0); \
        _Pragma("unroll") for (int i = 0; i < 8; ++i) { MMA_; if (i + 4 < 8) fr[i & 3] = FRAG_(i + 4); \
            if (i == 0) { mx_ = vmax3(PX[0], PX[1], PX[2]); mx_ = vmax3(mx_, PX[3], PX[4]); mx_ = vmax3(mx_, PX[5], PX[6]); mx_ = vmax3(mx_, PX[7], PX[8]); } \
            if (i == 1) { mx_ = vmax3(mx_, PX[9], PX[10]); mx_ = vmax3(mx_, PX[11], PX[12]); mx_ = vmax3(mx_, PX[13], PX[14]); mx_ = fmaxf(mx_, PX[15]); mx_ = fmaxf(mx_, partner32(mx_, hi)); asm volatile("" : "+v"(mx_)); } \
            if (i == 2) { const float mn_ = fmaxf(m_run, mx_); ALPHA = fast_exp2((m_run - mn_) * C2); l_run *= ALPHA; m_run = mn_; mc_ = mn_ * C2; asm volatile("" : "+v"(mc_), "+v"(ALPHA)); } \
            if (i >= 3 && i <= 6) { _Pragma("unroll") for (int r = 4 * (i - 3); r < 4 * (i - 3) + 4; ++r) { PX[r] = fast_exp2(PX[r] * C2 - mc_); ps_ += PX[r]; } \
                asm volatile("" : "+v"(PX[4 * (i - 3)]), "+v"(PX[4 * (i - 3) + 1]), "+v"(PX[4 * (i - 3) + 2]), "+v"(PX[4 * (i - 3) + 3]), "+v"(ps_)); } \
            if (i == 7) { l_run += ps_; PFA = pack8(PX[0], PX[1], PX[2], PX[3], PX[4], PX[5], PX[6], PX[7]); PFB = pack8(PX[8], PX[9], PX[10], PX[11], PX[12], PX[13], PX[14], PX[15]); } \
            __builtin_amdgcn_sched_barrier(0); } } while (0)
#define B_HINT() do { _Pragma("unroll") for (int i = 0; i < 8; ++i) { __builtin_amdgcn_sched_group_barrier(0x008, 1, 0); __builtin_amdgcn_sched_group_barrier(0x100, 1, 0); __builtin_amdgcn_sched_group_barrier(0x002, 10, 0); } } while (0)
#define B_ITER(KS, VS, FS, KL, VL, FL) { \
        const int cur = it & 1; \
        const bool more = j > u.t_lo; \
        if (j - 1 > u.t_lo) B_STAGE_LOAD(j - 2, KL, VL, FL); \
        if (active && j <= w_hi && !wave_done) { \
            f32x16 p0, p1; bf16x8 pf0, pf1, pf2, pf3; float alpha_a, alpha_b; \
            const LAS f32x4* fb = (const LAS f32x4*)(lds + OFF_FB + cur * 256); const float bmax = ((const LAS float*)fb)[0]; \
        _Pragma("unroll") \
            for (int g = 0; g < 4; ++g) { const f32x4 a = fb[2 * g + hi], b = fb[8 + 2 * g + hi]; \
        _Pragma("unroll") \
                for (int i = 0; i < 4; ++i) { p0[4 * g + i] = a[i]; p1[4 * g + i] = b[i]; } } \
            const bool need_mask = 64 * j + 63 > qpos_w0; const int kp0 = 64 * j + 4 * hi; \
            B_QK(p0, 0); \
            if (need_mask) { \
        _Pragma("unroll") \
                for (int r = 0; r < 16; ++r) { if (kp0 + (r & 3) + 8 * (r >> 2) > qpos) p0[r] = -__builtin_inff(); } } \
            B_MFMA_SM(p0, pf0, pf1, alpha_a, B_KFRAG1, p1 = __builtin_amdgcn_mfma_f32_32x32x16_bf16(fr[i & 3], qf[i], p1, 0, 0, 0)); \
            if (need_mask) { \
        _Pragma("unroll") \
                for (int r = 0; r < 16; ++r) { if (kp0 + 32 + (r & 3) + 8 * (r >> 2) > qpos) p1[r] = -__builtin_inff(); } } \
            B_RESCALE(alpha_a); \
            B_MFMA_SM(p1, pf2, pf3, alpha_b, B_VFRAG0, o[i & 3] = __builtin_amdgcn_mfma_f32_32x32x16_bf16(fr[i & 3], (i < 4 ? pf0 : pf1), o[i & 3], 0, 0, 0)); \
            B_RESCALE(alpha_b); \
            B_PV(2, pf2, pf3); \
            wave_done = __all((qk_bound + bmax - m_run) * C2 < -150.0f); \
        } \
        if (more) B_STAGE_STORE(cur ^ 1, KS, VS, FS); \
        if (lane == 0) ((LAS unsigned*)(lds + OFF_VOTE))[cur * 8 + wave] = (wave_done || j == 0) ? 1u : 0u; \
        LDS_WAIT(); __syncthreads(); \
        if (!more) break; \
        { const LAS u32x4* vv = (const LAS u32x4*)(lds + OFF_VOTE + cur * 32); const u32x4 x = vv[0], y = vv[1]; \
          if ((x.x & x.y & x.z & x.w & y.x & y.y & y.z & y.w) != 0u) break; } \
    }
    for (int j = u.t_hi, it = 0;;) {
        B_ITER(kreg, vreg, freg, kreg2, vreg2, freg2) --j; ++it;
        B_ITER(kreg2, vreg2, freg2, kreg, vreg, freg) --j; ++it;
    }
#undef B_ITER
#undef B_STAGE_LOAD
#undef B_STAGE_STORE
#undef B_QK
#undef B_SM
#undef B_PV
#undef B_RESCALE
#undef B_HINT
#undef B_MFMA_SM
#undef B_KFRAG1
#undef B_VFRAG0
    if (active) {
        const float lt = l_run + partner32(l_run, hi), inv = 1.0f / lt;
        bf16* op = u.o + (size_t)(wave * 32 + qr) * u.ostride + 4 * hi;
#pragma unroll
        for (int db = 0; db < 4; ++db)
#pragma unroll
            for (int g = 0; g < 4; ++g) { u32x2 w; w.x = cvt_pk_bf16(o[db][4 * g] * inv, o[db][4 * g + 1] * inv); w.y = cvt_pk_bf16(o[db][4 * g + 2] * inv, o[db][4 * g + 3] * inv);
                *(u32x2*)(op + 32 * db + 8 * g) = w; }
    }
    __syncthreads();
}

__device__ __forceinline__ int pull(LAS unsigned char* lds, unsigned* counter, int tid) {
    LAS int* qw = (LAS int*)(lds + OFF_QW);
    if (tid == 0) *qw = (int)__hip_atomic_fetch_add(counter, 1u, __ATOMIC_RELAXED, __HIP_MEMORY_SCOPE_AGENT);
    LDS_WAIT(); __syncthreads();
    const int v = *qw;
    __syncthreads();
    return v;
}

template <int MODE>
__device__ __forceinline__ void mode_loop(const Params& P, const Ctx& C, int layer, int probe_pass) {
    constexpr int NHG = MODE == 0 ? HA : HB;
    constexpr int H0 = MODE == 0 ? 0 : (MODE == 1 ? HA : HA + HB);
    constexpr int NPU = PB * NHG * (PT / 256), NSU = SB * NHG;
    unsigned* counter = (unsigned*)(P.ws + WS_CTL) + CW_QUEUE + 64 * (layer * 3 + MODE + 8 * probe_pass);
    const bf16* qkv = (const bf16*)(P.ws + WS_QKV);
    int i = pull(C.lds, counter, C.tid);
    while (i < NPU + NSU) {
        unsigned nxt = 0u;
        if (C.tid == 0) nxt = __hip_atomic_fetch_add(counter, 1u, __ATOMIC_RELAXED, __HIP_MEMORY_SCOPE_AGENT);
        Unit u;
        if (i < NPU) {
            const int qb = (PT / 256 - 1) - i / (PB * NHG), bh = i % (PB * NHG), b = bh / NHG, hg = bh % NHG, hh = H0 + hg;
            const size_t row0 = (size_t)b * PT;
            u.q = qkv + (row0 + (size_t)qb * 256) * LDQ + hh * HD; u.nq = 256; u.qpos0 = qb * 256; u.kv_len = PT; u.new_pos0 = 0;
            u.kn = qkv + row0 * LDQ + D + hh * HD; u.vn = qkv + row0 * LDQ + 2 * D + hh * HD; u.kc = P.in[2]; u.vc = P.in[3]; u.cstride = 0;
            u.t_hi = 4 * qb + 3; u.t_lo = MODE == 0 ? (4 * qb - 8 > 0 ? 4 * qb - 8 : 0) : 0;
            u.F = (const float*)(P.ws + WS_FP) + row0 * HB + hg; u.fref = MODE == 1 ? u.F[(size_t)u.qpos0 * HB] : 0.f;
            u.rel = P.in[17] + (size_t)layer * 257 * HA + hh;
            u.kmax = 0.f;
            if (MODE == 1) {
                const float* kn2 = (const float*)(P.ws + WS_KN2) + ((size_t)layer * MP + row0) * HB + hg; float mx = 0.f;
                for (int t = C.tid; t < u.qpos0 + 256; t += 512) mx = fmaxf(mx, kn2[(size_t)t * HB]);
#pragma unroll
                for (int o = 1; o < 64; o <<= 1) mx = fmaxf(mx, __shfl_xor(mx, o));
                LAS float* red = (LAS float*)(C.lds + OFF_VOTE);
                if (C.lane == 0) red[C.wave] = mx;
                LDS_WAIT(); __syncthreads();
                mx = fmaxf(fmaxf(fmaxf(red[0], red[1]), fmaxf(red[2], red[3])), fmaxf(fmaxf(red[4], red[5]), fmaxf(red[6], red[7])));
                __syncthreads();
                u.kmax = sqrtf(mx) * 1.01f; }
        } else {
            const int s = i - NPU, sb = s / NHG, hg = s % NHG, hh = H0 + hg;
            constexpr int CL = MODE == 0 ? AWIN : PAST;
            const size_t row0 = (size_t)MP + (size_t)sb * ST;
            u.q = qkv + row0 * LDQ + hh * HD; u.nq = ST; u.qpos0 = CL; u.kv_len = CL + ST; u.new_pos0 = CL;
            u.kn = qkv + row0 * LDQ + D + hh * HD; u.vn = qkv + row0 * LDQ + 2 * D + hh * HD;
            const size_t coff = ((size_t)(layer * SB + sb) * CL * NHG + hg) * HD;
            u.kc = P.in[MODE == 0 ? 2 : (MODE == 1 ? 4 : 7)] + coff; u.vc = P.in[MODE == 0 ? 3 : (MODE == 1 ? 5 : 8)] + coff;
            u.cstride = NHG * HD;
            u.t_hi = (CL + ST - 1) >> 6; u.t_lo = 0;
            u.F = (const float*)(P.ws + WS_FS) + (size_t)sb * (PAST + ST) * HB + hg; u.fref = MODE == 1 ? u.F[(size_t)u.qpos0 * HB] : 0.f;
            u.rel = P.in[17] + (size_t)layer * 257 * HA + hh; u.kmax = __builtin_inff();
        }
        u.o = (bf16*)u.q; u.ostride = LDQ;
        if (probe_pass) { u.o = (bf16*)(P.ws + WS_H) + (u.q - qkv) / LDQ * LDH + (u.q - qkv) % LDQ; u.ostride = LDH; }
        if constexpr (MODE == 1) run_unit_b(C.lds, u, C.tid, C.wave, C.lane); else run_unit<MODE>(C.lds, u, C.tid, C.wave, C.lane);
        { LAS int* qw = (LAS int*)(C.lds + OFF_QW); if (C.tid == 0) *qw = (int)nxt; LDS_WAIT(); __syncthreads(); i = *qw; __syncthreads(); }
    }
}
}


#ifndef PHASE_MASK
#define PHASE_MASK 0xFFF
#endif
#define PH(n) ((PHASE_MASK >> (n)) & 1)
#ifndef DUP_MASK
#define DUP_MASK 0
#endif
#define DUP(n) ((DUP_MASK >> (n)) & 1)
typedef const Params __attribute__((address_space(4)))* KParams;
__device__ __forceinline__ const Params& kparams() {
    KParams p = (KParams)__builtin_amdgcn_kernarg_segment_ptr(); asm volatile("" : "+s"(p)); return *(const Params*)p;
}
#define P (kparams())
__device__ __forceinline__ Ctx make_ctx(LAS unsigned char* lds) {
    Ctx C; int t = threadIdx.x; asm volatile("" : "+v"(t));
    C.lds = lds; C.tid = t; C.lane = t & 63; C.wave = __builtin_amdgcn_readfirstlane(t >> 6); C.G = gridDim.x; C.blk = blockIdx.x; return C;
}
__global__ void __launch_bounds__(512, 2) hse_fwd(Params P_unused) {
    extern __shared__ __attribute__((aligned(16))) unsigned char lds_raw[];
    LAS unsigned char* const lds = (LAS unsigned char*)lds_raw;
    volatile LAS unsigned* MISC = (volatile LAS unsigned*)(lds + MISC_OFF);
    if (threadIdx.x < 64) MISC[threadIdx.x] = 0u;
    __syncthreads();
    XcdBarrier bar = xcd_barrier_post((unsigned*)(P.ws + WS_CTL) + CW_BAR, MISC + 8);

    if (PH(0)) { const Params& Q = P; const Ctx C = make_ctx(lds); p0_prologue(Q, C); }
    xcd_barrier(bar);


#pragma unroll 1
    for (int layer = 0; layer < 2; ++layer) {
        if (DUP(1)) { const Params& Q = P; const Ctx C = make_ctx(lds); norm_phase<true>(Q, C, layer, layer == 0 ? Q.in[0] : Q.out + O_Y_P, nullptr, Q.in[13] + layer * D, 0, D, 0, nullptr, 0); }
        if (PH(1)) { const Params& Q = P; const Ctx C = make_ctx(lds); norm_phase<true>(Q, C, layer, layer == 0 ? Q.in[0] : Q.out + O_Y_P, layer == 0 ? Q.in[1] : Q.out + O_Y_S, Q.in[13] + layer * D, 0, D,
                                      layer == 0 ? 0 : DFF / 256, (const float*)(Q.ws + WS_MOD), 5 * D); }
        xcd_barrier(bar);
        if (PH(2)) { const Params& Q = P; const Ctx C = make_ctx(lds); fcum_phase(Q, C, layer); }
#ifdef PROBE_CLOCK
        if (layer == PROBE_CLOCK - 1 && blockIdx.x == 0 && threadIdx.x == 0) { const unsigned long long c = clock64(), t = wall_clock64(); MISC[16] = (unsigned)c; MISC[17] = (unsigned)(c >> 32); MISC[18] = (unsigned)t; MISC[19] = (unsigned)(t >> 32); }
#endif
        if (PH(3)) { const Params& Q = P; const Ctx C = make_ctx(lds); pg8::Gemm g{(const bf16*)(Q.ws + WS_H), (const bf16*)(Q.ws + WS_WIN + layer * SZ_WIN)}; pg8::StaticOrder<MP / 256, NQKV / 256> S; S.init(C.G, C.blk);
          pg8::EpiQKV E{(bf16*)(Q.ws + WS_QKV), Q.out, layer, (float*)(Q.ws + WS_KN2) + (size_t)layer * MP * HB};
          pg8::gemm_phase<pg8::EpiQKV, pg8::StaticOrder<MP / 256, NQKV / 256>, true, true, D, LDH, LDW>(C.lds + RING_OFF, g, S, E);
          if (DUP(3)) { __syncthreads(); pg8::gemm_phase<pg8::EpiQKV, pg8::StaticOrder<MP / 256, NQKV / 256>, true, true, D, LDH, LDW>(C.lds + RING_OFF, g, S, E); }
          pg8::SampleOrder<MP / 256, NQKV / 256, 8> SS; SS.init(C.G, C.blk); pg8::EpiPartial<NQKV> EP{(float*)(Q.ws + WS_PART)};
          pg8::gemm_phase<pg8::EpiPartial<NQKV>, pg8::SampleOrder<MP / 256, NQKV / 256, 8>, true, true, 256, LDH, LDW>(C.lds + RING_OFF, g, SS, EP); }
#ifdef PROBE_CLOCK
        if (layer == PROBE_CLOCK - 1 && blockIdx.x == 0 && threadIdx.x == 0) { const unsigned long long c = clock64(), t = wall_clock64();
            const unsigned long long c0 = ((unsigned long long)MISC[17] << 32) | MISC[16], t0 = ((unsigned long long)MISC[19] << 32) | MISC[18];
            MISC[20] = (unsigned)(((c - c0) * 100ull) / (t - t0)); }
#endif
        xcd_barrier(bar);
        if (PH(3)) { const Params& Q = P; const Ctx C = make_ctx(lds); finish_qkv(Q, C, layer); }
        xcd_barrier(bar);
#if DUP_MASK & 0x70
        if (DUP(4)) { const Params& Q = P; const Ctx C = make_ctx(lds); att::mode_loop<1>(Q, C, layer, 1); }
        if (DUP(5)) { const Params& Q = P; const Ctx C = make_ctx(lds); att::mode_loop<0>(Q, C, layer, 1); }
        if (DUP(6)) { const Params& Q = P; const Ctx C = make_ctx(lds); att::mode_loop<2>(Q, C, layer, 1); }
#endif
        if (PH(4)) { const Params& Q = P; const Ctx C = make_ctx(lds); att::mode_loop<1>(Q, C, layer, 0); }
        if (PH(5)) { const Params& Q = P; const Ctx C = make_ctx(lds); att::mode_loop<0>(Q, C, layer, 0); }
        if (PH(6)) { const Params& Q = P; const Ctx C = make_ctx(lds); att::mode_loop<2>(Q, C, layer, 0); }
        xcd_barrier(bar);
        if (PH(7)) { const Params& Q = P; const Ctx C = make_ctx(lds); pg8::Gemm g{(const bf16*)(Q.ws + WS_QKV), (const bf16*)(Q.ws + WS_WO + layer * SZ_WO)}; pg8::StaticOrder<MP / 256, D / 256> S; S.init(C.G, C.blk);
          pg8::EpiResid E{layer == 0 ? Q.in[0] : Q.out + O_Y_P, Q.out + O_Y_P, (const float*)(Q.ws + WS_MOD) + (size_t)layer * NMIDX * NMOD + 2 * D};
          pg8::gemm_phase<pg8::EpiResid, pg8::StaticOrder<MP / 256, D / 256>, true, true, D, LDQ, LDW>(C.lds + RING_OFF, g, S, E);
          pg8::SampleOrder<MP / 256, D / 256, 8> SS; SS.init(C.G, C.blk); pg8::EpiPartial<D> EP{(float*)(Q.ws + WS_PART)};
          pg8::gemm_phase<pg8::EpiPartial<D>, pg8::SampleOrder<MP / 256, D / 256, 8>, true, true, 256, LDQ, LDW>(C.lds + RING_OFF, g, SS, EP); }
        xcd_barrier(bar);
        if (PH(8)) { const Params& Q = P; const Ctx C = make_ctx(lds); norm_phase<false>(Q, C, layer, Q.out + O_Y_P, layer == 0 ? Q.in[1] : Q.out + O_Y_S, Q.in[14] + layer * D, 3 * D, 4 * D,
                                       D / 256, (const float*)(Q.ws + WS_MOD) + (size_t)layer * NMIDX * NMOD, 2 * D); }
        xcd_barrier(bar);
        if (PH(9)) { const Params& Q = P; const Ctx C = make_ctx(lds); pg8::Gemm g{(const bf16*)(Q.ws + WS_H), (const bf16*)(Q.ws + WS_WGU + layer * SZ_WGU)}; pg8::StaticOrder<MP / 256, 2 * DFF / 256> S; S.init(C.G, C.blk);
          pg8::EpiSwiGLU E{(bf16*)(Q.ws + WS_QKV)};
          pg8::gemm_phase<pg8::EpiSwiGLU, pg8::StaticOrder<MP / 256, 2 * DFF / 256>, true, true, D, LDH, LDW>(C.lds + RING_OFF, g, S, E);
          if (DUP(9)) { __syncthreads(); pg8::gemm_phase<pg8::EpiSwiGLU, pg8::StaticOrder<MP / 256, 2 * DFF / 256>, true, true, D, LDH, LDW>(C.lds + RING_OFF, g, S, E); }
          pg8::SampleOrder<MP / 256, 2 * DFF / 256, 4> SS; SS.init(C.G, C.blk); pg8::EpiPartial<2 * DFF> EP{(float*)(Q.ws + WS_PART)};
          pg8::gemm_phase<pg8::EpiPartial<2 * DFF>, pg8::SampleOrder<MP / 256, 2 * DFF / 256, 4>, true, true, 512, LDH, LDW>(C.lds + RING_OFF, g, SS, EP); }
        xcd_barrier(bar);
        if (PH(9)) { const Params& Q = P; const Ctx C = make_ctx(lds); finish_act(Q, C); }
        xcd_barrier(bar);
        if (PH(10)) { const Params& Q = P; const Ctx C = make_ctx(lds); pg8::Gemm g{(const bf16*)(Q.ws + WS_QKV), (const bf16*)(Q.ws + WS_WDN + layer * SZ_WDN)}; pg8::StaticOrder<MP / 256, D / 256> S; S.init(C.G, C.blk);
          pg8::EpiResid E{Q.out + O_Y_P, Q.out + O_Y_P, (const float*)(Q.ws + WS_MOD) + (size_t)layer * NMIDX * NMOD + 5 * D};
          pg8::gemm_phase<pg8::EpiResid, pg8::StaticOrder<MP / 256, D / 256>, true, true, DFF, LDACT, LDWD>(C.lds + RING_OFF, g, S, E);
          pg8::SampleOrder<MP / 256, D / 256, DFF / 256> SS; SS.init(C.G, C.blk); pg8::EpiPartial<D> EP{(float*)(Q.ws + WS_PART)};
          pg8::gemm_phase<pg8::EpiPartial<D>, pg8::SampleOrder<MP / 256, D / 256, DFF / 256>, true, true, 256, LDACT, LDWD>(C.lds + RING_OFF, g, SS, EP); }
        xcd_barrier(bar);
    }
    if (PH(11)) { const Params& Q = P; const Ctx C = make_ctx(lds); final_norm(Q, C); }
#ifdef PROBE_CLOCK
    if (blockIdx.x == 0 && threadIdx.x == 0) { const unsigned long long t0 = wall_clock64(), wait = (unsigned long long)MISC[20] * 100ull; while (wall_clock64() - t0 < wait) __builtin_amdgcn_s_sleep(8); }
#endif
}
#undef P

extern "C" void kernel_launch(void* const* d_in, const int* in_sizes, int n_in, void* d_out, int out_size, void* d_ws, size_t ws_size, hipStream_t stream) {
    static int grid = 0;
    if (grid == 0) {
        if (n_in != 23 || (size_t)out_size != O_END || ws_size < WS_END) {
            fprintf(stderr, "kernel_launch: unexpected shapes (n_in %d, out %d (want %zu), ws %zu (want >= %zu)); nothing launched\n", n_in, out_size, (size_t)O_END, ws_size, (size_t)WS_END); grid = -1; return; }
        int dev = 0, cus = 0, per_cu = 0;
        if (hipGetDevice(&dev) != hipSuccess || hipDeviceGetAttribute(&cus, hipDeviceAttributeMultiprocessorCount, dev) != hipSuccess) { grid = -1; return; }
        if (hipFuncSetAttribute((const void*)hse_fwd, hipFuncAttributeMaxDynamicSharedMemorySize, LDS_BYTES) != hipSuccess) { fprintf(stderr, "kernel_launch: hipFuncSetAttribute failed\n"); grid = -1; return; }
        if (hipOccupancyMaxActiveBlocksPerMultiprocessor(&per_cu, (const void*)hse_fwd, 512, LDS_BYTES) != hipSuccess || per_cu < 1) { fprintf(stderr, "kernel_launch: occupancy query says %d\n", per_cu); (void)hipGetLastError(); grid = -1; return; }
        grid = cus;
    }
    if (grid < 0) return;
    (void)in_sizes;
    if (hipMemsetAsync((char*)d_ws + WS_CTL, 0, CTL_ZERO_BYTES, stream) != hipSuccess) return;
    Params p{};
    for (int i = 0; i < 23; ++i) p.in[i] = (const float*)d_in[i];
    p.out = (float*)d_out; p.ws = (unsigned char*)d_ws;
    hipLaunchKernelGGL(hse_fwd, dim3(grid), dim3(512), LDS_BYTES, stream, p);
}
```
